# Optimizing an MI355X kernel written in HIP

```python
import math
import jax, jax.numpy as jnp
from jax import lax
import numpy as np

D_MODEL = 1024
BATCH = 4
SEQ = 4096
DEPTH = 1

D_MIX = D_MODEL
MOBA_HEADS = 8
MOBA_HEAD_DIM = 64
MOBA_WIDTH = MOBA_HEADS * MOBA_HEAD_DIM
MOBA_BLOCK = 256
MOBA_TOPK = 3
MOBA_QCHUNK = 32
GLA_HEADS = 4
GLA_DK = 64
GLA_DV = 128
GLA_KEY_WIDTH = GLA_HEADS * GLA_DK
GLA_WIDTH = GLA_HEADS * GLA_DV
GLA_GATE_RANK = 16
GLA_GATE_TAU = 16.0
GLA_CHUNK = 64
REL_BUCKETS = 32
REL_MAX_DIST = 128
N_EXPERTS = 256
TOP_K = 8
N_GROUPS = 8
TOPK_GROUPS = 4
EXPERT_FF = 256
SHARED_FF = 256
ROUTED_SCALE = 2.5
MOE_ROW_BLOCK = 128
NORM_EPS = 1e-6
D_IN = 3 * MOBA_WIDTH + 2 * GLA_KEY_WIDTH + 2 * GLA_WIDTH + GLA_GATE_RANK

kernel_name = "hybrid_moba_gla_moe_block"


def rms_norm(x, g):
    xf = x.astype(jnp.float32)
    y = xf * lax.rsqrt(jnp.mean(xf * xf, axis=-1, keepdims=True) + NORM_EPS)
    return (y * g.astype(jnp.float32)).astype(x.dtype)


def t5_bucket(rel):
    rel = jnp.maximum(rel, 0)
    max_exact = REL_BUCKETS // 2
    relf = jnp.maximum(rel, 1).astype(jnp.float32)
    large = max_exact + (jnp.log(relf / max_exact) / math.log(REL_MAX_DIST / max_exact)
                         * (REL_BUCKETS - max_exact)).astype(jnp.int32)
    large = jnp.minimum(large, REL_BUCKETS - 1)
    return jnp.where(rel < max_exact, rel, large)


def _gather_blocks(blocks, idx):
    return jax.vmap(jax.vmap(lambda kb, i: kb[i]))(blocks, idx)


def moba_attention(q, k, v, rel_bias):
    B, H, S, Dh = q.shape
    n_blk = -(-S // MOBA_BLOCK)
    s_pad = n_blk * MOBA_BLOCK
    pad = ((0, 0), (0, 0), (0, s_pad - S), (0, 0))
    q, k, v = jnp.pad(q, pad), jnp.pad(k, pad), jnp.pad(v, pad)
    k_blocks = k.reshape(B, H, n_blk, MOBA_BLOCK, Dh)
    v_blocks = v.reshape(B, H, n_blk, MOBA_BLOCK, Dh)
    k_mean = jnp.mean(k_blocks.astype(jnp.float32), axis=3).astype(k.dtype)
    scale = Dh ** -0.5
    bias_t = rel_bias.T
    h_idx = jnp.arange(H)[:, None, None, None]
    k_sel = min(MOBA_TOPK, n_blk)
    blk_off = jnp.arange(MOBA_BLOCK)

    def chunk(ci):
        q0 = ci * MOBA_QCHUNK
        blk = q0 // MOBA_BLOCK
        qc = lax.dynamic_slice_in_dim(q, q0, MOBA_QCHUNK, axis=2)
        q_pos = q0 + jnp.arange(MOBA_QCHUNK)
        gate = jnp.einsum('bhqd,bhnd->bhqn', qc, k_mean).astype(jnp.float32)
        gate = jnp.where(jnp.arange(n_blk) < blk, gate, -jnp.inf)
        _, sel = lax.top_k(gate, k_sel)
        sel_valid = jnp.arange(k_sel) < blk
        k_g = _gather_blocks(k_blocks, sel)
        v_g = _gather_blocks(v_blocks, sel)
        k_pos_sel = sel[..., None] * MOBA_BLOCK + blk_off
        s_sel = jnp.einsum('bhqd,bhqjkd->bhqjk', qc, k_g).astype(jnp.float32) * scale
        s_sel = s_sel + bias_t[h_idx, t5_bucket(q_pos[:, None, None] - k_pos_sel)]
        s_sel = jnp.where(sel_valid[:, None], s_sel, -jnp.inf)
        s_sel = s_sel.reshape(B, H, MOBA_QCHUNK, k_sel * MOBA_BLOCK)
        b0 = blk * MOBA_BLOCK
        k_own = lax.dynamic_slice_in_dim(k, b0, MOBA_BLOCK, axis=2)
        v_own = lax.dynamic_slice_in_dim(v, b0, MOBA_BLOCK, axis=2)
        rel_own = q_pos[:, None] - (b0 + blk_off)[None, :]
        s_own = jnp.einsum('bhqd,bhkd->bhqk', qc, k_own).astype(jnp.float32) * scale
        s_own = s_own + bias_t[:, t5_bucket(rel_own)][None]
        s_own = jnp.where(rel_own >= 0, s_own, -jnp.inf)
        p = jax.nn.softmax(jnp.concatenate([s_sel, s_own], axis=-1), axis=-1)
        p_sel = p[..., :k_sel * MOBA_BLOCK].reshape(B, H, MOBA_QCHUNK, k_sel, MOBA_BLOCK).astype(v.dtype)
        p_own = p[..., k_sel * MOBA_BLOCK:].astype(v.dtype)
        return (jnp.einsum('bhqjk,bhqjkd->bhqd', p_sel, v_g)
                + jnp.einsum('bhqk,bhkd->bhqd', p_own, v_own))

    out = lax.map(chunk, jnp.arange(s_pad // MOBA_QCHUNK))
    return jnp.moveaxis(out, 0, 2).reshape(B, H, s_pad, Dh)[:, :, :S]


def gla_chunked(q, k, v, log_a):
    B, H, S, dk = q.shape
    dv = v.shape[-1]
    C = GLA_CHUNK
    nc = S // C

    def chunks(t):
        return jnp.moveaxis(t.astype(jnp.float32).reshape(B, H, nc, C, t.shape[-1]), 2, 0)

    causal = jnp.tril(jnp.ones((C, C), dtype=bool))[:, :, None]

    def step(state, inp):
        qc, kc, vc, ac = inp
        b = jnp.cumsum(ac, axis=2)
        diff = b[:, :, :, None, :] - b[:, :, None, :, :]
        decay = jnp.exp(jnp.where(causal, diff, -jnp.inf))
        scores = jnp.einsum('bhid,bhjd,bhijd->bhij', qc, kc, decay)
        o = (jnp.einsum('bhij,bhjv->bhiv', scores, vc)
             + jnp.einsum('bhid,bhdv->bhiv', qc * jnp.exp(b), state))
        b_last = b[:, :, -1:, :]
        state = (jnp.exp(b_last[:, :, 0, :])[..., None] * state
                 + jnp.einsum('bhjd,bhjv->bhdv', kc * jnp.exp(b_last - b), vc))
        return state, o

    state0 = jnp.zeros((B, H, dk, dv), jnp.float32)
    _, o = lax.scan(step, state0, (chunks(q), chunks(k), chunks(v), chunks(log_a)))
    return jnp.moveaxis(o, 0, 2).reshape(B, H, S, dv).astype(v.dtype)


def hybrid_mixer(h, w_in, q_norm_w, k_norm_w, rel_bias, w_alpha, b_alpha, moba_out_w, gla_out_w, w_out):
    B, S, _ = h.shape
    proj = h @ w_in
    sizes = [MOBA_WIDTH, MOBA_WIDTH, MOBA_WIDTH, GLA_KEY_WIDTH, GLA_KEY_WIDTH, GLA_WIDTH, GLA_WIDTH, GLA_GATE_RANK]
    offsets = [int(o) for o in np.cumsum(sizes)[:-1]]
    mq, mk, mv, gq, gk, gv, gg, ga = jnp.split(proj, offsets, axis=-1)

    def heads(t, n):
        return t.reshape(B, S, n, -1).transpose(0, 2, 1, 3)

    mq = rms_norm(heads(mq, MOBA_HEADS), q_norm_w)
    mk = rms_norm(heads(mk, MOBA_HEADS), k_norm_w)
    o_a = moba_attention(mq, mk, heads(mv, MOBA_HEADS), rel_bias)
    o_a = rms_norm(o_a, moba_out_w).transpose(0, 2, 1, 3).reshape(B, S, MOBA_WIDTH)
    log_a = jax.nn.log_sigmoid((ga @ w_alpha + b_alpha).astype(jnp.float32)) / GLA_GATE_TAU
    o_b = gla_chunked(heads(gq, GLA_HEADS) * (GLA_DK ** -0.5), heads(gk, GLA_HEADS),
                      heads(gv, GLA_HEADS), heads(log_a, GLA_HEADS))
    o_b = rms_norm(o_b, gla_out_w).transpose(0, 2, 1, 3).reshape(B, S, GLA_WIDTH)
    o_b = o_b * jax.nn.silu(gg)
    return jnp.concatenate([o_a, o_b], axis=-1) @ w_out


def moe_ffn(h, w_router, e_bias, w1, w3, w2, ws1, ws3, ws2):
    B, S, D = h.shape
    T = B * S
    R = MOE_ROW_BLOCK
    xt = h.reshape(T, D)
    scores = jax.nn.sigmoid((xt @ w_router).astype(jnp.float32))
    choice = scores + e_bias.astype(jnp.float32)
    grp = choice.reshape(T, N_GROUPS, N_EXPERTS // N_GROUPS)
    grp_score = lax.top_k(grp, 2)[0].sum(-1)
    _, grp_idx = lax.top_k(grp_score, TOPK_GROUPS)
    grp_mask = jnp.any(grp_idx[..., None] == jnp.arange(N_GROUPS), axis=1)
    masked = jnp.where(jnp.repeat(grp_mask, N_EXPERTS // N_GROUPS, axis=1), choice, -jnp.inf)
    _, top_idx = lax.top_k(masked, TOP_K)
    top_w = jnp.take_along_axis(scores, top_idx, axis=1)
    top_w = top_w / jnp.sum(top_w, axis=-1, keepdims=True) * ROUTED_SCALE
    TK = T * TOP_K
    e_flat = top_idx.reshape(TK)
    tok_flat = jnp.repeat(jnp.arange(T, dtype=jnp.int32), TOP_K)
    w_flat = top_w.reshape(TK)
    order = jnp.argsort(e_flat)
    e_sorted = e_flat[order]
    counts = jnp.bincount(e_flat, length=N_EXPERTS)
    start = jnp.cumsum(counts) - counts
    padded = (counts + R - 1) // R * R
    pend = jnp.cumsum(padded)
    pstart = pend - padded
    dest = pstart[e_sorted] + (jnp.arange(TK) - start[e_sorted])
    n_rows = (TK + N_EXPERTS * (R - 1) + R - 1) // R * R
    n_blocks = n_rows // R
    row_tok = jnp.zeros((n_rows,), jnp.int32).at[dest].set(tok_flat[order])
    row_w = jnp.zeros((n_rows,), jnp.float32).at[dest].set(w_flat[order])
    blk_expert = jnp.minimum(jnp.searchsorted(pend, jnp.arange(n_blocks) * R, side='right'), N_EXPERTS - 1)

    def run_block(args):
        e, toks = args
        xb = xt[toks]
        return (jax.nn.silu(xb @ w1[e]) * (xb @ w3[e])) @ w2[e]

    rows = lax.map(run_block, (blk_expert, row_tok.reshape(n_blocks, R)))
    rows = rows.reshape(n_rows, D) * row_w[:, None].astype(rows.dtype)
    routed = jax.ops.segment_sum(rows, row_tok, num_segments=T)
    shared = (jax.nn.silu(xt @ ws1) * (xt @ ws3)) @ ws2
    return (shared + routed).reshape(B, S, D)


def setup_inputs(seed: int = 0) -> dict:
    key = jax.random.key(seed)
    ks = jax.random.split(key, 24)
    f32 = jnp.float32
    L = DEPTH

    def nrm(k, shape, scale):
        return jax.random.normal(k, shape, f32) * scale

    return dict(
        x=nrm(ks[0], (BATCH, SEQ, D_MODEL), 1.0),
        c=nrm(ks[1], (BATCH, D_MODEL), 1.0),
        w_ada=nrm(ks[2], (L, D_MODEL, 6 * D_MODEL), 0.5 * D_MODEL ** -0.5),
        b_ada=nrm(ks[3], (L, 6 * D_MODEL), 0.02),
        norm1_w=1.0 + nrm(ks[4], (L, D_MODEL), 0.02),
        norm2_w=1.0 + nrm(ks[5], (L, D_MODEL), 0.02),
        w_in=nrm(ks[6], (L, D_MODEL, D_IN), D_MODEL ** -0.5),
        q_norm_w=1.0 + nrm(ks[7], (L, MOBA_HEAD_DIM), 0.02),
        k_norm_w=1.0 + nrm(ks[8], (L, MOBA_HEAD_DIM), 0.02),
        rel_bias=nrm(ks[9], (REL_BUCKETS, MOBA_HEADS), 0.5),
        w_alpha=nrm(ks[10], (L, GLA_GATE_RANK, GLA_KEY_WIDTH), GLA_GATE_RANK ** -0.5),
        b_alpha=nrm(ks[11], (L, GLA_KEY_WIDTH), 0.1),
        moba_out_w=1.0 + nrm(ks[12], (L, MOBA_HEAD_DIM), 0.02),
        gla_out_w=1.0 + nrm(ks[13], (L, GLA_DV), 0.02),
        w_out=nrm(ks[14], (L, D_MIX, D_MODEL), D_MIX ** -0.5),
        w_router=nrm(ks[15], (L, D_MODEL, N_EXPERTS), D_MODEL ** -0.5),
        e_bias=nrm(ks[16], (L, N_EXPERTS), 0.01),
        w1=nrm(ks[17], (L, N_EXPERTS, D_MODEL, EXPERT_FF), D_MODEL ** -0.5),
        w3=nrm(ks[18], (L, N_EXPERTS, D_MODEL, EXPERT_FF), D_MODEL ** -0.5),
        w2=nrm(ks[19], (L, N_EXPERTS, EXPERT_FF, D_MODEL), EXPERT_FF ** -0.5),
        ws1=nrm(ks[20], (L, D_MODEL, SHARED_FF), D_MODEL ** -0.5),
        ws3=nrm(ks[21], (L, D_MODEL, SHARED_FF), D_MODEL ** -0.5),
        ws2=nrm(ks[22], (L, SHARED_FF, D_MODEL), SHARED_FF ** -0.5),
    )


def reference(x, c, w_ada, b_ada, norm1_w, norm2_w, w_in, q_norm_w, k_norm_w, rel_bias, w_alpha, b_alpha,
              moba_out_w, gla_out_w, w_out, w_router, e_bias, w1, w3, w2, ws1, ws3, ws2):
    for l in range(DEPTH):
        mod = jax.nn.silu(c) @ w_ada[l] + b_ada[l]
        sh1, sc1, g1, sh2, sc2, g2 = jnp.split(mod[:, None, :], 6, axis=-1)
        h = rms_norm(x, norm1_w[l]) * (1.0 + sc1) + sh1
        x = x + g1 * hybrid_mixer(h, w_in[l], q_norm_w[l], k_norm_w[l], rel_bias, w_alpha[l], b_alpha[l],
                                  moba_out_w[l], gla_out_w[l], w_out[l])
        h = rms_norm(x, norm2_w[l]) * (1.0 + sc2) + sh2
        x = x + g2 * moe_ffn(h, w_router[l], e_bias[l], w1[l], w3[l], w2[l], ws1[l], ws3[l], ws2[l])
    return x
```

```cpp
#include <hip/hip_runtime.h>
#include <hip/hip_cooperative_groups.h>
#include <stdint.h>
#include <stdio.h>

#ifndef FUSED
#define FUSED 0
#endif

namespace cg = cooperative_groups;

#define DI __device__ __forceinline__
typedef short bf16x8 __attribute__((ext_vector_type(8)));
typedef float f32x16 __attribute__((ext_vector_type(16)));
typedef float f32x4 __attribute__((ext_vector_type(4)));
typedef unsigned u32x4 __attribute__((ext_vector_type(4)));
typedef unsigned u32x2 __attribute__((ext_vector_type(2)));
typedef __bf16 bf16x2_t __attribute__((ext_vector_type(2)));
typedef float f32x2_t __attribute__((ext_vector_type(2)));
typedef unsigned short u16;

#define MFMA32(a, b, c) __builtin_amdgcn_mfma_f32_32x32x16_bf16((a), (b), (c), 0, 0, 0)

constexpr int Bn = 4, S = 4096, D = 1024, T = Bn * S;
constexpr int DIN = 3088;
constexpr int NE = 256;
constexpr float EPS = 1e-6f;
constexpr float LOG2E = 1.4426950408889634f;
constexpr int LISTCAP = 16384;

constexpr size_t al256(size_t x) { return (x + 255) & ~(size_t)255; }
constexpr size_t OFF_BAR   = 0;
constexpr size_t OFF_CNT   = 16384;
constexpr size_t OFF_KMEAN = 32768;
constexpr size_t ZERO_BYTES = OFF_KMEAN + 4 * 8 * 16 * 64 * 4;
constexpr size_t OFF_MOD   = al256(ZERO_BYTES);
constexpr size_t OFF_WRT   = al256(OFF_MOD + 4 * 6144 * 4);
constexpr size_t OFF_H1B   = al256(OFF_WRT + 256 * 1024 * 2);
constexpr size_t OFF_MQ    = al256(OFF_H1B + (size_t)T * 1024 * 2);
constexpr size_t OFF_MK    = al256(OFF_MQ + (size_t)T * 512 * 2);
constexpr size_t OFF_VT    = al256(OFF_MK + (size_t)T * 512 * 2);
constexpr size_t OFF_GQ    = al256(OFF_VT + (size_t)T * 512 * 2);
constexpr size_t OFF_GK    = al256(OFF_GQ + (size_t)T * 256 * 2);
constexpr size_t OFF_GKT   = al256(OFF_GK + (size_t)T * 256 * 2);
constexpr size_t OFF_GVT   = al256(OFF_GKT + (size_t)T * 256 * 2);
constexpr size_t OFF_SG    = al256(OFF_GVT + (size_t)T * 512 * 2);
constexpr size_t OFF_BC    = al256(OFF_SG + (size_t)T * 512 * 2);
constexpr size_t OFF_BCT   = al256(OFF_BC + (size_t)T * 256 * 4);
constexpr size_t OFF_UT    = al256(OFF_BCT + (size_t)T * 256 * 4);
constexpr size_t OFF_DEC   = al256(OFF_UT + (size_t)16 * 64 * 128 * 64 * 4);
constexpr size_t OFF_ST    = al256(OFF_DEC + (size_t)16 * 64 * 64 * 4);
constexpr size_t OFF_MIX   = al256(OFF_ST + (size_t)16 * 64 * 128 * 64 * 2);
constexpr size_t OFF_X1    = al256(OFF_MIX + (size_t)T * 1024 * 2);
constexpr size_t OFF_H2B   = al256(OFF_X1 + (size_t)T * 1024 * 4);
constexpr size_t OFF_LIST  = al256(OFF_H2B + (size_t)T * 1024 * 2);
constexpr size_t OFF_TOPW  = al256(OFF_LIST + (size_t)256 * LISTCAP * 4);
constexpr size_t OFF_ACT   = al256(OFF_TOPW + (size_t)T * 8 * 4);
constexpr size_t OFF_ACTS  = al256(OFF_ACT + (size_t)T * 8 * 256 * 2);
constexpr size_t OFF_Y     = al256(OFF_ACTS + (size_t)T * 256 * 2);
constexpr size_t WS_END    = al256(OFF_Y + (size_t)T * 8 * 1024 * 2);

constexpr int LDS_C = 128 * 132 * 4;
constexpr int LDS_TBL = LDS_C;
constexpr int LDS_BYTES = LDS_C + 4096;

struct Params {
  const float *x, *c, *w_ada, *b_ada, *norm1_w, *norm2_w, *w_in, *q_norm_w, *k_norm_w, *rel_bias, *w_alpha, *b_alpha,
      *moba_out_w, *gla_out_w, *w_out, *w_router, *e_bias, *w1, *w3, *w2, *ws1, *ws3, *ws2;
  float* out;
  unsigned char* ws;
};

DI unsigned pack2(float a, float b) { f32x2_t v = {a, b}; return __builtin_bit_cast(unsigned, __builtin_convertvector(v, bf16x2_t)); }
DI float bflo(unsigned u) { return __uint_as_float(u << 16); }
DI float bfhi(unsigned u) { return __uint_as_float(u & 0xffff0000u); }
DI int crow(int reg, int h) { return (reg & 3) + 8 * (reg >> 2) + 4 * h; }
DI int swz(int row) { return ((row >> 2) ^ (row >> 1)) & 7; }
DI u32x4 pack8(float a0, float a1, float a2, float a3, float a4, float a5, float a6, float a7) {
  u32x4 r; r[0] = pack2(a0, a1); r[1] = pack2(a2, a3); r[2] = pack2(a4, a5); r[3] = pack2(a6, a7); return r;
}
DI float wave_sum(float v) {
  v += __shfl_xor(v, 32); v += __shfl_xor(v, 16); v += __shfl_xor(v, 8); v += __shfl_xor(v, 4); v += __shfl_xor(v, 2); v += __shfl_xor(v, 1);
  return v;
}
DI float siluf(float x) { return x / (1.f + __expf(-x)); }

struct ALoadBf16 {
  const u16* rp[4];
  u32x4 v[4];
  DI void load(int kt) {
#pragma unroll
    for (int i = 0; i < 4; ++i) v[i] = *(const u32x4*)(rp[i] + kt * 64);
  }
  DI void store(char* sA, int tid) {
    const int c = tid & 7, row = tid >> 3;
    const int off = ((c ^ swz(row)) << 4);
#pragma unroll
    for (int i = 0; i < 4; ++i) *(u32x4*)(sA + (row + 32 * i) * 128 + off) = v[i];
  }
};

struct BLoadF32 {
  const float* p;
  size_t ldb;
  bool valid;
  f32x4 v[8];
  DI void load(int kt) {
    const float* q = p + (size_t)kt * 64 * ldb;
#pragma unroll
    for (int i = 0; i < 8; ++i) {
      if (valid) v[i] = *(const f32x4*)(q + (size_t)i * ldb);
      else { v[i][0] = 0.f; v[i][1] = 0.f; v[i][2] = 0.f; v[i][3] = 0.f; }
    }
  }
  DI void store(char* sB, int tid) {
    const int n4 = (tid & 31) * 4, kg = tid >> 5;
#pragma unroll
    for (int j = 0; j < 4; ++j) {
      const int n = n4 + j;
      u32x4 w = pack8(v[0][j], v[1][j], v[2][j], v[3][j], v[4][j], v[5][j], v[6][j], v[7][j]);
      *(u32x4*)(sB + n * 128 + ((kg ^ swz(n)) << 4)) = w;
    }
  }
};

DI void mma_step(const char* sA, const char* sB, f32x16 (&acc)[2][2], int lane, int wm, int wn) {
  const int r = lane & 31, h = lane >> 5, f = swz(r);
  const char* a0 = sA + (wm * 64 + r) * 128;
  const char* b0 = sB + (wn * 64 + r) * 128;
#pragma unroll
  for (int kk = 0; kk < 4; ++kk) {
    const int off = (((kk * 2 + h) ^ f) << 4);
    const bf16x8 fa0 = *(const bf16x8*)(a0 + off);
    const bf16x8 fa1 = *(const bf16x8*)(a0 + 32 * 128 + off);
    const bf16x8 fb0 = *(const bf16x8*)(b0 + off);
    const bf16x8 fb1 = *(const bf16x8*)(b0 + 32 * 128 + off);
    acc[0][0] = MFMA32(fa0, fb0, acc[0][0]);
    acc[0][1] = MFMA32(fa0, fb1, acc[0][1]);
    acc[1][0] = MFMA32(fa1, fb0, acc[1][0]);
    acc[1][1] = MFMA32(fa1, fb1, acc[1][1]);
  }
}

template <class AL, class BL>
DI void gemm_mainloop(AL& al, BL& bl, int nk, char* smem, f32x16 (&acc)[2][2]) {
  const int tid = threadIdx.x, lane = tid & 63, w = tid >> 6, wm = w >> 1, wn = w & 1;
#pragma unroll
  for (int i = 0; i < 2; ++i)
#pragma unroll
    for (int j = 0; j < 2; ++j)
#pragma unroll
      for (int r = 0; r < 16; ++r) acc[i][j][r] = 0.f;
  __syncthreads();
  al.load(0); bl.load(0);
  al.store(smem, tid); bl.store(smem + 16384, tid);
  __syncthreads();
  for (int kt = 0; kt < nk; ++kt) {
    const int cur = kt & 1;
    const bool more = (kt + 1 < nk);
    if (more) { al.load(kt + 1); bl.load(kt + 1); }
    mma_step(smem + cur * 32768, smem + cur * 32768 + 16384, acc, lane, wm, wn);
    if (more) { al.store(smem + (cur ^ 1) * 32768, tid); bl.store(smem + (cur ^ 1) * 32768 + 16384, tid); }
    __syncthreads();
  }
}

DI void stage_nat(float* cs, const f32x16 (&acc)[2][2]) {
  const int lane = threadIdx.x & 63, w = threadIdx.x >> 6, wm = w >> 1, wn = w & 1, r = lane & 31, h = lane >> 5;
#pragma unroll
  for (int mt = 0; mt < 2; ++mt)
#pragma unroll
    for (int nt = 0; nt < 2; ++nt)
#pragma unroll
      for (int g = 0; g < 16; ++g) cs[(wm * 64 + mt * 32 + crow(g, h)) * 132 + wn * 64 + nt * 32 + r] = acc[mt][nt][g];
}
DI void stage_tr(float* cs, const f32x16 (&acc)[2][2]) {
  const int lane = threadIdx.x & 63, w = threadIdx.x >> 6, wm = w >> 1, wn = w & 1, r = lane & 31, h = lane >> 5;
#pragma unroll
  for (int mt = 0; mt < 2; ++mt)
#pragma unroll
    for (int nt = 0; nt < 2; ++nt)
#pragma unroll
      for (int g = 0; g < 4; ++g) {
        f32x4 v = {acc[mt][nt][4 * g], acc[mt][nt][4 * g + 1], acc[mt][nt][4 * g + 2], acc[mt][nt][4 * g + 3]};
        *(f32x4*)(cs + (wn * 64 + nt * 32 + r) * 132 + wm * 64 + mt * 32 + 8 * g + 4 * h) = v;
      }
}

DI void phase0(const Params& p, char* smem) {
  const int tid = threadIdx.x, lane = tid & 63, w = tid >> 6;
  float* mod = (float*)(p.ws + OFF_MOD);
  float* sil = (float*)smem;
  float* red = sil + 4096;
  for (int task = blockIdx.x; task < 96; task += gridDim.x) {
    __syncthreads();
    for (int i = tid; i < 4096; i += 256) sil[i] = siluf(p.c[i]);
    __syncthreads();
    const int col = task * 64 + lane;
    float a0 = 0.f, a1 = 0.f, a2 = 0.f, a3 = 0.f;
    const float* wp = p.w_ada + (size_t)(w * 256) * 6144 + col;
#pragma unroll 8
    for (int k = 0; k < 256; ++k) {
      const float wv = wp[(size_t)k * 6144];
      const int kk = w * 256 + k;
      a0 += sil[kk] * wv; a1 += sil[1024 + kk] * wv; a2 += sil[2048 + kk] * wv; a3 += sil[3072 + kk] * wv;
    }
    red[(w * 4 + 0) * 64 + lane] = a0; red[(w * 4 + 1) * 64 + lane] = a1; red[(w * 4 + 2) * 64 + lane] = a2; red[(w * 4 + 3) * 64 + lane] = a3;
    __syncthreads();
    {
      const int b = w;
      float s = red[(0 * 4 + b) * 64 + lane] + red[(1 * 4 + b) * 64 + lane] + red[(2 * 4 + b) * 64 + lane] + red[(3 * 4 + b) * 64 + lane];
      mod[b * 6144 + col] = s + p.b_ada[col];
    }
  }
  u16* wrT = (u16*)(p.ws + OFF_WRT);
  for (int i = blockIdx.x * 256 + tid; i < 256 * 128; i += gridDim.x * 256) {
    const int n = i & 255, k8 = (i >> 8) * 8;
    float v[8];
#pragma unroll
    for (int j = 0; j < 8; ++j) v[j] = p.w_router[(size_t)(k8 + j) * 256 + n];
    *(u32x4*)(wrT + (size_t)n * 1024 + k8) = pack8(v[0], v[1], v[2], v[3], v[4], v[5], v[6], v[7]);
  }
}

DI void phase1(const Params& p) {
  const int tid = threadIdx.x, lane = tid & 63, w = tid >> 6;
  const float* mod = (const float*)(p.ws + OFF_MOD);
  u16* h1b = (u16*)(p.ws + OFF_H1B);
  const int nW = gridDim.x * 4;
  for (int t = blockIdx.x * 4 + w; t < T; t += nW) {
    const int b = t >> 12;
    f32x4 xv[4]; float ssq = 0.f;
#pragma unroll
    for (int i = 0; i < 4; ++i) {
      xv[i] = *(const f32x4*)(p.x + (size_t)t * 1024 + i * 256 + lane * 4);
      ssq += xv[i][0] * xv[i][0] + xv[i][1] * xv[i][1] + xv[i][2] * xv[i][2] + xv[i][3] * xv[i][3];
    }
    ssq = wave_sum(ssq);
    const float r = rsqrtf(ssq * (1.f / 1024.f) + EPS);
#pragma unroll
    for (int i = 0; i < 4; ++i) {
      const int k = i * 256 + lane * 4;
      const f32x4 nw = *(const f32x4*)(p.norm1_w + k);
      const f32x4 sc = *(const f32x4*)(mod + b * 6144 + 1024 + k);
      const f32x4 sh = *(const f32x4*)(mod + b * 6144 + k);
      float o[4];
#pragma unroll
      for (int j = 0; j < 4; ++j) o[j] = xv[i][j] * r * nw[j] * (1.f + sc[j]) + sh[j];
      u32x2 pk = {pack2(o[0], o[1]), pack2(o[2], o[3])};
      *(u32x2*)(h1b + (size_t)t * 1024 + k) = pk;
    }
  }
}

DI float logsig(float z) { return fminf(z, 0.f) - log1pf(__expf(-fabsf(z))); }

DI void phase2(const Params& p, char* smem) {
  const int tid = threadIdx.x, lane = tid & 63;
  const int g = blockIdx.x & 7, j = blockIdx.x >> 3, nj = gridDim.x >> 3;
  const u16* h1b = (const u16*)(p.ws + OFF_H1B);
  float* cs = (float*)smem;
  for (int id = j; id < 400; id += nj) {
    int mtile, ntile;
    if (id < 384) { mtile = id / 3; ntile = 3 * g + id % 3; } else { ntile = 24; mtile = 16 * g + (id - 384); }
    const int row0 = mtile * 128, b = row0 >> 12, s0 = row0 & 4095;
    ALoadBf16 al; BLoadF32 bl;
#pragma unroll
    for (int i = 0; i < 4; ++i) al.rp[i] = h1b + (size_t)(row0 + (tid >> 3) + 32 * i) * 1024 + (tid & 7) * 8;
    {
      const int n4 = (tid & 31) * 4, kg = tid >> 5;
      const int col = ntile * 128 + n4;
      bl.valid = (col < DIN);
      bl.ldb = DIN;
      bl.p = p.w_in + (size_t)(kg * 8) * DIN + (bl.valid ? col : 0);
    }
    f32x16 acc[2][2];
    gemm_mainloop(al, bl, 16, smem, acc);
    if (ntile < 8 || (ntile >= 12 && ntile < 16) || (ntile >= 20 && ntile < 24)) {
      stage_nat(cs, acc);
      __syncthreads();
      float ksum[8];
#pragma unroll
      for (int q = 0; q < 8; ++q) ksum[q] = 0.f;
#pragma unroll 1
      for (int it = 0; it < 8; ++it) {
        const int i = it * 256 + tid, row = i >> 4, c8 = (i & 15) * 8;
        const f32x4 va = *(const f32x4*)(cs + row * 132 + c8), vb = *(const f32x4*)(cs + row * 132 + c8 + 4);
        float v[8] = {va[0], va[1], va[2], va[3], vb[0], vb[1], vb[2], vb[3]};
        const int d0 = c8 & 63;
        if (ntile < 8) {
          float ssq = 0.f;
#pragma unroll
          for (int q = 0; q < 8; ++q) ssq += v[q] * v[q];
          ssq += __shfl_xor(ssq, 1); ssq += __shfl_xor(ssq, 2); ssq += __shfl_xor(ssq, 4);
          const float sc = rsqrtf(ssq * (1.f / 64.f) + EPS);
          const float* nw = (ntile < 4) ? p.q_norm_w : p.k_norm_w;
#pragma unroll
          for (int q = 0; q < 8; ++q) v[q] = v[q] * sc * nw[d0 + q];
          const int hd = (ntile & 3) * 2 + (c8 >> 6);
          u16* dst = (u16*)(p.ws + (ntile < 4 ? OFF_MQ : OFF_MK)) + ((size_t)(b * 8 + hd) * S + s0 + row) * 64 + d0;
          *(u32x4*)dst = pack8(v[0], v[1], v[2], v[3], v[4], v[5], v[6], v[7]);
          if (ntile >= 4) {
#pragma unroll
            for (int q = 0; q < 8; ++q) ksum[q] += v[q];
          }
        } else if (ntile < 16) {
          const int hd = (ntile & 1) * 2 + (c8 >> 6);
          if (ntile < 14) {
#pragma unroll
            for (int q = 0; q < 8; ++q) v[q] *= 0.125f;
          }
          u16* dst = (u16*)(p.ws + (ntile < 14 ? OFF_GQ : OFF_GK)) + ((size_t)(b * 4 + hd) * S + s0 + row) * 64 + d0;
          *(u32x4*)dst = pack8(v[0], v[1], v[2], v[3], v[4], v[5], v[6], v[7]);
        } else {
#pragma unroll
          for (int q = 0; q < 8; ++q) v[q] = siluf(v[q]);
          u16* dst = (u16*)(p.ws + OFF_SG) + (size_t)(row0 + row) * 512 + (ntile - 20) * 128 + c8;
          *(u32x4*)dst = pack8(v[0], v[1], v[2], v[3], v[4], v[5], v[6], v[7]);
        }
      }
      if (ntile >= 4 && ntile < 8) {
        __syncthreads();
        const int c8 = (tid & 15) * 8;
#pragma unroll
        for (int q = 0; q < 8; ++q) cs[(tid >> 4) * 128 + c8 + q] = ksum[q];
        __syncthreads();
        if (tid < 128) {
          float s = 0.f;
#pragma unroll
          for (int q = 0; q < 16; ++q) s += cs[q * 128 + tid];
          const int hd = (ntile - 4) * 2 + (tid >> 6);
          float* km = (float*)(p.ws + OFF_KMEAN);
          atomicAdd(&km[((size_t)(b * 8 + hd) * 16 + (s0 >> 8)) * 64 + (tid & 63)], s * (1.f / 256.f));
        }
      }
      if (ntile == 14 || ntile == 15) __syncthreads();
    }
    if ((ntile >= 8 && ntile < 12) || (ntile >= 14 && ntile < 20)) {
      stage_tr(cs, acc);
      __syncthreads();
#pragma unroll 1
      for (int it = 0; it < 8; ++it) {
        const int i = it * 256 + tid, col = i >> 4, r8 = (i & 15) * 8;
        const f32x4 va = *(const f32x4*)(cs + col * 132 + r8), vb = *(const f32x4*)(cs + col * 132 + r8 + 4);
        u16* dst;
        if (ntile < 12)      dst = (u16*)(p.ws + OFF_VT) + ((size_t)(b * 8 + (ntile - 8) * 2 + (col >> 6)) * 64 + (col & 63)) * S + s0 + r8;
        else if (ntile < 16) dst = (u16*)(p.ws + OFF_GKT) + ((size_t)(b * 4 + (ntile - 14) * 2 + (col >> 6)) * 64 + (col & 63)) * S + s0 + r8;
        else                 dst = (u16*)(p.ws + OFF_GVT) + ((size_t)(b * 4 + (ntile - 16)) * 128 + col) * S + s0 + r8;
        *(u32x4*)dst = pack8(va[0], va[1], va[2], va[3], vb[0], vb[1], vb[2], vb[3]);
      }
    }
    if (ntile == 24) {
      stage_nat(cs, acc);
      __syncthreads();
      float wa[16];
#pragma unroll
      for (int q = 0; q < 16; ++q) wa[q] = p.w_alpha[q * 256 + tid];
      const float ba = p.b_alpha[tid];
      const int hd = tid >> 6, d = tid & 63;
      float* bc = (float*)(p.ws + OFF_BC) + ((size_t)(b * 4 + hd) * S + s0) * 64 + d;
      float* bct = (float*)(p.ws + OFF_BCT) + ((size_t)(b * 4 + hd) * 64 + d) * S + s0;
#pragma unroll 1
      for (int ch = 0; ch < 2; ++ch) {
        float cum = 0.f;
#pragma unroll 1
        for (int r4 = 0; r4 < 16; ++r4) {
          f32x4 o;
#pragma unroll
          for (int q4 = 0; q4 < 4; ++q4) {
            const int row = ch * 64 + r4 * 4 + q4;
            float z = ba;
#pragma unroll
            for (int q = 0; q < 16; ++q) z += cs[row * 132 + q] * wa[q];
            cum += logsig(z) * (1.f / 16.f);
            bc[(size_t)row * 64] = cum;
            o[q4] = cum;
          }
          *(f32x4*)(bct + ch * 64 + r4 * 4) = o;
        }
      }
    }
  }
}

DI int t5_bucket(int rel) {
  if (rel < 16) return rel;
  int bkt = 16;
  bkt += (rel >= 19); bkt += (rel >= 21); bkt += (rel >= 24); bkt += (rel >= 27); bkt += (rel >= 31); bkt += (rel >= 35); bkt += (rel >= 40);
  bkt += (rel >= 46); bkt += (rel >= 52); bkt += (rel >= 59); bkt += (rel >= 67); bkt += (rel >= 77); bkt += (rel >= 87); bkt += (rel >= 99); bkt += (rel >= 113);
  return bkt;
}

struct MobaState { f32x16 o0, o1; float m, l; };

template <int MODE>
DI void moba_subtile(MobaState& st, const bf16x8 (&qf)[4], const u16* kbase, const u16* vbase, int kpos0, int qpos, bool sel,
                     const float* lut, float cb31, int r, int h5) {
  const float NEG = -__builtin_inff();
  f32x16 s;
#pragma unroll
  for (int i = 0; i < 16; ++i) s[i] = 0.f;
  const u16* kp = kbase + (size_t)(kpos0 + r) * 64 + h5 * 8;
#pragma unroll
  for (int ks = 0; ks < 4; ++ks) s = MFMA32(*(const bf16x8*)(kp + ks * 16), qf[ks], s);
  const float c1 = 0.125f * LOG2E;
  float t[16]; float tm = NEG;
#pragma unroll
  for (int i = 0; i < 16; ++i) {
    float tv;
    if (MODE == 0) tv = s[i] * c1 + cb31;
    else {
      const int rel = qpos - (kpos0 + crow(i, h5));
      const float bias = (rel >= 128) ? cb31 : lut[rel < 0 ? 0 : rel];
      tv = s[i] * c1 + bias;
      if (MODE == 2 && rel < 0) tv = NEG;
    }
    if (!sel) tv = NEG;
    t[i] = tv; tm = fmaxf(tm, tv);
  }
  tm = fmaxf(tm, __shfl_xor(tm, 32));
  const float mn = fmaxf(st.m, tm);
  const float mu = (mn == NEG) ? 0.f : mn;
  const float alpha = exp2f(st.m - mu);
  float psum = 0.f;
#pragma unroll
  for (int i = 0; i < 16; ++i) { t[i] = exp2f(t[i] - mu); psum += t[i]; }
  st.l = st.l * alpha + psum; st.m = mn;
#pragma unroll
  for (int i = 0; i < 16; ++i) { st.o0[i] *= alpha; st.o1[i] *= alpha; }
  const bf16x8 pf0 = __builtin_bit_cast(bf16x8, pack8(t[0], t[1], t[2], t[3], t[4], t[5], t[6], t[7]));
  const bf16x8 pf1 = __builtin_bit_cast(bf16x8, pack8(t[8], t[9], t[10], t[11], t[12], t[13], t[14], t[15]));
#pragma unroll
  for (int s2 = 0; s2 < 2; ++s2) {
#pragma unroll
    for (int dt = 0; dt < 2; ++dt) {
      const u16* vp = vbase + (size_t)(dt * 32 + r) * S + kpos0 + 16 * s2 + 4 * h5;
      const u32x2 lo = *(const u32x2*)vp, hi = *(const u32x2*)(vp + 8);
      u32x4 vv = {lo[0], lo[1], hi[0], hi[1]};
      const bf16x8 vf = __builtin_bit_cast(bf16x8, vv);
      if (dt == 0) st.o0 = MFMA32(vf, s2 ? pf1 : pf0, st.o0); else st.o1 = MFMA32(vf, s2 ? pf1 : pf0, st.o1);
    }
  }
}

DI void phase_moba(const Params& p, char* smem, int task_lo, int task_hi) {
  const int tid = threadIdx.x, lane = tid & 63, w = tid >> 6, r = lane & 31, h5 = lane >> 5;
  float* lut = (float*)smem;
  const float NEG = -__builtin_inff();
  const u16* mq = (const u16*)(p.ws + OFF_MQ);
  const u16* mk = (const u16*)(p.ws + OFF_MK);
  const u16* vT = (const u16*)(p.ws + OFF_VT);
  const float* kmean = (const float*)(p.ws + OFF_KMEAN);
  u16* mix = (u16*)(p.ws + OFF_MIX);
  for (int task = task_lo + blockIdx.x; task < task_hi; task += gridDim.x) {
    const int blk = 15 - (task >> 6), rem = task & 63, bh = rem >> 1, half = rem & 1, hd = bh & 7, b = bh >> 3;
    __syncthreads();
    if (tid < 128) lut[tid] = p.rel_bias[t5_bucket(tid) * 8 + hd] * LOG2E;
    __syncthreads();
    const float cb31 = p.rel_bias[31 * 8 + hd] * LOG2E;
    const int qpos = blk * 256 + half * 128 + w * 32 + r;
    const u16* qptr = mq + ((size_t)bh * S + qpos) * 64 + h5 * 8;
    bf16x8 qf[4];
#pragma unroll
    for (int ks = 0; ks < 4; ++ks) qf[ks] = *(const bf16x8*)(qptr + ks * 16);
    unsigned selmask = 0;
    if (blk > 0) {
      f32x16 g;
#pragma unroll
      for (int i = 0; i < 16; ++i) g[i] = 0.f;
      const int n = r < 15 ? r : 15;
      const float* kmp = kmean + ((size_t)bh * 16 + n) * 64 + h5 * 8;
#pragma unroll
      for (int ks = 0; ks < 4; ++ks) {
        const f32x4 v0 = *(const f32x4*)(kmp + ks * 16), v1 = *(const f32x4*)(kmp + ks * 16 + 4);
        const u32x4 hi = pack8(v0[0], v0[1], v0[2], v0[3], v1[0], v1[1], v1[2], v1[3]);
        const u32x4 lo = pack8(v0[0] - bflo(hi[0]), v0[1] - bfhi(hi[0]), v0[2] - bflo(hi[1]), v0[3] - bfhi(hi[1]),
                               v1[0] - bflo(hi[2]), v1[1] - bfhi(hi[2]), v1[2] - bflo(hi[3]), v1[3] - bfhi(hi[3]));
        g = MFMA32(__builtin_bit_cast(bf16x8, hi), qf[ks], g);
        g = MFMA32(__builtin_bit_cast(bf16x8, lo), qf[ks], g);
      }
      float gt[16];
#pragma unroll
      for (int nn = 0; nn < 16; ++nn) {
        const int x = (nn >> 2) & 1, rr = (nn & 3) + 4 * (nn >> 3);
        const float own = g[rr];
        const float par = __shfl_xor(own, 32);
        gt[nn] = (h5 == x) ? own : par;
      }
#pragma unroll
      for (int it = 0; it < 3; ++it) {
        float best = NEG; int bi = -1;
#pragma unroll
        for (int nn = 0; nn < 16; ++nn) {
          const bool ok = (nn < blk) && !((selmask >> nn) & 1u);
          if (ok && gt[nn] > best) { best = gt[nn]; bi = nn; }
        }
        if (bi >= 0) selmask |= 1u << bi;
      }
    }
    unsigned umask = 0;
    for (int nn = 0; nn < blk; ++nn) if (__any((int)((selmask >> nn) & 1u))) umask |= 1u << nn;
    MobaState st;
#pragma unroll
    for (int i = 0; i < 16; ++i) { st.o0[i] = 0.f; st.o1[i] = 0.f; }
    st.m = NEG; st.l = 0.f;
    const u16* kbase = mk + (size_t)bh * S * 64;
    const u16* vbase = vT + (size_t)bh * 64 * S;
    for (int nn = 0; nn < blk; ++nn) {
      if (!((umask >> nn) & 1u)) continue;
      const bool sel = (selmask >> nn) & 1u;
      if (nn == blk - 1) {
        for (int kt = 0; kt < 8; ++kt) moba_subtile<1>(st, qf, kbase, vbase, nn * 256 + kt * 32, qpos, sel, lut, cb31, r, h5);
      } else {
        for (int kt = 0; kt < 8; ++kt) moba_subtile<0>(st, qf, kbase, vbase, nn * 256 + kt * 32, qpos, sel, lut, cb31, r, h5);
      }
    }
    const int ktmax = half * 4 + w;
    for (int kt = 0; kt <= ktmax; ++kt) moba_subtile<2>(st, qf, kbase, vbase, blk * 256 + kt * 32, qpos, true, lut, cb31, r, h5);
    float l = st.l + __shfl_xor(st.l, 32);
    const float inv = 1.f / l;
    float ssq = 0.f;
#pragma unroll
    for (int i = 0; i < 16; ++i) { st.o0[i] *= inv; st.o1[i] *= inv; ssq += st.o0[i] * st.o0[i] + st.o1[i] * st.o1[i]; }
    ssq += __shfl_xor(ssq, 32);
    const float rs = rsqrtf(ssq * (1.f / 64.f) + EPS);
    u16* op = mix + (size_t)(b * S + qpos) * 1024 + hd * 64;
#pragma unroll
    for (int dt = 0; dt < 2; ++dt)
#pragma unroll
      for (int g4 = 0; g4 < 4; ++g4) {
        const int d0 = dt * 32 + 8 * g4 + 4 * h5;
        const f32x4 mw = *(const f32x4*)(p.moba_out_w + d0);
        float o[4];
#pragma unroll
        for (int q = 0; q < 4; ++q) o[q] = (dt ? st.o1[4 * g4 + q] : st.o0[4 * g4 + q]) * rs * mw[q];
        u32x2 pk = {pack2(o[0], o[1]), pack2(o[2], o[3])};
        *(u32x2*)(op + d0) = pk;
      }
  }
}

DI void phase_gla_a(const Params& p) {
  const int tid = threadIdx.x, lane = tid & 63, w = tid >> 6, r = lane & 31, h5 = lane >> 5;
  const u16* gkT = (const u16*)(p.ws + OFF_GKT);
  const u16* gvT = (const u16*)(p.ws + OFF_GVT);
  const float* bcT = (const float*)(p.ws + OFF_BCT);
  float* UT = (float*)(p.ws + OFF_UT);
  float* dec = (float*)(p.ws + OFF_DEC);
  for (int task = blockIdx.x; task < 1024; task += gridDim.x) {
    const int bh = task >> 6, c = task & 63;
    f32x16 acc[2];
#pragma unroll
    for (int i = 0; i < 16; ++i) { acc[0][i] = 0.f; acc[1][i] = 0.f; }
    const u16* vp = gvT + ((size_t)bh * 128 + w * 32 + r) * S + c * 64 + h5 * 8;
#pragma unroll
    for (int dt = 0; dt < 2; ++dt) {
      const int d = dt * 32 + r;
      const float* bp = bcT + ((size_t)bh * 64 + d) * S + c * 64;
      const u16* kp = gkT + ((size_t)bh * 64 + d) * S + c * 64;
      const float bl = bp[63];
      if (w == 0 && h5 == 0) dec[((size_t)bh * 64 + c) * 64 + d] = __expf(bl);
#pragma unroll
      for (int ks = 0; ks < 4; ++ks) {
        const u32x4 kk = *(const u32x4*)(kp + ks * 16 + h5 * 8);
        const f32x4 b0 = *(const f32x4*)(bp + ks * 16 + h5 * 8), b1 = *(const f32x4*)(bp + ks * 16 + h5 * 8 + 4);
        const u32x4 kh = pack8(bflo(kk[0]) * __expf(bl - b0[0]), bfhi(kk[0]) * __expf(bl - b0[1]), bflo(kk[1]) * __expf(bl - b0[2]), bfhi(kk[1]) * __expf(bl - b0[3]),
                               bflo(kk[2]) * __expf(bl - b1[0]), bfhi(kk[2]) * __expf(bl - b1[1]), bflo(kk[3]) * __expf(bl - b1[2]), bfhi(kk[3]) * __expf(bl - b1[3]));
        const bf16x8 vf = *(const bf16x8*)(vp + ks * 16);
        acc[dt] = MFMA32(vf, __builtin_bit_cast(bf16x8, kh), acc[dt]);
      }
    }
    float* up = UT + ((size_t)bh * 64 + c) * 128 * 64;
#pragma unroll
    for (int dt = 0; dt < 2; ++dt)
#pragma unroll
      for (int i = 0; i < 16; ++i) up[(size_t)(w * 32 + crow(i, h5)) * 64 + dt * 32 + r] = acc[dt][i];
  }
}

DI void phase_gla_b(const Params& p) {
  const float* UT = (const float*)(p.ws + OFF_UT);
  const float* dec = (const float*)(p.ws + OFF_DEC);
  u16* ST = (u16*)(p.ws + OFF_ST);
  for (int i = blockIdx.x * 256 + threadIdx.x; i < 16 * 128 * 16; i += gridDim.x * 256) {
    const int d4 = (i & 15) * 4, v = (i >> 4) & 127, bh = i >> 11;
    f32x4 st = {0.f, 0.f, 0.f, 0.f};
#pragma unroll 8
    for (int c = 0; c < 64; ++c) {
      const size_t o = (((size_t)bh * 64 + c) * 128 + v) * 64 + d4;
      const f32x4 u = *(const f32x4*)(UT + o);
      const f32x4 a = *(const f32x4*)(dec + ((size_t)bh * 64 + c) * 64 + d4);
      u32x2 pk = {pack2(st[0], st[1]), pack2(st[2], st[3])};
      *(u32x2*)(ST + o) = pk;
      st[0] = a[0] * st[0] + u[0]; st[1] = a[1] * st[1] + u[1]; st[2] = a[2] * st[2] + u[2]; st[3] = a[3] * st[3] + u[3];
    }
  }
}

DI void phase_gla_c(const Params& p) {
  const int tid = threadIdx.x, lane = tid & 63, w = tid >> 6, r = lane & 31, h5 = lane >> 5;
  const u16* gq = (const u16*)(p.ws + OFF_GQ);
  const u16* gk = (const u16*)(p.ws + OFF_GK);
  const u16* gvT = (const u16*)(p.ws + OFF_GVT);
  const float* bc = (const float*)(p.ws + OFF_BC);
  const u16* ST = (const u16*)(p.ws + OFF_ST);
  const u16* sg = (const u16*)(p.ws + OFF_SG);
  u16* mix = (u16*)(p.ws + OFF_MIX);
  for (int task = blockIdx.x; task < 512; task += gridDim.x) {
    const int bh = task >> 5, c = (task & 31) * 2 + (w >> 1), ih = w & 1, b = bh >> 2, hd = bh & 3;
    const int tpos = c * 64 + ih * 32 + r;
    bf16x8 qt[4];
    {
      const u16* qp = gq + ((size_t)bh * S + tpos) * 64 + h5 * 8;
      const float* bp = bc + ((size_t)bh * S + tpos) * 64 + h5 * 8;
#pragma unroll
      for (int ks = 0; ks < 4; ++ks) {
        const u32x4 qq = *(const u32x4*)(qp + ks * 16);
        const f32x4 b0 = *(const f32x4*)(bp + ks * 16), b1 = *(const f32x4*)(bp + ks * 16 + 4);
        qt[ks] = __builtin_bit_cast(bf16x8, pack8(bflo(qq[0]) * __expf(b0[0]), bfhi(qq[0]) * __expf(b0[1]), bflo(qq[1]) * __expf(b0[2]), bfhi(qq[1]) * __expf(b0[3]),
                                                 bflo(qq[2]) * __expf(b1[0]), bfhi(qq[2]) * __expf(b1[1]), bflo(qq[3]) * __expf(b1[2]), bfhi(qq[3]) * __expf(b1[3])));
      }
    }
    f32x16 oacc[4];
#pragma unroll
    for (int vt = 0; vt < 4; ++vt)
#pragma unroll
      for (int i = 0; i < 16; ++i) oacc[vt][i] = 0.f;
#pragma unroll
    for (int jt = 0; jt < 2; ++jt) {
      if (jt <= ih) {
        f32x16 X;
#pragma unroll
        for (int i = 0; i < 16; ++i) X[i] = 0.f;
        const int jpos = c * 64 + jt * 32 + r;
        const u16* kp = gk + ((size_t)bh * S + jpos) * 64 + h5 * 8;
        const float* bp = bc + ((size_t)bh * S + jpos) * 64 + h5 * 8;
#pragma unroll
        for (int ks = 0; ks < 4; ++ks) {
          const u32x4 kk = *(const u32x4*)(kp + ks * 16);
          const f32x4 b0 = *(const f32x4*)(bp + ks * 16), b1 = *(const f32x4*)(bp + ks * 16 + 4);
          const u32x4 kt = pack8(bflo(kk[0]) * __expf(-b0[0]), bfhi(kk[0]) * __expf(-b0[1]), bflo(kk[1]) * __expf(-b0[2]), bfhi(kk[1]) * __expf(-b0[3]),
                                 bflo(kk[2]) * __expf(-b1[0]), bfhi(kk[2]) * __expf(-b1[1]), bflo(kk[3]) * __expf(-b1[2]), bfhi(kk[3]) * __expf(-b1[3]));
          X = MFMA32(__builtin_bit_cast(bf16x8, kt), qt[ks], X);
        }
        if (jt == ih) {
#pragma unroll
          for (int i = 0; i < 16; ++i) if (crow(i, h5) > r) X[i] = 0.f;
        }
        const bf16x8 pf0 = __builtin_bit_cast(bf16x8, pack8(X[0], X[1], X[2], X[3], X[4], X[5], X[6], X[7]));
        const bf16x8 pf1 = __builtin_bit_cast(bf16x8, pack8(X[8], X[9], X[10], X[11], X[12], X[13], X[14], X[15]));
#pragma unroll
        for (int vt = 0; vt < 4; ++vt) {
#pragma unroll
          for (int s2 = 0; s2 < 2; ++s2) {
            const u16* vp = gvT + ((size_t)bh * 128 + vt * 32 + r) * S + c * 64 + jt * 32 + 16 * s2 + 4 * h5;
            const u32x2 lo = *(const u32x2*)vp, hi = *(const u32x2*)(vp + 8);
            u32x4 vv = {lo[0], lo[1], hi[0], hi[1]};
            oacc[vt] = MFMA32(__builtin_bit_cast(bf16x8, vv), s2 ? pf1 : pf0, oacc[vt]);
          }
        }
      }
    }
    {
      const u16* sp = ST + (((size_t)bh * 64 + c) * 128 + r) * 64 + h5 * 8;
#pragma unroll
      for (int vt = 0; vt < 4; ++vt)
#pragma unroll
        for (int ks = 0; ks < 4; ++ks) oacc[vt] = MFMA32(*(const bf16x8*)(sp + (size_t)vt * 32 * 64 + ks * 16), qt[ks], oacc[vt]);
    }
    float ssq = 0.f;
#pragma unroll
    for (int vt = 0; vt < 4; ++vt)
#pragma unroll
      for (int i = 0; i < 16; ++i) ssq += oacc[vt][i] * oacc[vt][i];
    ssq += __shfl_xor(ssq, 32);
    const float rs = rsqrtf(ssq * (1.f / 128.f) + EPS);
    const size_t t = (size_t)b * S + tpos;
    const u16* sgp = sg + t * 512 + hd * 128;
    u16* op = mix + t * 1024 + 512 + hd * 128;
#pragma unroll
    for (int vt = 0; vt < 4; ++vt)
#pragma unroll
      for (int g4 = 0; g4 < 4; ++g4) {
        const int v0 = vt * 32 + 8 * g4 + 4 * h5;
        const f32x4 gw = *(const f32x4*)(p.gla_out_w + v0);
        const u32x2 sv = *(const u32x2*)(sgp + v0);
        const float o0 = oacc[vt][4 * g4 + 0] * rs * gw[0] * bflo(sv[0]);
        const float o1 = oacc[vt][4 * g4 + 1] * rs * gw[1] * bfhi(sv[0]);
        const float o2 = oacc[vt][4 * g4 + 2] * rs * gw[2] * bflo(sv[1]);
        const float o3 = oacc[vt][4 * g4 + 3] * rs * gw[3] * bfhi(sv[1]);
        u32x2 pk = {pack2(o0, o1), pack2(o2, o3)};
        *(u32x2*)(op + v0) = pk;
      }
  }
}

DI void phase6(const Params& p, char* smem) {
  const int tid = threadIdx.x, lane = tid & 63, w = tid >> 6, wm = w >> 1, wn = w & 1, r = lane & 31, h5 = lane >> 5;
  const int g = blockIdx.x & 7, j = blockIdx.x >> 3, nj = gridDim.x >> 3;
  const u16* mix = (const u16*)(p.ws + OFF_MIX);
  const float* mod = (const float*)(p.ws + OFF_MOD);
  float* x1 = (float*)(p.ws + OFF_X1);
  for (int mtile = j; mtile < 128; mtile += nj) {
    const int ntile = g, row0 = mtile * 128, b = row0 >> 12;
    ALoadBf16 al; BLoadF32 bl;
#pragma unroll
    for (int i = 0; i < 4; ++i) al.rp[i] = mix + (size_t)(row0 + (tid >> 3) + 32 * i) * 1024 + (tid & 7) * 8;
    bl.valid = true; bl.ldb = 1024;
    bl.p = p.w_out + (size_t)((tid >> 5) * 8) * 1024 + ntile * 128 + (tid & 31) * 4;
    f32x16 acc[2][2];
    gemm_mainloop(al, bl, 16, smem, acc);
#pragma unroll
    for (int mt = 0; mt < 2; ++mt)
#pragma unroll
      for (int nt = 0; nt < 2; ++nt) {
        const int col = ntile * 128 + wn * 64 + nt * 32 + r;
        const float g1 = mod[b * 6144 + 2048 + col];
#pragma unroll
        for (int i = 0; i < 16; ++i) {
          const size_t o = (size_t)(row0 + wm * 64 + mt * 32 + crow(i, h5)) * 1024 + col;
          x1[o] = p.x[o] + g1 * acc[mt][nt][i];
        }
      }
  }
}

DI void phase7(const Params& p, char* smem) {
  const int tid = threadIdx.x, lane = tid & 63, w = tid >> 6, r = lane & 31, h5 = lane >> 5;
  const float NEG = -__builtin_inff();
  const float* x1 = (const float*)(p.ws + OFF_X1);
  const float* mod = (const float*)(p.ws + OFF_MOD);
  u16* h2b = (u16*)(p.ws + OFF_H2B);
  const u16* wrT = (const u16*)(p.ws + OFF_WRT);
  int* cnt = (int*)(p.ws + OFF_CNT);
  int* list = (int*)(p.ws + OFF_LIST);
  float* topw = (float*)(p.ws + OFF_TOPW);
  float* lg = (float*)smem;
  for (int task = blockIdx.x; task < 512; task += gridDim.x) {
    const int row0 = task * 32, b = row0 >> 12;
    __syncthreads();
    {
      f32x4 gm[4], sh[4];
#pragma unroll
      for (int i = 0; i < 4; ++i) {
        const int k = i * 256 + lane * 4;
        const f32x4 nw = *(const f32x4*)(p.norm2_w + k);
        const f32x4 sc = *(const f32x4*)(mod + b * 6144 + 4096 + k);
        sh[i] = *(const f32x4*)(mod + b * 6144 + 3072 + k);
#pragma unroll
        for (int q = 0; q < 4; ++q) gm[i][q] = nw[q] * (1.f + sc[q]);
      }
#pragma unroll 1
      for (int rr = 0; rr < 8; ++rr) {
        const int row = w * 8 + rr; const size_t t = row0 + row;
        f32x4 xv[4]; float ssq = 0.f;
#pragma unroll
        for (int i = 0; i < 4; ++i) {
          xv[i] = *(const f32x4*)(x1 + t * 1024 + i * 256 + lane * 4);
          ssq += xv[i][0] * xv[i][0] + xv[i][1] * xv[i][1] + xv[i][2] * xv[i][2] + xv[i][3] * xv[i][3];
        }
        ssq = wave_sum(ssq);
        const float rn = rsqrtf(ssq * (1.f / 1024.f) + EPS);
#pragma unroll
        for (int i = 0; i < 4; ++i) {
          const int k = i * 256 + lane * 4;
          float o[4];
#pragma unroll
          for (int q = 0; q < 4; ++q) o[q] = xv[i][q] * rn * gm[i][q] + sh[i][q];
          u32x2 pk = {pack2(o[0], o[1]), pack2(o[2], o[3])};
          *(u32x2*)(h2b + t * 1024 + k) = pk;
          *(u32x2*)(smem + row * 2064 + k * 2) = pk;
        }
      }
    }
    __syncthreads();
    f32x16 acc[2];
#pragma unroll
    for (int i = 0; i < 16; ++i) { acc[0][i] = 0.f; acc[1][i] = 0.f; }
    {
      const char* ap = smem + r * 2064 + h5 * 16;
      const u16* bp0 = wrT + (size_t)(w * 64 + r) * 1024 + h5 * 8;
      const u16* bp1 = bp0 + 32 * 1024;
#pragma unroll 4
      for (int ks = 0; ks < 64; ++ks) {
        const bf16x8 a = *(const bf16x8*)(ap + ks * 32);
        acc[0] = MFMA32(a, *(const bf16x8*)(bp0 + ks * 16), acc[0]);
        acc[1] = MFMA32(a, *(const bf16x8*)(bp1 + ks * 16), acc[1]);
      }
    }
    __syncthreads();
#pragma unroll
    for (int nt = 0; nt < 2; ++nt)
#pragma unroll
      for (int i = 0; i < 16; ++i) lg[crow(i, h5) * 256 + w * 64 + nt * 32 + r] = acc[nt][i];
    __syncthreads();
    const f32x4 eb = *(const f32x4*)(p.e_bias + lane * 4);
#pragma unroll 1
    for (int rr = 0; rr < 8; ++rr) {
      const int row = w * 8 + rr; const int t = row0 + row;
      const f32x4 lv = *(const f32x4*)(lg + row * 256 + lane * 4);
      float sc[4], ch[4];
#pragma unroll
      for (int q = 0; q < 4; ++q) { sc[q] = 1.f / (1.f + __expf(-lv[q])); ch[q] = sc[q] + eb[q]; }
      float m1 = fmaxf(ch[0], ch[1]), m2 = fminf(ch[0], ch[1]);
#pragma unroll
      for (int q = 2; q < 4; ++q) { const float v = ch[q]; m2 = fmaxf(m2, fminf(m1, v)); m1 = fmaxf(m1, v); }
#pragma unroll
      for (int sft = 1; sft < 8; sft <<= 1) {
        const float o1 = __shfl_xor(m1, sft), o2 = __shfl_xor(m2, sft);
        const float n1 = fmaxf(m1, o1); const float n2 = fmaxf(fminf(m1, o1), fmaxf(m2, o2));
        m1 = n1; m2 = n2;
      }
      const float gs = m1 + m2; const int mygrp = lane >> 3;
      int rank = 0;
#pragma unroll
      for (int q = 0; q < 8; ++q) { const float og = __shfl(gs, q * 8); rank += (og > gs || (og == gs && q < mygrp)) ? 1 : 0; }
      const bool allowed = rank < 4;
      float cand[4];
#pragma unroll
      for (int q = 0; q < 4; ++q) cand[q] = allowed ? ch[q] : NEG;
      float wsel = 0.f; int esel = 0; float wsum = 0.f;
#pragma unroll 1
      for (int k = 0; k < 8; ++k) {
        float bv = cand[0]; int bi = lane * 4;
#pragma unroll
        for (int q = 1; q < 4; ++q) if (cand[q] > bv) { bv = cand[q]; bi = lane * 4 + q; }
#pragma unroll
        for (int sft = 32; sft >= 1; sft >>= 1) {
          const float ov = __shfl_xor(bv, sft); const int oi = __shfl_xor(bi, sft);
          if (ov > bv || (ov == bv && oi < bi)) { bv = ov; bi = oi; }
        }
        float sv = 0.f;
        if ((bi >> 2) == lane) {
#pragma unroll
          for (int q = 0; q < 4; ++q) if ((bi & 3) == q) { sv = sc[q]; cand[q] = NEG; }
        }
        sv = __shfl(sv, bi >> 2);
        wsum += sv;
        if (lane == k) { wsel = sv; esel = bi; }
      }
      if (lane < 8) {
        const float wgt = wsel / wsum * 2.5f;
        const int pos = atomicAdd(&cnt[esel], 1);
        list[(size_t)esel * LISTCAP + pos] = t * 8 + lane;
        topw[t * 8 + lane] = wgt;
      }
    }
  }
}

DI int perm_e(int o) { return (o & 31) * 8 + (o >> 5); }
DI void build_tables(const Params& p, int* tbl) {
  const int tid = threadIdx.x;
  const int* cnt = (const int*)(p.ws + OFF_CNT);
  __syncthreads();
  tbl[520 + tid] = cnt[perm_e(tid)];
  __syncthreads();
  int tp = 0, rp = 0;
  for (int o = 0; o < tid; ++o) { const int cc = tbl[520 + o]; tp += (cc + 127) >> 7; rp += cc; }
  tbl[tid] = tp; tbl[260 + tid] = rp;
  if (tid == 255) { const int cc = tbl[520 + 255]; tbl[256] = tp + ((cc + 127) >> 7); tbl[260 + 256] = rp + cc; }
  __syncthreads();
}
DI int find_o(const int* tbl, int g, int tile) {
  int lo = 32 * g, hi = 32 * g + 31;
  while (lo < hi) { const int mid = (lo + hi + 1) >> 1; if (tbl[mid] <= tile) lo = mid; else hi = mid - 1; }
  return lo;
}

DI void phase8(const Params& p, char* smem) {
  const int tid = threadIdx.x, lane = tid & 63, w = tid >> 6, wm = w >> 1, wn = w & 1, r = lane & 31, h5 = lane >> 5;
  const int g = blockIdx.x & 7, j = blockIdx.x >> 3, nj = gridDim.x >> 3;
  int* tbl = (int*)(smem + LDS_TBL);
  build_tables(p, tbl);
  const u16* h2b = (const u16*)(p.ws + OFF_H2B);
  const int* list = (const int*)(p.ws + OFF_LIST);
  const int t0 = tbl[32 * g], ntl = tbl[32 * g + 32] - t0;
  const int ntask = ntl * 4 + 64;
  for (int id = j; id < ntask; id += nj) {
    int e, mtile, nchunk, cnt_e, rowbase;
    if (id < ntl * 4) {
      const int tile = t0 + (id >> 2); nchunk = id & 3;
      const int o = find_o(tbl, g, tile);
      e = perm_e(o); mtile = tile - tbl[o]; cnt_e = tbl[520 + o]; rowbase = tbl[260 + o];
    } else {
      const int sid = id - ntl * 4; e = 256; mtile = 16 * g + (sid >> 2); nchunk = sid & 3; cnt_e = T; rowbase = 0;
    }
    ALoadBf16 al; BLoadF32 bl;
#pragma unroll
    for (int i = 0; i < 4; ++i) {
      const int rr = mtile * 128 + (tid >> 3) + 32 * i;
      int tok = 0;
      if (rr < cnt_e) tok = (e < 256) ? (list[(size_t)e * LISTCAP + rr] >> 3) : rr;
      al.rp[i] = h2b + (size_t)tok * 1024 + (tid & 7) * 8;
    }
    {
      const int n4 = (tid & 31) * 4, kg = tid >> 5;
      const int twn = n4 >> 6, tnt = (n4 >> 5) & 1, jj = n4 & 31;
      const int col = nchunk * 64 + twn * 32 + jj;
      const float* base = (e < 256) ? ((tnt ? p.w3 : p.w1) + (size_t)e * 1024 * 256) : (tnt ? p.ws3 : p.ws1);
      bl.valid = true; bl.ldb = 256; bl.p = base + (size_t)(kg * 8) * 256 + col;
    }
    f32x16 acc[2][2];
    gemm_mainloop(al, bl, 16, smem, acc);
    u16* actp = (e < 256) ? ((u16*)(p.ws + OFF_ACT) + (size_t)rowbase * 256) : (u16*)(p.ws + OFF_ACTS);
#pragma unroll
    for (int mt = 0; mt < 2; ++mt)
#pragma unroll
      for (int i = 0; i < 16; ++i) {
        const int rr = mtile * 128 + wm * 64 + mt * 32 + crow(i, h5);
        if (rr < cnt_e) {
          const float a1 = acc[mt][0][i], a3 = acc[mt][1][i];
          const float v = siluf(a1) * a3;
          actp[(size_t)rr * 256 + nchunk * 64 + wn * 32 + r] = (u16)(pack2(v, 0.f) & 0xffffu);
        }
      }
  }
}

DI void phase9(const Params& p, char* smem) {
  const int tid = threadIdx.x, lane = tid & 63, w = tid >> 6, wm = w >> 1, wn = w & 1, r = lane & 31, h5 = lane >> 5;
  const int g = blockIdx.x & 7, j = blockIdx.x >> 3, nj = gridDim.x >> 3;
  int* tbl = (int*)(smem + LDS_TBL);
  build_tables(p, tbl);
  const int* list = (const int*)(p.ws + OFF_LIST);
  const float* topw = (const float*)(p.ws + OFF_TOPW);
  u16* y = (u16*)(p.ws + OFF_Y);
  const int t0 = tbl[32 * g], ntl = tbl[32 * g + 32] - t0;
  const int ntask = ntl * 8;
  for (int id = j; id < ntask; id += nj) {
    const int tile = t0 + (id >> 3), ntile = id & 7;
    const int o = find_o(tbl, g, tile);
    const int e = perm_e(o), mtile = tile - tbl[o], cnt_e = tbl[520 + o], rowbase = tbl[260 + o];
    const u16* actp = (const u16*)(p.ws + OFF_ACT) + (size_t)rowbase * 256;
    ALoadBf16 al; BLoadF32 bl;
#pragma unroll
    for (int i = 0; i < 4; ++i) {
      int rr = mtile * 128 + (tid >> 3) + 32 * i;
      if (rr >= cnt_e) rr = 0;
      al.rp[i] = actp + (size_t)rr * 256 + (tid & 7) * 8;
    }
    bl.valid = true; bl.ldb = 1024;
    bl.p = p.w2 + (size_t)e * 256 * 1024 + (size_t)((tid >> 5) * 8) * 1024 + ntile * 128 + (tid & 31) * 4;
    f32x16 acc[2][2];
    gemm_mainloop(al, bl, 4, smem, acc);
#pragma unroll
    for (int mt = 0; mt < 2; ++mt)
#pragma unroll
      for (int i = 0; i < 16; ++i) {
        const int rr = mtile * 128 + wm * 64 + mt * 32 + crow(i, h5);
        if (rr < cnt_e) {
          const int asg = list[(size_t)e * LISTCAP + rr];
          const float wg = topw[asg];
          u16* yp = y + (size_t)asg * 1024 + ntile * 128 + wn * 64 + r;
          yp[0] = (u16)(pack2(acc[mt][0][i] * wg, 0.f) & 0xffffu);
          yp[32] = (u16)(pack2(acc[mt][1][i] * wg, 0.f) & 0xffffu);
        }
      }
  }
}

DI void phase10(const Params& p, char* smem) {
  const int tid = threadIdx.x;
  const int g = blockIdx.x & 7, j = blockIdx.x >> 3, nj = gridDim.x >> 3;
  const u16* acts = (const u16*)(p.ws + OFF_ACTS);
  const u16* y = (const u16*)(p.ws + OFF_Y);
  const float* x1 = (const float*)(p.ws + OFF_X1);
  const float* mod = (const float*)(p.ws + OFF_MOD);
  float* cs = (float*)smem;
  for (int mtile = j; mtile < 128; mtile += nj) {
    const int ntile = g, row0 = mtile * 128, b = row0 >> 12;
    ALoadBf16 al; BLoadF32 bl;
#pragma unroll
    for (int i = 0; i < 4; ++i) al.rp[i] = acts + (size_t)(row0 + (tid >> 3) + 32 * i) * 256 + (tid & 7) * 8;
    bl.valid = true; bl.ldb = 1024;
    bl.p = p.ws2 + (size_t)((tid >> 5) * 8) * 1024 + ntile * 128 + (tid & 31) * 4;
    f32x16 acc[2][2];
    gemm_mainloop(al, bl, 4, smem, acc);
    stage_nat(cs, acc);
    __syncthreads();
#pragma unroll 1
    for (int it = 0; it < 8; ++it) {
      const int i = it * 256 + tid, row = i >> 4, c8 = (i & 15) * 8;
      const size_t t = row0 + row; const int col = ntile * 128 + c8;
      float v[8];
      {
        const f32x4 va = *(const f32x4*)(cs + row * 132 + c8), vb = *(const f32x4*)(cs + row * 132 + c8 + 4);
        v[0] = va[0]; v[1] = va[1]; v[2] = va[2]; v[3] = va[3]; v[4] = vb[0]; v[5] = vb[1]; v[6] = vb[2]; v[7] = vb[3];
      }
#pragma unroll
      for (int k = 0; k < 8; ++k) {
        const u32x4 yy = *(const u32x4*)(y + (t * 8 + k) * 1024 + col);
        v[0] += bflo(yy[0]); v[1] += bfhi(yy[0]); v[2] += bflo(yy[1]); v[3] += bfhi(yy[1]);
        v[4] += bflo(yy[2]); v[5] += bfhi(yy[2]); v[6] += bflo(yy[3]); v[7] += bfhi(yy[3]);
      }
      const f32x4 g2a = *(const f32x4*)(mod + b * 6144 + 5120 + col), g2b = *(const f32x4*)(mod + b * 6144 + 5120 + col + 4);
      const f32x4 xa = *(const f32x4*)(x1 + t * 1024 + col), xb = *(const f32x4*)(x1 + t * 1024 + col + 4);
      f32x4 oa = {xa[0] + g2a[0] * v[0], xa[1] + g2a[1] * v[1], xa[2] + g2a[2] * v[2], xa[3] + g2a[3] * v[3]};
      f32x4 ob = {xb[0] + g2b[0] * v[4], xb[1] + g2b[1] * v[5], xb[2] + g2b[2] * v[6], xb[3] + g2b[3] * v[7]};
      *(f32x4*)(p.out + t * 1024 + col) = oa;
      *(f32x4*)(p.out + t * 1024 + col + 4) = ob;
    }
  }
}

#if !FUSED
#define PHASE_KERNEL(name, body)                                                 \
  __global__ void __launch_bounds__(256, 2) name(Params p) {                     \
    __shared__ __attribute__((aligned(16))) char smem[LDS_BYTES];                \
    body;                                                                        \
  }
PHASE_KERNEL(k_p0, phase0(p, smem))
PHASE_KERNEL(k_p1, phase1(p); (void)smem)
PHASE_KERNEL(k_p2, phase2(p, smem))
PHASE_KERNEL(k_p3, phase_moba(p, smem, 0, 1024); phase_gla_a(p))
PHASE_KERNEL(k_p4, phase_gla_b(p); (void)smem)
PHASE_KERNEL(k_p5, phase_gla_c(p); (void)smem)
PHASE_KERNEL(k_p6, phase6(p, smem))
PHASE_KERNEL(k_p7, phase7(p, smem))
PHASE_KERNEL(k_p8, phase8(p, smem))
PHASE_KERNEL(k_p9, phase9(p, smem))
PHASE_KERNEL(k_p10, phase10(p, smem))
#else
__global__ void __launch_bounds__(256, 2) k_fused(Params p) {
  __shared__ __attribute__((aligned(16))) char smem[LDS_BYTES];
  cg::grid_group grid = cg::this_grid();
  phase0(p, smem);                                    grid.sync();
  phase1(p);                                          grid.sync();
  phase2(p, smem);                                    grid.sync();
  phase_moba(p, smem, 0, 1024); phase_gla_a(p);       grid.sync();
  phase_gla_b(p);                                     grid.sync();
  phase_gla_c(p);                                     grid.sync();
  phase6(p, smem);                                    grid.sync();
  phase7(p, smem);                                    grid.sync();
  phase8(p, smem);                                    grid.sync();
  phase9(p, smem);                                    grid.sync();
  phase10(p, smem);
}
#endif

extern "C" void kernel_launch(void* const* d_in, const int* in_sizes, int n_in, void* d_out, int out_size, void* d_ws, size_t ws_size,
                              hipStream_t stream) {
  if (n_in != 23 || out_size != T * D || ws_size < WS_END) {
    fprintf(stderr, "kernel_launch: unexpected problem (n_in %d, out %d, ws %zu, need %zu)\n", n_in, out_size, ws_size, (size_t)WS_END);
    return;
  }
  Params p{};
  const float** f = (const float**)&p;
  for (int i = 0; i < 23; ++i) f[i] = (const float*)d_in[i];
  p.out = (float*)d_out;
  p.ws = (unsigned char*)d_ws;
  (void)hipMemsetAsync(d_ws, 0, ZERO_BYTES, stream);
#if !FUSED
  const dim3 grid(512), blk(256);
  hipLaunchKernelGGL(k_p0, grid, blk, 0, stream, p);
  hipLaunchKernelGGL(k_p1, grid, blk, 0, stream, p);
  hipLaunchKernelGGL(k_p2, grid, blk, 0, stream, p);
  hipLaunchKernelGGL(k_p3, grid, blk, 0, stream, p);
  hipLaunchKernelGGL(k_p4, grid, blk, 0, stream, p);
  hipLaunchKernelGGL(k_p5, grid, blk, 0, stream, p);
  hipLaunchKernelGGL(k_p6, grid, blk, 0, stream, p);
  hipLaunchKernelGGL(k_p7, grid, blk, 0, stream, p);
  hipLaunchKernelGGL(k_p8, grid, blk, 0, stream, p);
  hipLaunchKernelGGL(k_p9, grid, blk, 0, stream, p);
  hipLaunchKernelGGL(k_p10, grid, blk, 0, stream, p);
#else
  static int grid_blocks = 0;
  if (!grid_blocks) {
    int dev = 0, cus = 0, per_cu = 0;
    hipGetDevice(&dev);
    hipDeviceGetAttribute(&cus, hipDeviceAttributeMultiprocessorCount, dev);
    hipOccupancyMaxActiveBlocksPerMultiprocessor(&per_cu, k_fused, 256, 0);
    if (per_cu > 2) per_cu = 2;
    grid_blocks = cus * per_cu;
    grid_blocks -= grid_blocks % 8;
  }
  void* args[] = {&p};
  hipError_t e = hipLaunchCooperativeKernel((void*)k_fused, dim3(grid_blocks), dim3(256), args, 0, stream);
  if (e != hipSuccess) fprintf(stderr, "cooperative launch failed: %s (grid %d)\n", hipGetErrorString(e), grid_blocks);
#endif
}
```

```cpp
#include <hip/hip_runtime.h>
#include <hip/hip_cooperative_groups.h>
#include <stdint.h>
#include <stdio.h>

#ifndef FUSED
#define FUSED 1
#endif

namespace cg = cooperative_groups;

#define DI __device__ __forceinline__
typedef short bf16x8 __attribute__((ext_vector_type(8)));
typedef float f32x16 __attribute__((ext_vector_type(16)));
typedef float f32x4 __attribute__((ext_vector_type(4)));
typedef unsigned u32x4 __attribute__((ext_vector_type(4)));
typedef unsigned u32x2 __attribute__((ext_vector_type(2)));
typedef __bf16 bf16x2_t __attribute__((ext_vector_type(2)));
typedef float f32x2_t __attribute__((ext_vector_type(2)));
typedef unsigned short u16;

#define MFMA32(a, b, c) __builtin_amdgcn_mfma_f32_32x32x16_bf16((a), (b), (c), 0, 0, 0)

constexpr int Bn = 4, S = 4096, D = 1024, T = Bn * S;
constexpr int DIN = 3088;
constexpr int NE = 256;
constexpr float EPS = 1e-6f;
constexpr float LOG2E = 1.4426950408889634f;
constexpr int LISTCAP = 16384;

constexpr size_t al256(size_t x) { return (x + 255) & ~(size_t)255; }
constexpr size_t OFF_BAR   = 0;
constexpr size_t OFF_CNT   = 16384;
constexpr size_t OFF_KMEAN = 32768;
constexpr size_t ZERO_BYTES = OFF_KMEAN + 4 * 8 * 16 * 64 * 4;
constexpr size_t OFF_MOD   = al256(ZERO_BYTES);
constexpr size_t OFF_WRT   = al256(OFF_MOD + 4 * 6144 * 4);
constexpr size_t OFF_H1B   = al256(OFF_WRT + 256 * 1024 * 2);
constexpr size_t OFF_MQ    = al256(OFF_H1B + (size_t)T * 1024 * 2);
constexpr size_t OFF_MK    = al256(OFF_MQ + (size_t)T * 512 * 2);
constexpr size_t OFF_VT    = al256(OFF_MK + (size_t)T * 512 * 2);
constexpr size_t OFF_GQ    = al256(OFF_VT + (size_t)T * 512 * 2);
constexpr size_t OFF_GK    = al256(OFF_GQ + (size_t)T * 256 * 2);
constexpr size_t OFF_GKT   = al256(OFF_GK + (size_t)T * 256 * 2);
constexpr size_t OFF_GVT   = al256(OFF_GKT + (size_t)T * 256 * 2);
constexpr size_t OFF_SG    = al256(OFF_GVT + (size_t)T * 512 * 2);
constexpr size_t OFF_BC    = al256(OFF_SG + (size_t)T * 512 * 2);
constexpr size_t OFF_BCT   = al256(OFF_BC + (size_t)T * 256 * 4);
constexpr size_t OFF_UT    = al256(OFF_BCT + (size_t)T * 256 * 4);
constexpr size_t OFF_DEC   = al256(OFF_UT + (size_t)16 * 64 * 128 * 64 * 4);
constexpr size_t OFF_ST    = al256(OFF_DEC + (size_t)16 * 64 * 64 * 4);
constexpr size_t OFF_MIX   = al256(OFF_ST + (size_t)16 * 64 * 128 * 64 * 2);
constexpr size_t OFF_X1    = al256(OFF_MIX + (size_t)T * 1024 * 2);
constexpr size_t OFF_H2B   = al256(OFF_X1 + (size_t)T * 1024 * 4);
constexpr size_t OFF_LIST  = al256(OFF_H2B + (size_t)T * 1024 * 2);
constexpr size_t OFF_TOPW  = al256(OFF_LIST + (size_t)256 * LISTCAP * 4);
constexpr size_t OFF_ACT   = al256(OFF_TOPW + (size_t)T * 8 * 4);
constexpr size_t OFF_ACTS  = al256(OFF_ACT + (size_t)T * 8 * 256 * 2);
constexpr size_t OFF_Y     = al256(OFF_ACTS + (size_t)T * 256 * 2);
constexpr size_t WS_END    = al256(OFF_Y + (size_t)T * 8 * 1024 * 2);

constexpr int LDS_C = 128 * 132 * 4;
constexpr int LDS_TBL = LDS_C;
constexpr int LDS_BYTES = LDS_C + 4096;

struct Params {
  const float *x, *c, *w_ada, *b_ada, *norm1_w, *norm2_w, *w_in, *q_norm_w, *k_norm_w, *rel_bias, *w_alpha, *b_alpha,
      *moba_out_w, *gla_out_w, *w_out, *w_router, *e_bias, *w1, *w3, *w2, *ws1, *ws3, *ws2;
  float* out;
  unsigned char* ws;
};

DI unsigned pack2(float a, float b) { f32x2_t v = {a, b}; return __builtin_bit_cast(unsigned, __builtin_convertvector(v, bf16x2_t)); }
DI float bflo(unsigned u) { return __uint_as_float(u << 16); }
DI float bfhi(unsigned u) { return __uint_as_float(u & 0xffff0000u); }
DI int crow(int reg, int h) { return (reg & 3) + 8 * (reg >> 2) + 4 * h; }
DI int swz(int row) { return ((row >> 2) ^ (row >> 1)) & 7; }
DI u32x4 pack8(float a0, float a1, float a2, float a3, float a4, float a5, float a6, float a7) {
  u32x4 r; r[0] = pack2(a0, a1); r[1] = pack2(a2, a3); r[2] = pack2(a4, a5); r[3] = pack2(a6, a7); return r;
}
DI float wave_sum(float v) {
  v += __shfl_xor(v, 32); v += __shfl_xor(v, 16); v += __shfl_xor(v, 8); v += __shfl_xor(v, 4); v += __shfl_xor(v, 2); v += __shfl_xor(v, 1);
  return v;
}
DI float siluf(float x) { return x / (1.f + __expf(-x)); }

struct ALoadBf16 {
  const u16* rp[4];
  u32x4 v[4];
  DI void load(int kt) {
#pragma unroll
    for (int i = 0; i < 4; ++i) v[i] = *(const u32x4*)(rp[i] + kt * 64);
  }
  DI void store(char* sA, int tid) {
    const int c = tid & 7, row = tid >> 3;
    const int off = ((c ^ swz(row)) << 4);
#pragma unroll
    for (int i = 0; i < 4; ++i) *(u32x4*)(sA + (row + 32 * i) * 128 + off) = v[i];
  }
};

struct BLoadF32 {
  const float* p;
  size_t ldb;
  bool valid;
  f32x4 v[8];
  DI void load(int kt) {
    const float* q = p + (size_t)kt * 64 * ldb;
#pragma unroll
    for (int i = 0; i < 8; ++i) {
      if (valid) v[i] = *(const f32x4*)(q + (size_t)i * ldb);
      else { v[i][0] = 0.f; v[i][1] = 0.f; v[i][2] = 0.f; v[i][3] = 0.f; }
    }
  }
  DI void store(char* sB, int tid) {
    const int n4 = (tid & 31) * 4, kg = tid >> 5;
#pragma unroll
    for (int j = 0; j < 4; ++j) {
      const int n = n4 + j;
      u32x4 w = pack8(v[0][j], v[1][j], v[2][j], v[3][j], v[4][j], v[5][j], v[6][j], v[7][j]);
      *(u32x4*)(sB + n * 128 + ((kg ^ swz(n)) << 4)) = w;
    }
  }
};

DI void mma_step(const char* sA, const char* sB, f32x16 (&acc)[2][2], int lane, int wm, int wn) {
  const int r = lane & 31, h = lane >> 5, f = swz(r);
  const char* a0 = sA + (wm * 64 + r) * 128;
  const char* b0 = sB + (wn * 64 + r) * 128;
#pragma unroll
  for (int kk = 0; kk < 4; ++kk) {
    const int off = (((kk * 2 + h) ^ f) << 4);
    const bf16x8 fa0 = *(const bf16x8*)(a0 + off);
    const bf16x8 fa1 = *(const bf16x8*)(a0 + 32 * 128 + off);
    const bf16x8 fb0 = *(const bf16x8*)(b0 + off);
    const bf16x8 fb1 = *(const bf16x8*)(b0 + 32 * 128 + off);
    acc[0][0] = MFMA32(fa0, fb0, acc[0][0]);
    acc[0][1] = MFMA32(fa0, fb1, acc[0][1]);
    acc[1][0] = MFMA32(fa1, fb0, acc[1][0]);
    acc[1][1] = MFMA32(fa1, fb1, acc[1][1]);
  }
}

template <class AL, class BL>
DI void gemm_mainloop(AL& al, BL& bl, int nk, char* smem, f32x16 (&acc)[2][2]) {
  const int tid = threadIdx.x, lane = tid & 63, w = tid >> 6, wm = w >> 1, wn = w & 1;
#pragma unroll
  for (int i = 0; i < 2; ++i)
#pragma unroll
    for (int j = 0; j < 2; ++j)
#pragma unroll
      for (int r = 0; r < 16; ++r) acc[i][j][r] = 0.f;
  __syncthreads();
  al.load(0); bl.load(0);
  al.store(smem, tid); bl.store(smem + 16384, tid);
  __syncthreads();
  for (int kt = 0; kt < nk; ++kt) {
    const int cur = kt & 1;
    const bool more = (kt + 1 < nk);
    if (more) { al.load(kt + 1); bl.load(kt + 1); }
    mma_step(smem + cur * 32768, smem + cur * 32768 + 16384, acc, lane, wm, wn);
    if (more) { al.store(smem + (cur ^ 1) * 32768, tid); bl.store(smem + (cur ^ 1) * 32768 + 16384, tid); }
    __syncthreads();
  }
}

DI void stage_nat(float* cs, const f32x16 (&acc)[2][2]) {
  const int lane = threadIdx.x & 63, w = threadIdx.x >> 6, wm = w >> 1, wn = w & 1, r = lane & 31, h = lane >> 5;
#pragma unroll
  for (int mt = 0; mt < 2; ++mt)
#pragma unroll
    for (int nt = 0; nt < 2; ++nt)
#pragma unroll
      for (int g = 0; g < 16; ++g) cs[(wm * 64 + mt * 32 + crow(g, h)) * 132 + wn * 64 + nt * 32 + r] = acc[mt][nt][g];
}
DI void stage_tr(float* cs, const f32x16 (&acc)[2][2]) {
  const int lane = threadIdx.x & 63, w = threadIdx.x >> 6, wm = w >> 1, wn = w & 1, r = lane & 31, h = lane >> 5;
#pragma unroll
  for (int mt = 0; mt < 2; ++mt)
#pragma unroll
    for (int nt = 0; nt < 2; ++nt)
#pragma unroll
      for (int g = 0; g < 4; ++g) {
        f32x4 v = {acc[mt][nt][4 * g], acc[mt][nt][4 * g + 1], acc[mt][nt][4 * g + 2], acc[mt][nt][4 * g + 3]};
        *(f32x4*)(cs + (wn * 64 + nt * 32 + r) * 132 + wm * 64 + mt * 32 + 8 * g + 4 * h) = v;
      }
}

DI void phase0(const Params& p, char* smem) {
  const int tid = threadIdx.x, lane = tid & 63, w = tid >> 6;
  float* mod = (float*)(p.ws + OFF_MOD);
  float* sil = (float*)smem;
  float* red = sil + 4096;
  for (int task = blockIdx.x; task < 96; task += gridDim.x) {
    __syncthreads();
    for (int i = tid; i < 4096; i += 256) sil[i] = siluf(p.c[i]);
    __syncthreads();
    const int col = task * 64 + lane;
    float a0 = 0.f, a1 = 0.f, a2 = 0.f, a3 = 0.f;
    const float* wp = p.w_ada + (size_t)(w * 256) * 6144 + col;
#pragma unroll 8
    for (int k = 0; k < 256; ++k) {
      const float wv = wp[(size_t)k * 6144];
      const int kk = w * 256 + k;
      a0 += sil[kk] * wv; a1 += sil[1024 + kk] * wv; a2 += sil[2048 + kk] * wv; a3 += sil[3072 + kk] * wv;
    }
    red[(w * 4 + 0) * 64 + lane] = a0; red[(w * 4 + 1) * 64 + lane] = a1; red[(w * 4 + 2) * 64 + lane] = a2; red[(w * 4 + 3) * 64 + lane] = a3;
    __syncthreads();
    {
      const int b = w;
      float s = red[(0 * 4 + b) * 64 + lane] + red[(1 * 4 + b) * 64 + lane] + red[(2 * 4 + b) * 64 + lane] + red[(3 * 4 + b) * 64 + lane];
      mod[b * 6144 + col] = s + p.b_ada[col];
    }
  }
  u16* wrT = (u16*)(p.ws + OFF_WRT);
  for (int i = blockIdx.x * 256 + tid; i < 256 * 128; i += gridDim.x * 256) {
    const int n = i & 255, k8 = (i >> 8) * 8;
    float v[8];
#pragma unroll
    for (int j = 0; j < 8; ++j) v[j] = p.w_router[(size_t)(k8 + j) * 256 + n];
    *(u32x4*)(wrT + (size_t)n * 1024 + k8) = pack8(v[0], v[1], v[2], v[3], v[4], v[5], v[6], v[7]);
  }
}

DI void phase1(const Params& p) {
  const int tid = threadIdx.x, lane = tid & 63, w = tid >> 6;
  const float* mod = (const float*)(p.ws + OFF_MOD);
  u16* h1b = (u16*)(p.ws + OFF_H1B);
  const int nW = gridDim.x * 4;
  for (int t = blockIdx.x * 4 + w; t < T; t += nW) {
    const int b = t >> 12;
    f32x4 xv[4]; float ssq = 0.f;
#pragma unroll
    for (int i = 0; i < 4; ++i) {
      xv[i] = *(const f32x4*)(p.x + (size_t)t * 1024 + i * 256 + lane * 4);
      ssq += xv[i][0] * xv[i][0] + xv[i][1] * xv[i][1] + xv[i][2] * xv[i][2] + xv[i][3] * xv[i][3];
    }
    ssq = wave_sum(ssq);
    const float r = rsqrtf(ssq * (1.f / 1024.f) + EPS);
#pragma unroll
    for (int i = 0; i < 4; ++i) {
      const int k = i * 256 + lane * 4;
      const f32x4 nw = *(const f32x4*)(p.norm1_w + k);
      const f32x4 sc = *(const f32x4*)(mod + b * 6144 + 1024 + k);
      const f32x4 sh = *(const f32x4*)(mod + b * 6144 + k);
      float o[4];
#pragma unroll
      for (int j = 0; j < 4; ++j) o[j] = xv[i][j] * r * nw[j] * (1.f + sc[j]) + sh[j];
      u32x2 pk = {pack2(o[0], o[1]), pack2(o[2], o[3])};
      *(u32x2*)(h1b + (size_t)t * 1024 + k) = pk;
    }
  }
}

DI float logsig(float z) { return fminf(z, 0.f) - log1pf(__expf(-fabsf(z))); }

DI void phase2(const Params& p, char* smem) {
  const int tid = threadIdx.x, lane = tid & 63;
  const int g = blockIdx.x & 7, j = blockIdx.x >> 3, nj = gridDim.x >> 3;
  const u16* h1b = (const u16*)(p.ws + OFF_H1B);
  float* cs = (float*)smem;
  for (int id = j; id < 400; id += nj) {
    int mtile, ntile;
    if (id < 384) { mtile = id / 3; ntile = 3 * g + id % 3; } else { ntile = 24; mtile = 16 * g + (id - 384); }
    const int row0 = mtile * 128, b = row0 >> 12, s0 = row0 & 4095;
    ALoadBf16 al; BLoadF32 bl;
#pragma unroll
    for (int i = 0; i < 4; ++i) al.rp[i] = h1b + (size_t)(row0 + (tid >> 3) + 32 * i) * 1024 + (tid & 7) * 8;
    {
      const int n4 = (tid & 31) * 4, kg = tid >> 5;
      const int col = ntile * 128 + n4;
      bl.valid = (col < DIN);
      bl.ldb = DIN;
      bl.p = p.w_in + (size_t)(kg * 8) * DIN + (bl.valid ? col : 0);
    }
    f32x16 acc[2][2];
    gemm_mainloop(al, bl, 16, smem, acc);
    if (ntile < 8 || (ntile >= 12 && ntile < 16) || (ntile >= 20 && ntile < 24)) {
      stage_nat(cs, acc);
      __syncthreads();
      float ksum[8];
#pragma unroll
      for (int q = 0; q < 8; ++q) ksum[q] = 0.f;
#pragma unroll 1
      for (int it = 0; it < 8; ++it) {
        const int i = it * 256 + tid, row = i >> 4, c8 = (i & 15) * 8;
        const f32x4 va = *(const f32x4*)(cs + row * 132 + c8), vb = *(const f32x4*)(cs + row * 132 + c8 + 4);
        float v[8] = {va[0], va[1], va[2], va[3], vb[0], vb[1], vb[2], vb[3]};
        const int d0 = c8 & 63;
        if (ntile < 8) {
          float ssq = 0.f;
#pragma unroll
          for (int q = 0; q < 8; ++q) ssq += v[q] * v[q];
          ssq += __shfl_xor(ssq, 1); ssq += __shfl_xor(ssq, 2); ssq += __shfl_xor(ssq, 4);
          const float sc = rsqrtf(ssq * (1.f / 64.f) + EPS);
          const float* nw = (ntile < 4) ? p.q_norm_w : p.k_norm_w;
#pragma unroll
          for (int q = 0; q < 8; ++q) v[q] = v[q] * sc * nw[d0 + q];
          const int hd = (ntile & 3) * 2 + (c8 >> 6);
          u16* dst = (u16*)(p.ws + (ntile < 4 ? OFF_MQ : OFF_MK)) + ((size_t)(b * 8 + hd) * S + s0 + row) * 64 + d0;
          *(u32x4*)dst = pack8(v[0], v[1], v[2], v[3], v[4], v[5], v[6], v[7]);
          if (ntile >= 4) {
#pragma unroll
            for (int q = 0; q < 8; ++q) ksum[q] += v[q];
          }
        } else if (ntile < 16) {
          const int hd = (ntile & 1) * 2 + (c8 >> 6);
          if (ntile < 14) {
#pragma unroll
            for (int q = 0; q < 8; ++q) v[q] *= 0.125f;
          }
          u16* dst = (u16*)(p.ws + (ntile < 14 ? OFF_GQ : OFF_GK)) + ((size_t)(b * 4 + hd) * S + s0 + row) * 64 + d0;
          *(u32x4*)dst = pack8(v[0], v[1], v[2], v[3], v[4], v[5], v[6], v[7]);
        } else {
#pragma unroll
          for (int q = 0; q < 8; ++q) v[q] = siluf(v[q]);
          u16* dst = (u16*)(p.ws + OFF_SG) + (size_t)(row0 + row) * 512 + (ntile - 20) * 128 + c8;
          *(u32x4*)dst = pack8(v[0], v[1], v[2], v[3], v[4], v[5], v[6], v[7]);
        }
      }
      if (ntile >= 4 && ntile < 8) {
        __syncthreads();
        const int c8 = (tid & 15) * 8;
#pragma unroll
        for (int q = 0; q < 8; ++q) cs[(tid >> 4) * 128 + c8 + q] = ksum[q];
        __syncthreads();
        if (tid < 128) {
          float s = 0.f;
#pragma unroll
          for (int q = 0; q < 16; ++q) s += cs[q * 128 + tid];
          const int hd = (ntile - 4) * 2 + (tid >> 6);
          float* km = (float*)(p.ws + OFF_KMEAN);
          atomicAdd(&km[((size_t)(b * 8 + hd) * 16 + (s0 >> 8)) * 64 + (tid & 63)], s * (1.f / 256.f));
        }
      }
      if (ntile == 14 || ntile == 15) __syncthreads();
    }
    if ((ntile >= 8 && ntile < 12) || (ntile >= 14 && ntile < 20)) {
      stage_tr(cs, acc);
      __syncthreads();
#pragma unroll 1
      for (int it = 0; it < 8; ++it) {
        const int i = it * 256 + tid, col = i >> 4, r8 = (i & 15) * 8;
        const f32x4 va = *(const f32x4*)(cs + col * 132 + r8), vb = *(const f32x4*)(cs + col * 132 + r8 + 4);
        u16* dst;
        if (ntile < 12)      dst = (u16*)(p.ws + OFF_VT) + ((size_t)(b * 8 + (ntile - 8) * 2 + (col >> 6)) * 64 + (col & 63)) * S + s0 + r8;
        else if (ntile < 16) dst = (u16*)(p.ws + OFF_GKT) + ((size_t)(b * 4 + (ntile - 14) * 2 + (col >> 6)) * 64 + (col & 63)) * S + s0 + r8;
        else                 dst = (u16*)(p.ws + OFF_GVT) + ((size_t)(b * 4 + (ntile - 16)) * 128 + col) * S + s0 + r8;
        *(u32x4*)dst = pack8(va[0], va[1], va[2], va[3], vb[0], vb[1], vb[2], vb[3]);
      }
    }
    if (ntile == 24) {
      stage_nat(cs, acc);
      __syncthreads();
      float wa[16];
#pragma unroll
      for (int q = 0; q < 16; ++q) wa[q] = p.w_alpha[q * 256 + tid];
      const float ba = p.b_alpha[tid];
      const int hd = tid >> 6, d = tid & 63;
      float* bc = (float*)(p.ws + OFF_BC) + ((size_t)(b * 4 + hd) * S + s0) * 64 + d;
      float* bct = (float*)(p.ws + OFF_BCT) + ((size_t)(b * 4 + hd) * 64 + d) * S + s0;
#pragma unroll 1
      for (int ch = 0; ch < 2; ++ch) {
        float cum = 0.f;
#pragma unroll 1
        for (int r4 = 0; r4 < 16; ++r4) {
          f32x4 o;
#pragma unroll
          for (int q4 = 0; q4 < 4; ++q4) {
            const int row = ch * 64 + r4 * 4 + q4;
            float z = ba;
#pragma unroll
            for (int q = 0; q < 16; ++q) z += cs[row * 132 + q] * wa[q];
            cum += logsig(z) * (1.f / 16.f);
            bc[(size_t)row * 64] = cum;
            o[q4] = cum;
          }
          *(f32x4*)(bct + ch * 64 + r4 * 4) = o;
        }
      }
    }
  }
}

DI int t5_bucket(int rel) {
  if (rel < 16) return rel;
  int bkt = 16;
  bkt += (rel >= 19); bkt += (rel >= 21); bkt += (rel >= 24); bkt += (rel >= 27); bkt += (rel >= 31); bkt += (rel >= 35); bkt += (rel >= 40);
  bkt += (rel >= 46); bkt += (rel >= 52); bkt += (rel >= 59); bkt += (rel >= 67); bkt += (rel >= 77); bkt += (rel >= 87); bkt += (rel >= 99); bkt += (rel >= 113);
  return bkt;
}

struct MobaState { f32x16 o0, o1; float m, l; };

template <int MODE>
DI void moba_subtile(MobaState& st, const bf16x8 (&qf)[4], const u16* kbase, const u16* vbase, int kpos0, int qpos, bool sel,
                     const float* lut, float cb31, int r, int h5) {
  const float NEG = -__builtin_inff();
  f32x16 s;
#pragma unroll
  for (int i = 0; i < 16; ++i) s[i] = 0.f;
  const u16* kp = kbase + (size_t)(kpos0 + r) * 64 + h5 * 8;
#pragma unroll
  for (int ks = 0; ks < 4; ++ks) s = MFMA32(*(const bf16x8*)(kp + ks * 16), qf[ks], s);
  const float c1 = 0.125f * LOG2E;
  float t[16]; float tm = NEG;
#pragma unroll
  for (int i = 0; i < 16; ++i) {
    float tv;
    if (MODE == 0) tv = s[i] * c1 + cb31;
    else {
      const int rel = qpos - (kpos0 + crow(i, h5));
      const float bias = (rel >= 128) ? cb31 : lut[rel < 0 ? 0 : rel];
      tv = s[i] * c1 + bias;
      if (MODE == 2 && rel < 0) tv = NEG;
    }
    if (!sel) tv = NEG;
    t[i] = tv; tm = fmaxf(tm, tv);
  }
  tm = fmaxf(tm, __shfl_xor(tm, 32));
  const float mn = fmaxf(st.m, tm);
  const float mu = (mn == NEG) ? 0.f : mn;
  const float alpha = exp2f(st.m - mu);
  float psum = 0.f;
#pragma unroll
  for (int i = 0; i < 16; ++i) { t[i] = exp2f(t[i] - mu); psum += t[i]; }
  st.l = st.l * alpha + psum; st.m = mn;
#pragma unroll
  for (int i = 0; i < 16; ++i) { st.o0[i] *= alpha; st.o1[i] *= alpha; }
  const bf16x8 pf0 = __builtin_bit_cast(bf16x8, pack8(t[0], t[1], t[2], t[3], t[4], t[5], t[6], t[7]));
  const bf16x8 pf1 = __builtin_bit_cast(bf16x8, pack8(t[8], t[9], t[10], t[11], t[12], t[13], t[14], t[15]));
#pragma unroll
  for (int s2 = 0; s2 < 2; ++s2) {
#pragma unroll
    for (int dt = 0; dt < 2; ++dt) {
      const u16* vp = vbase + (size_t)(dt * 32 + r) * S + kpos0 + 16 * s2 + 4 * h5;
      const u32x2 lo = *(const u32x2*)vp, hi = *(const u32x2*)(vp + 8);
      u32x4 vv = {lo[0], lo[1], hi[0], hi[1]};
      const bf16x8 vf = __builtin_bit_cast(bf16x8, vv);
      if (dt == 0) st.o0 = MFMA32(vf, s2 ? pf1 : pf0, st.o0); else st.o1 = MFMA32(vf, s2 ? pf1 : pf0, st.o1);
    }
  }
}

DI void phase_moba(const Params& p, char* smem, int task_lo, int task_hi) {
  const int tid = threadIdx.x, lane = tid & 63, w = tid >> 6, r = lane & 31, h5 = lane >> 5;
  float* lut = (float*)smem;
  const float NEG = -__builtin_inff();
  const u16* mq = (const u16*)(p.ws + OFF_MQ);
  const u16* mk = (const u16*)(p.ws + OFF_MK);
  const u16* vT = (const u16*)(p.ws + OFF_VT);
  const float* kmean = (const float*)(p.ws + OFF_KMEAN);
  u16* mix = (u16*)(p.ws + OFF_MIX);
  for (int task = task_lo + blockIdx.x; task < task_hi; task += gridDim.x) {
    const int blk = 15 - (task >> 6), rem = task & 63, bh = rem >> 1, half = rem & 1, hd = bh & 7, b = bh >> 3;
    __syncthreads();
    if (tid < 128) lut[tid] = p.rel_bias[t5_bucket(tid) * 8 + hd] * LOG2E;
    __syncthreads();
    const float cb31 = p.rel_bias[31 * 8 + hd] * LOG2E;
    const int qpos = blk * 256 + half * 128 + w * 32 + r;
    const u16* qptr = mq + ((size_t)bh * S + qpos) * 64 + h5 * 8;
    bf16x8 qf[4];
#pragma unroll
    for (int ks = 0; ks < 4; ++ks) qf[ks] = *(const bf16x8*)(qptr + ks * 16);
    unsigned selmask = 0;
    if (blk > 0) {
      f32x16 g;
#pragma unroll
      for (int i = 0; i < 16; ++i) g[i] = 0.f;
      const int n = r < 15 ? r : 15;
      const float* kmp = kmean + ((size_t)bh * 16 + n) * 64 + h5 * 8;
#pragma unroll
      for (int ks = 0; ks < 4; ++ks) {
        const f32x4 v0 = *(const f32x4*)(kmp + ks * 16), v1 = *(const f32x4*)(kmp + ks * 16 + 4);
        const u32x4 hi = pack8(v0[0], v0[1], v0[2], v0[3], v1[0], v1[1], v1[2], v1[3]);
        const u32x4 lo = pack8(v0[0] - bflo(hi[0]), v0[1] - bfhi(hi[0]), v0[2] - bflo(hi[1]), v0[3] - bfhi(hi[1]),
                               v1[0] - bflo(hi[2]), v1[1] - bfhi(hi[2]), v1[2] - bflo(hi[3]), v1[3] - bfhi(hi[3]));
        g = MFMA32(__builtin_bit_cast(bf16x8, hi), qf[ks], g);
        g = MFMA32(__builtin_bit_cast(bf16x8, lo), qf[ks], g);
      }
      float gt[16];
#pragma unroll
      for (int nn = 0; nn < 16; ++nn) {
        const int x = (nn >> 2) & 1, rr = (nn & 3) + 4 * (nn >> 3);
        const float own = g[rr];
        const float par = __shfl_xor(own, 32);
        gt[nn] = (h5 == x) ? own : par;
      }
#pragma unroll
      for (int it = 0; it < 3; ++it) {
        float best = NEG; int bi = -1;
#pragma unroll
        for (int nn = 0; nn < 16; ++nn) {
          const bool ok = (nn < blk) && !((selmask >> nn) & 1u);
          if (ok && gt[nn] > best) { best = gt[nn]; bi = nn; }
        }
        if (bi >= 0) selmask |= 1u << bi;
      }
    }
    unsigned umask = 0;
    for (int nn = 0; nn < blk; ++nn) if (__any((int)((selmask >> nn) & 1u))) umask |= 1u << nn;
    MobaState st;
#pragma unroll
    for (int i = 0; i < 16; ++i) { st.o0[i] = 0.f; st.o1[i] = 0.f; }
    st.m = NEG; st.l = 0.f;
    const u16* kbase = mk + (size_t)bh * S * 64;
    const u16* vbase = vT + (size_t)bh * 64 * S;
    for (int nn = 0; nn < blk; ++nn) {
      if (!((umask >> nn) & 1u)) continue;
      const bool sel = (selmask >> nn) & 1u;
      if (nn == blk - 1) {
        for (int kt = 0; kt < 8; ++kt) moba_subtile<1>(st, qf, kbase, vbase, nn * 256 + kt * 32, qpos, sel, lut, cb31, r, h5);
      } else {
        for (int kt = 0; kt < 8; ++kt) moba_subtile<0>(st, qf, kbase, vbase, nn * 256 + kt * 32, qpos, sel, lut, cb31, r, h5);
      }
    }
    const int ktmax = half * 4 + w;
    for (int kt = 0; kt <= ktmax; ++kt) moba_subtile<2>(st, qf, kbase, vbase, blk * 256 + kt * 32, qpos, true, lut, cb31, r, h5);
    float l = st.l + __shfl_xor(st.l, 32);
    const float inv = 1.f / l;
    float ssq = 0.f;
#pragma unroll
    for (int i = 0; i < 16; ++i) { st.o0[i] *= inv; st.o1[i] *= inv; ssq += st.o0[i] * st.o0[i] + st.o1[i] * st.o1[i]; }
    ssq += __shfl_xor(ssq, 32);
    const float rs = rsqrtf(ssq * (1.f / 64.f) + EPS);
    u16* op = mix + (size_t)(b * S + qpos) * 1024 + hd * 64;
#pragma unroll
    for (int dt = 0; dt < 2; ++dt)
#pragma unroll
      for (int g4 = 0; g4 < 4; ++g4) {
        const int d0 = dt * 32 + 8 * g4 + 4 * h5;
        const f32x4 mw = *(const f32x4*)(p.moba_out_w + d0);
        float o[4];
#pragma unroll
        for (int q = 0; q < 4; ++q) o[q] = (dt ? st.o1[4 * g4 + q] : st.o0[4 * g4 + q]) * rs * mw[q];
        u32x2 pk = {pack2(o[0], o[1]), pack2(o[2], o[3])};
        *(u32x2*)(op + d0) = pk;
      }
  }
}

DI void phase_gla_a(const Params& p) {
  const int tid = threadIdx.x, lane = tid & 63, w = tid >> 6, r = lane & 31, h5 = lane >> 5;
  const u16* gkT = (const u16*)(p.ws + OFF_GKT);
  const u16* gvT = (const u16*)(p.ws + OFF_GVT);
  const float* bcT = (const float*)(p.ws + OFF_BCT);
  float* UT = (float*)(p.ws + OFF_UT);
  float* dec = (float*)(p.ws + OFF_DEC);
  for (int task = blockIdx.x; task < 1024; task += gridDim.x) {
    const int bh = task >> 6, c = task & 63;
    f32x16 acc[2];
#pragma unroll
    for (int i = 0; i < 16; ++i) { acc[0][i] = 0.f; acc[1][i] = 0.f; }
    const u16* vp = gvT + ((size_t)bh * 128 + w * 32 + r) * S + c * 64 + h5 * 8;
#pragma unroll
    for (int dt = 0; dt < 2; ++dt) {
      const int d = dt * 32 + r;
      const float* bp = bcT + ((size_t)bh * 64 + d) * S + c * 64;
      const u16* kp = gkT + ((size_t)bh * 64 + d) * S + c * 64;
      const float bl = bp[63];
      if (w == 0 && h5 == 0) dec[((size_t)bh * 64 + c) * 64 + d] = __expf(bl);
#pragma unroll
      for (int ks = 0; ks < 4; ++ks) {
        const u32x4 kk = *(const u32x4*)(kp + ks * 16 + h5 * 8);
        const f32x4 b0 = *(const f32x4*)(bp + ks * 16 + h5 * 8), b1 = *(const f32x4*)(bp + ks * 16 + h5 * 8 + 4);
        const u32x4 kh = pack8(bflo(kk[0]) * __expf(bl - b0[0]), bfhi(kk[0]) * __expf(bl - b0[1]), bflo(kk[1]) * __expf(bl - b0[2]), bfhi(kk[1]) * __expf(bl - b0[3]),
                               bflo(kk[2]) * __expf(bl - b1[0]), bfhi(kk[2]) * __expf(bl - b1[1]), bflo(kk[3]) * __expf(bl - b1[2]), bfhi(kk[3]) * __expf(bl - b1[3]));
        const bf16x8 vf = *(const bf16x8*)(vp + ks * 16);
        acc[dt] = MFMA32(vf, __builtin_bit_cast(bf16x8, kh), acc[dt]);
      }
    }
    float* up = UT + ((size_t)bh * 64 + c) * 128 * 64;
#pragma unroll
    for (int dt = 0; dt < 2; ++dt)
#pragma unroll
      for (int i = 0; i < 16; ++i) up[(size_t)(w * 32 + crow(i, h5)) * 64 + dt * 32 + r] = acc[dt][i];
  }
}

DI void phase_gla_b(const Params& p) {
  const float* UT = (const float*)(p.ws + OFF_UT);
  const float* dec = (const float*)(p.ws + OFF_DEC);
  u16* ST = (u16*)(p.ws + OFF_ST);
  for (int i = blockIdx.x * 256 + threadIdx.x; i < 16 * 128 * 16; i += gridDim.x * 256) {
    const int d4 = (i & 15) * 4, v = (i >> 4) & 127, bh = i >> 11;
    f32x4 st = {0.f, 0.f, 0.f, 0.f};
#pragma unroll 8
    for (int c = 0; c < 64; ++c) {
      const size_t o = (((size_t)bh * 64 + c) * 128 + v) * 64 + d4;
      const f32x4 u = *(const f32x4*)(UT + o);
      const f32x4 a = *(const f32x4*)(dec + ((size_t)bh * 64 + c) * 64 + d4);
      u32x2 pk = {pack2(st[0], st[1]), pack2(st[2], st[3])};
      *(u32x2*)(ST + o) = pk;
      st[0] = a[0] * st[0] + u[0]; st[1] = a[1] * st[1] + u[1]; st[2] = a[2] * st[2] + u[2]; st[3] = a[3] * st[3] + u[3];
    }
  }
}

DI void phase_gla_c(const Params& p) {
  const int tid = threadIdx.x, lane = tid & 63, w = tid >> 6, r = lane & 31, h5 = lane >> 5;
  const u16* gq = (const u16*)(p.ws + OFF_GQ);
  const u16* gk = (const u16*)(p.ws + OFF_GK);
  const u16* gvT = (const u16*)(p.ws + OFF_GVT);
  const float* bc = (const float*)(p.ws + OFF_BC);
  const u16* ST = (const u16*)(p.ws + OFF_ST);
  const u16* sg = (const u16*)(p.ws + OFF_SG);
  u16* mix = (u16*)(p.ws + OFF_MIX);
  for (int task = blockIdx.x; task < 512; task += gridDim.x) {
    const int bh = task >> 5, c = (task & 31) * 2 + (w >> 1), ih = w & 1, b = bh >> 2, hd = bh & 3;
    const int tpos = c * 64 + ih * 32 + r;
    bf16x8 qt[4];
    {
      const u16* qp = gq + ((size_t)bh * S + tpos) * 64 + h5 * 8;
      const float* bp = bc + ((size_t)bh * S + tpos) * 64 + h5 * 8;
#pragma unroll
      for (int ks = 0; ks < 4; ++ks) {
        const u32x4 qq = *(const u32x4*)(qp + ks * 16);
        const f32x4 b0 = *(const f32x4*)(bp + ks * 16), b1 = *(const f32x4*)(bp + ks * 16 + 4);
        qt[ks] = __builtin_bit_cast(bf16x8, pack8(bflo(qq[0]) * __expf(b0[0]), bfhi(qq[0]) * __expf(b0[1]), bflo(qq[1]) * __expf(b0[2]), bfhi(qq[1]) * __expf(b0[3]),
                                                 bflo(qq[2]) * __expf(b1[0]), bfhi(qq[2]) * __expf(b1[1]), bflo(qq[3]) * __expf(b1[2]), bfhi(qq[3]) * __expf(b1[3])));
      }
    }
    f32x16 oacc[4];
#pragma unroll
    for (int vt = 0; vt < 4; ++vt)
#pragma unroll
      for (int i = 0; i < 16; ++i) oacc[vt][i] = 0.f;
#pragma unroll
    for (int jt = 0; jt < 2; ++jt) {
      if (jt <= ih) {
        f32x16 X;
#pragma unroll
        for (int i = 0; i < 16; ++i) X[i] = 0.f;
        const int jpos = c * 64 + jt * 32 + r;
        const u16* kp = gk + ((size_t)bh * S + jpos) * 64 + h5 * 8;
        const float* bp = bc + ((size_t)bh * S + jpos) * 64 + h5 * 8;
#pragma unroll
        for (int ks = 0; ks < 4; ++ks) {
          const u32x4 kk = *(const u32x4*)(kp + ks * 16);
          const f32x4 b0 = *(const f32x4*)(bp + ks * 16), b1 = *(const f32x4*)(bp + ks * 16 + 4);
          const u32x4 kt = pack8(bflo(kk[0]) * __expf(-b0[0]), bfhi(kk[0]) * __expf(-b0[1]), bflo(kk[1]) * __expf(-b0[2]), bfhi(kk[1]) * __expf(-b0[3]),
                                 bflo(kk[2]) * __expf(-b1[0]), bfhi(kk[2]) * __expf(-b1[1]), bflo(kk[3]) * __expf(-b1[2]), bfhi(kk[3]) * __expf(-b1[3]));
          X = MFMA32(__builtin_bit_cast(bf16x8, kt), qt[ks], X);
        }
        if (jt == ih) {
#pragma unroll
          for (int i = 0; i < 16; ++i) if (crow(i, h5) > r) X[i] = 0.f;
        }
        const bf16x8 pf0 = __builtin_bit_cast(bf16x8, pack8(X[0], X[1], X[2], X[3], X[4], X[5], X[6], X[7]));
        const bf16x8 pf1 = __builtin_bit_cast(bf16x8, pack8(X[8], X[9], X[10], X[11], X[12], X[13], X[14], X[15]));
#pragma unroll
        for (int vt = 0; vt < 4; ++vt) {
#pragma unroll
          for (int s2 = 0; s2 < 2; ++s2) {
            const u16* vp = gvT + ((size_t)bh * 128 + vt * 32 + r) * S + c * 64 + jt * 32 + 16 * s2 + 4 * h5;
            const u32x2 lo = *(const u32x2*)vp, hi = *(const u32x2*)(vp + 8);
            u32x4 vv = {lo[0], lo[1], hi[0], hi[1]};
            oacc[vt] = MFMA32(__builtin_bit_cast(bf16x8, vv), s2 ? pf1 : pf0, oacc[vt]);
          }
        }
      }
    }
    {
      const u16* sp = ST + (((size_t)bh * 64 + c) * 128 + r) * 64 + h5 * 8;
#pragma unroll
      for (int vt = 0; vt < 4; ++vt)
#pragma unroll
        for (int ks = 0; ks < 4; ++ks) oacc[vt] = MFMA32(*(const bf16x8*)(sp + (size_t)vt * 32 * 64 + ks * 16), qt[ks], oacc[vt]);
    }
    float ssq = 0.f;
#pragma unroll
    for (int vt = 0; vt < 4; ++vt)
#pragma unroll
      for (int i = 0; i < 16; ++i) ssq += oacc[vt][i] * oacc[vt][i];
    ssq += __shfl_xor(ssq, 32);
    const float rs = rsqrtf(ssq * (1.f / 128.f) + EPS);
    const size_t t = (size_t)b * S + tpos;
    const u16* sgp = sg + t * 512 + hd * 128;
    u16* op = mix + t * 1024 + 512 + hd * 128;
#pragma unroll
    for (int vt = 0; vt < 4; ++vt)
#pragma unroll
      for (int g4 = 0; g4 < 4; ++g4) {
        const int v0 = vt * 32 + 8 * g4 + 4 * h5;
        const f32x4 gw = *(const f32x4*)(p.gla_out_w + v0);
        const u32x2 sv = *(const u32x2*)(sgp + v0);
        const float o0 = oacc[vt][4 * g4 + 0] * rs * gw[0] * bflo(sv[0]);
        const float o1 = oacc[vt][4 * g4 + 1] * rs * gw[1] * bfhi(sv[0]);
        const float o2 = oacc[vt][4 * g4 + 2] * rs * gw[2] * bflo(sv[1]);
        const float o3 = oacc[vt][4 * g4 + 3] * rs * gw[3] * bfhi(sv[1]);
        u32x2 pk = {pack2(o0, o1), pack2(o2, o3)};
        *(u32x2*)(op + v0) = pk;
      }
  }
}

DI void phase6(const Params& p, char* smem) {
  const int tid = threadIdx.x, lane = tid & 63, w = tid >> 6, wm = w >> 1, wn = w & 1, r = lane & 31, h5 = lane >> 5;
  const int g = blockIdx.x & 7, j = blockIdx.x >> 3, nj = gridDim.x >> 3;
  const u16* mix = (const u16*)(p.ws + OFF_MIX);
  const float* mod = (const float*)(p.ws + OFF_MOD);
  float* x1 = (float*)(p.ws + OFF_X1);
  for (int mtile = j; mtile < 128; mtile += nj) {
    const int ntile = g, row0 = mtile * 128, b = row0 >> 12;
    ALoadBf16 al; BLoadF32 bl;
#pragma unroll
    for (int i = 0; i < 4; ++i) al.rp[i] = mix + (size_t)(row0 + (tid >> 3) + 32 * i) * 1024 + (tid & 7) * 8;
    bl.valid = true; bl.ldb = 1024;
    bl.p = p.w_out + (size_t)((tid >> 5) * 8) * 1024 + ntile * 128 + (tid & 31) * 4;
    f32x16 acc[2][2];
    gemm_mainloop(al, bl, 16, smem, acc);
#pragma unroll
    for (int mt = 0; mt < 2; ++mt)
#pragma unroll
      for (int nt = 0; nt < 2; ++nt) {
        const int col = ntile * 128 + wn * 64 + nt * 32 + r;
        const float g1 = mod[b * 6144 + 2048 + col];
#pragma unroll
        for (int i = 0; i < 16; ++i) {
          const size_t o = (size_t)(row0 + wm * 64 + mt * 32 + crow(i, h5)) * 1024 + col;
          x1[o] = p.x[o] + g1 * acc[mt][nt][i];
        }
      }
  }
}

DI void phase7(const Params& p, char* smem) {
  const int tid = threadIdx.x, lane = tid & 63, w = tid >> 6, r = lane & 31, h5 = lane >> 5;
  const float NEG = -__builtin_inff();
  const float* x1 = (const float*)(p.ws + OFF_X1);
  const float* mod = (const float*)(p.ws + OFF_MOD);
  u16* h2b = (u16*)(p.ws + OFF_H2B);
  const u16* wrT = (const u16*)(p.ws + OFF_WRT);
  int* cnt = (int*)(p.ws + OFF_CNT);
  int* list = (int*)(p.ws + OFF_LIST);
  float* topw = (float*)(p.ws + OFF_TOPW);
  float* lg = (float*)smem;
  for (int task = blockIdx.x; task < 512; task += gridDim.x) {
    const int row0 = task * 32, b = row0 >> 12;
    __syncthreads();
    {
      f32x4 gm[4], sh[4];
#pragma unroll
      for (int i = 0; i < 4; ++i) {
        const int k = i * 256 + lane * 4;
        const f32x4 nw = *(const f32x4*)(p.norm2_w + k);
        const f32x4 sc = *(const f32x4*)(mod + b * 6144 + 4096 + k);
        sh[i] = *(const f32x4*)(mod + b * 6144 + 3072 + k);
#pragma unroll
        for (int q = 0; q < 4; ++q) gm[i][q] = nw[q] * (1.f + sc[q]);
      }
#pragma unroll 1
      for (int rr = 0; rr < 8; ++rr) {
        const int row = w * 8 + rr; const size_t t = row0 + row;
        f32x4 xv[4]; float ssq = 0.f;
#pragma unroll
        for (int i = 0; i < 4; ++i) {
          xv[i] = *(const f32x4*)(x1 + t * 1024 + i * 256 + lane * 4);
          ssq += xv[i][0] * xv[i][0] + xv[i][1] * xv[i][1] + xv[i][2] * xv[i][2] + xv[i][3] * xv[i][3];
        }
        ssq = wave_sum(ssq);
        const float rn = rsqrtf(ssq * (1.f / 1024.f) + EPS);
#pragma unroll
        for (int i = 0; i < 4; ++i) {
          const int k = i * 256 + lane * 4;
          float o[4];
#pragma unroll
          for (int q = 0; q < 4; ++q) o[q] = xv[i][q] * rn * gm[i][q] + sh[i][q];
          u32x2 pk = {pack2(o[0], o[1]), pack2(o[2], o[3])};
          *(u32x2*)(h2b + t * 1024 + k) = pk;
          *(u32x2*)(smem + row * 2064 + k * 2) = pk;
        }
      }
    }
    __syncthreads();
    f32x16 acc[2];
#pragma unroll
    for (int i = 0; i < 16; ++i) { acc[0][i] = 0.f; acc[1][i] = 0.f; }
    {
      const char* ap = smem + r * 2064 + h5 * 16;
      const u16* bp0 = wrT + (size_t)(w * 64 + r) * 1024 + h5 * 8;
      const u16* bp1 = bp0 + 32 * 1024;
#pragma unroll 4
      for (int ks = 0; ks < 64; ++ks) {
        const bf16x8 a = *(const bf16x8*)(ap + ks * 32);
        acc[0] = MFMA32(a, *(const bf16x8*)(bp0 + ks * 16), acc[0]);
        acc[1] = MFMA32(a, *(const bf16x8*)(bp1 + ks * 16), acc[1]);
      }
    }
    __syncthreads();
#pragma unroll
    for (int nt = 0; nt < 2; ++nt)
#pragma unroll
      for (int i = 0; i < 16; ++i) lg[crow(i, h5) * 256 + w * 64 + nt * 32 + r] = acc[nt][i];
    __syncthreads();
    const f32x4 eb = *(const f32x4*)(p.e_bias + lane * 4);
#pragma unroll 1
    for (int rr = 0; rr < 8; ++rr) {
      const int row = w * 8 + rr; const int t = row0 + row;
      const f32x4 lv = *(const f32x4*)(lg + row * 256 + lane * 4);
      float sc[4], ch[4];
#pragma unroll
      for (int q = 0; q < 4; ++q) { sc[q] = 1.f / (1.f + __expf(-lv[q])); ch[q] = sc[q] + eb[q]; }
      float m1 = fmaxf(ch[0], ch[1]), m2 = fminf(ch[0], ch[1]);
#pragma unroll
      for (int q = 2; q < 4; ++q) { const float v = ch[q]; m2 = fmaxf(m2, fminf(m1, v)); m1 = fmaxf(m1, v); }
#pragma unroll
      for (int sft = 1; sft < 8; sft <<= 1) {
        const float o1 = __shfl_xor(m1, sft), o2 = __shfl_xor(m2, sft);
        const float n1 = fmaxf(m1, o1); const float n2 = fmaxf(fminf(m1, o1), fmaxf(m2, o2));
        m1 = n1; m2 = n2;
      }
      const float gs = m1 + m2; const int mygrp = lane >> 3;
      int rank = 0;
#pragma unroll
      for (int q = 0; q < 8; ++q) { const float og = __shfl(gs, q * 8); rank += (og > gs || (og == gs && q < mygrp)) ? 1 : 0; }
      const bool allowed = rank < 4;
      float cand[4];
#pragma unroll
      for (int q = 0; q < 4; ++q) cand[q] = allowed ? ch[q] : NEG;
      float wsel = 0.f; int esel = 0; float wsum = 0.f;
#pragma unroll 1
      for (int k = 0; k < 8; ++k) {
        float bv = cand[0]; int bi = lane * 4;
#pragma unroll
        for (int q = 1; q < 4; ++q) if (cand[q] > bv) { bv = cand[q]; bi = lane * 4 + q; }
#pragma unroll
        for (int sft = 32; sft >= 1; sft >>= 1) {
          const float ov = __shfl_xor(bv, sft); const int oi = __shfl_xor(bi, sft);
          if (ov > bv || (ov == bv && oi < bi)) { bv = ov; bi = oi; }
        }
        float sv = 0.f;
        if ((bi >> 2) == lane) {
#pragma unroll
          for (int q = 0; q < 4; ++q) if ((bi & 3) == q) { sv = sc[q]; cand[q] = NEG; }
        }
        sv = __shfl(sv, bi >> 2);
        wsum += sv;
        if (lane == k) { wsel = sv; esel = bi; }
      }
      if (lane < 8) {
        const float wgt = wsel / wsum * 2.5f;
        const int pos = atomicAdd(&cnt[esel], 1);
        list[(size_t)esel * LISTCAP + pos] = t * 8 + lane;
        topw[t * 8 + lane] = wgt;
      }
    }
  }
}

DI int perm_e(int o) { return (o & 31) * 8 + (o >> 5); }
DI void build_tables(const Params& p, int* tbl) {
  const int tid = threadIdx.x;
  const int* cnt = (const int*)(p.ws + OFF_CNT);
  __syncthreads();
  tbl[520 + tid] = cnt[perm_e(tid)];
  __syncthreads();
  int tp = 0, rp = 0;
  for (int o = 0; o < tid; ++o) { const int cc = tbl[520 + o]; tp += (cc + 127) >> 7; rp += cc; }
  tbl[tid] = tp; tbl[260 + tid] = rp;
  if (tid == 255) { const int cc = tbl[520 + 255]; tbl[256] = tp + ((cc + 127) >> 7); tbl[260 + 256] = rp + cc; }
  __syncthreads();
}
DI int find_o(const int* tbl, int g, int tile) {
  int lo = 32 * g, hi = 32 * g + 31;
  while (lo < hi) { const int mid = (lo + hi + 1) >> 1; if (tbl[mid] <= tile) lo = mid; else hi = mid - 1; }
  return lo;
}

DI void phase8(const Params& p, char* smem) {
  const int tid = threadIdx.x, lane = tid & 63, w = tid >> 6, wm = w >> 1, wn = w & 1, r = lane & 31, h5 = lane >> 5;
  const int g = blockIdx.x & 7, j = blockIdx.x >> 3, nj = gridDim.x >> 3;
  int* tbl = (int*)(smem + LDS_TBL);
  build_tables(p, tbl);
  const u16* h2b = (const u16*)(p.ws + OFF_H2B);
  const int* list = (const int*)(p.ws + OFF_LIST);
  const int t0 = tbl[32 * g], ntl = tbl[32 * g + 32] - t0;
  const int ntask = ntl * 4 + 64;
  for (int id = j; id < ntask; id += nj) {
    int e, mtile, nchunk, cnt_e, rowbase;
    if (id < ntl * 4) {
      const int tile = t0 + (id >> 2); nchunk = id & 3;
      const int o = find_o(tbl, g, tile);
      e = perm_e(o); mtile = tile - tbl[o]; cnt_e = tbl[520 + o]; rowbase = tbl[260 + o];
    } else {
      const int sid = id - ntl * 4; e = 256; mtile = 16 * g + (sid >> 2); nchunk = sid & 3; cnt_e = T; rowbase = 0;
    }
    ALoadBf16 al; BLoadF32 bl;
#pragma unroll
    for (int i = 0; i < 4; ++i) {
      const int rr = mtile * 128 + (tid >> 3) + 32 * i;
      int tok = 0;
      if (rr < cnt_e) tok = (e < 256) ? (list[(size_t)e * LISTCAP + rr] >> 3) : rr;
      al.rp[i] = h2b + (size_t)tok * 1024 + (tid & 7) * 8;
    }
    {
      const int n4 = (tid & 31) * 4, kg = tid >> 5;
      const int twn = n4 >> 6, tnt = (n4 >> 5) & 1, jj = n4 & 31;
      const int col = nchunk * 64 + twn * 32 + jj;
      const float* base = (e < 256) ? ((tnt ? p.w3 : p.w1) + (size_t)e * 1024 * 256) : (tnt ? p.ws3 : p.ws1);
      bl.valid = true; bl.ldb = 256; bl.p = base + (size_t)(kg * 8) * 256 + col;
    }
    f32x16 acc[2][2];
    gemm_mainloop(al, bl, 16, smem, acc);
    u16* actp = (e < 256) ? ((u16*)(p.ws + OFF_ACT) + (size_t)rowbase * 256) : (u16*)(p.ws + OFF_ACTS);
#pragma unroll
    for (int mt = 0; mt < 2; ++mt)
#pragma unroll
      for (int i = 0; i < 16; ++i) {
        const int rr = mtile * 128 + wm * 64 + mt * 32 + crow(i, h5);
        if (rr < cnt_e) {
          const float a1 = acc[mt][0][i], a3 = acc[mt][1][i];
          const float v = siluf(a1) * a3;
          actp[(size_t)rr * 256 + nchunk * 64 + wn * 32 + r] = (u16)(pack2(v, 0.f) & 0xffffu);
        }
      }
  }
}

DI void phase9(const Params& p, char* smem) {
  const int tid = threadIdx.x, lane = tid & 63, w = tid >> 6, wm = w >> 1, wn = w & 1, r = lane & 31, h5 = lane >> 5;
  const int g = blockIdx.x & 7, j = blockIdx.x >> 3, nj = gridDim.x >> 3;
  int* tbl = (int*)(smem + LDS_TBL);
  build_tables(p, tbl);
  const int* list = (const int*)(p.ws + OFF_LIST);
  const float* topw = (const float*)(p.ws + OFF_TOPW);
  u16* y = (u16*)(p.ws + OFF_Y);
  const int t0 = tbl[32 * g], ntl = tbl[32 * g + 32] - t0;
  const int ntask = ntl * 8;
  for (int id = j; id < ntask; id += nj) {
    const int tile = t0 + (id >> 3), ntile = id & 7;
    const int o = find_o(tbl, g, tile);
    const int e = perm_e(o), mtile = tile - tbl[o], cnt_e = tbl[520 + o], rowbase = tbl[260 + o];
    const u16* actp = (const u16*)(p.ws + OFF_ACT) + (size_t)rowbase * 256;
    ALoadBf16 al; BLoadF32 bl;
#pragma unroll
    for (int i = 0; i < 4; ++i) {
      int rr = mtile * 128 + (tid >> 3) + 32 * i;
      if (rr >= cnt_e) rr = 0;
      al.rp[i] = actp + (size_t)rr * 256 + (tid & 7) * 8;
    }
    bl.valid = true; bl.ldb = 1024;
    bl.p = p.w2 + (size_t)e * 256 * 1024 + (size_t)((tid >> 5) * 8) * 1024 + ntile * 128 + (tid & 31) * 4;
    f32x16 acc[2][2];
    gemm_mainloop(al, bl, 4, smem, acc);
#pragma unroll
    for (int mt = 0; mt < 2; ++mt)
#pragma unroll
      for (int i = 0; i < 16; ++i) {
        const int rr = mtile * 128 + wm * 64 + mt * 32 + crow(i, h5);
        if (rr < cnt_e) {
          const int asg = list[(size_t)e * LISTCAP + rr];
          const float wg = topw[asg];
          u16* yp = y + (size_t)asg * 1024 + ntile * 128 + wn * 64 + r;
          yp[0] = (u16)(pack2(acc[mt][0][i] * wg, 0.f) & 0xffffu);
          yp[32] = (u16)(pack2(acc[mt][1][i] * wg, 0.f) & 0xffffu);
        }
      }
  }
}

DI void phase10(const Params& p, char* smem) {
  const int tid = threadIdx.x;
  const int g = blockIdx.x & 7, j = blockIdx.x >> 3, nj = gridDim.x >> 3;
  const u16* acts = (const u16*)(p.ws + OFF_ACTS);
  const u16* y = (const u16*)(p.ws + OFF_Y);
  const float* x1 = (const float*)(p.ws + OFF_X1);
  const float* mod = (const float*)(p.ws + OFF_MOD);
  float* cs = (float*)smem;
  for (int mtile = j; mtile < 128; mtile += nj) {
    const int ntile = g, row0 = mtile * 128, b = row0 >> 12;
    ALoadBf16 al; BLoadF32 bl;
#pragma unroll
    for (int i = 0; i < 4; ++i) al.rp[i] = acts + (size_t)(row0 + (tid >> 3) + 32 * i) * 256 + (tid & 7) * 8;
    bl.valid = true; bl.ldb = 1024;
    bl.p = p.ws2 + (size_t)((tid >> 5) * 8) * 1024 + ntile * 128 + (tid & 31) * 4;
    f32x16 acc[2][2];
    gemm_mainloop(al, bl, 4, smem, acc);
    stage_nat(cs, acc);
    __syncthreads();
#pragma unroll 1
    for (int it = 0; it < 8; ++it) {
      const int i = it * 256 + tid, row = i >> 4, c8 = (i & 15) * 8;
      const size_t t = row0 + row; const int col = ntile * 128 + c8;
      float v[8];
      {
        const f32x4 va = *(const f32x4*)(cs + row * 132 + c8), vb = *(const f32x4*)(cs + row * 132 + c8 + 4);
        v[0] = va[0]; v[1] = va[1]; v[2] = va[2]; v[3] = va[3]; v[4] = vb[0]; v[5] = vb[1]; v[6] = vb[2]; v[7] = vb[3];
      }
#pragma unroll
      for (int k = 0; k < 8; ++k) {
        const u32x4 yy = *(const u32x4*)(y + (t * 8 + k) * 1024 + col);
        v[0] += bflo(yy[0]); v[1] += bfhi(yy[0]); v[2] += bflo(yy[1]); v[3] += bfhi(yy[1]);
        v[4] += bflo(yy[2]); v[5] += bfhi(yy[2]); v[6] += bflo(yy[3]); v[7] += bfhi(yy[3]);
      }
      const f32x4 g2a = *(const f32x4*)(mod + b * 6144 + 5120 + col), g2b = *(const f32x4*)(mod + b * 6144 + 5120 + col + 4);
      const f32x4 xa = *(const f32x4*)(x1 + t * 1024 + col), xb = *(const f32x4*)(x1 + t * 1024 + col + 4);
      f32x4 oa = {xa[0] + g2a[0] * v[0], xa[1] + g2a[1] * v[1], xa[2] + g2a[2] * v[2], xa[3] + g2a[3] * v[3]};
      f32x4 ob = {xb[0] + g2b[0] * v[4], xb[1] + g2b[1] * v[5], xb[2] + g2b[2] * v[6], xb[3] + g2b[3] * v[7]};
      *(f32x4*)(p.out + t * 1024 + col) = oa;
      *(f32x4*)(p.out + t * 1024 + col + 4) = ob;
    }
  }
}

#if !FUSED
#define PHASE_KERNEL(name, body)                                                 \
  __global__ void __launch_bounds__(256, 2) name(Params p) {                     \
    __shared__ __attribute__((aligned(16))) char smem[LDS_BYTES];                \
    body;                                                                        \
  }
PHASE_KERNEL(k_p0, phase0(p, smem))
PHASE_KERNEL(k_p1, phase1(p); (void)smem)
PHASE_KERNEL(k_p2, phase2(p, smem))
PHASE_KERNEL(k_p3, phase_moba(p, smem, 0, 1024); phase_gla_a(p))
PHASE_KERNEL(k_p4, phase_gla_b(p); (void)smem)
PHASE_KERNEL(k_p5, phase_gla_c(p); (void)smem)
PHASE_KERNEL(k_p6, phase6(p, smem))
PHASE_KERNEL(k_p7, phase7(p, smem))
PHASE_KERNEL(k_p8, phase8(p, smem))
PHASE_KERNEL(k_p9, phase9(p, smem))
PHASE_KERNEL(k_p10, phase10(p, smem))
#else
__global__ void __launch_bounds__(256, 2) k_fused(Params p) {
  __shared__ __attribute__((aligned(16))) char smem[LDS_BYTES];
  cg::grid_group grid = cg::this_grid();
  phase0(p, smem);                                    grid.sync();
  phase1(p);                                          grid.sync();
  phase2(p, smem);                                    grid.sync();
  phase_moba(p, smem, 0, 1024); phase_gla_a(p);       grid.sync();
  phase_gla_b(p);                                     grid.sync();
  phase_gla_c(p);                                     grid.sync();
  phase6(p, smem);                                    grid.sync();
  phase7(p, smem);                                    grid.sync();
  phase8(p, smem);                                    grid.sync();
  phase9(p, smem);                                    grid.sync();
  phase10(p, smem);
}
#endif

extern "C" void kernel_launch(void* const* d_in, const int* in_sizes, int n_in, void* d_out, int out_size, void* d_ws, size_t ws_size,
                              hipStream_t stream) {
  if (n_in != 23 || out_size != T * D || ws_size < WS_END) {
    fprintf(stderr, "kernel_launch: unexpected problem (n_in %d, out %d, ws %zu, need %zu)\n", n_in, out_size, ws_size, (size_t)WS_END);
    return;
  }
  Params p{};
  const float** f = (const float**)&p;
  for (int i = 0; i < 23; ++i) f[i] = (const float*)d_in[i];
  p.out = (float*)d_out;
  p.ws = (unsigned char*)d_ws;
  (void)hipMemsetAsync(d_ws, 0, ZERO_BYTES, stream);
#if !FUSED
  const dim3 grid(512), blk(256);
  hipLaunchKernelGGL(k_p0, grid, blk, 0, stream, p);
  hipLaunchKernelGGL(k_p1, grid, blk, 0, stream, p);
  hipLaunchKernelGGL(k_p2, grid, blk, 0, stream, p);
  hipLaunchKernelGGL(k_p3, grid, blk, 0, stream, p);
  hipLaunchKernelGGL(k_p4, grid, blk, 0, stream, p);
  hipLaunchKernelGGL(k_p5, grid, blk, 0, stream, p);
  hipLaunchKernelGGL(k_p6, grid, blk, 0, stream, p);
  hipLaunchKernelGGL(k_p7, grid, blk, 0, stream, p);
  hipLaunchKernelGGL(k_p8, grid, blk, 0, stream, p);
  hipLaunchKernelGGL(k_p9, grid, blk, 0, stream, p);
  hipLaunchKernelGGL(k_p10, grid, blk, 0, stream, p);
#else
  static int grid_blocks = 0;
  if (!grid_blocks) {
    int dev = 0, cus = 0, per_cu = 0;
    hipGetDevice(&dev);
    hipDeviceGetAttribute(&cus, hipDeviceAttributeMultiprocessorCount, dev);
    hipOccupancyMaxActiveBlocksPerMultiprocessor(&per_cu, k_fused, 256, 0);
    if (per_cu > 2) per_cu = 2;
    grid_blocks = cus * per_cu;
    grid_blocks -= grid_blocks % 8;
  }
  void* args[] = {&p};
  hipError_t e = hipLaunchCooperativeKernel((void*)k_fused, dim3(grid_blocks), dim3(256), args, 0, stream);
  if (e != hipSuccess) fprintf(stderr, "cooperative launch failed: %s (grid %d)\n", hipGetErrorString(e), grid_blocks);
#endif
}
```

```cpp
#include <hip/hip_runtime.h>
#include <stdint.h>
#include <stdio.h>

#ifndef FUSED
#define FUSED 1
#endif
#ifndef DUPMASK
#define DUPMASK 0
#endif

#define DI __device__ __forceinline__
typedef short bf16x8 __attribute__((ext_vector_type(8)));
typedef float f32x16 __attribute__((ext_vector_type(16)));
typedef float f32x4 __attribute__((ext_vector_type(4)));
typedef unsigned u32x4 __attribute__((ext_vector_type(4)));
typedef unsigned u32x2 __attribute__((ext_vector_type(2)));
typedef __bf16 bf16x2_t __attribute__((ext_vector_type(2)));
typedef float f32x2_t __attribute__((ext_vector_type(2)));
typedef unsigned short u16;

#define MFMA32(a, b, c) __builtin_amdgcn_mfma_f32_32x32x16_bf16((a), (b), (c), 0, 0, 0)

constexpr int Bn = 4, S = 4096, D = 1024, T = Bn * S;
constexpr int DIN = 3088;
constexpr int NE = 256;
constexpr float EPS = 1e-6f;
constexpr float LOG2E = 1.4426950408889634f;
constexpr int LISTCAP = 16384;
constexpr int NTHR = 512;

constexpr size_t al256(size_t x) { return (x + 255) & ~(size_t)255; }
constexpr size_t OFF_BAR   = 0;
constexpr size_t OFF_CNT   = 16384;
constexpr size_t ZERO_BYTES = 32768;
constexpr size_t OFF_KMEAN = 32768;
constexpr size_t OFF_MOD   = al256(OFF_KMEAN + 4 * 8 * 16 * 64 * 4);
constexpr size_t OFF_WRT   = al256(OFF_MOD + 4 * 6144 * 4);
constexpr size_t OFF_WINT  = al256(OFF_WRT + 256 * 1024 * 2);
constexpr size_t OFF_WOUTT = al256(OFF_WINT + (size_t)3088 * 1024 * 2);
constexpr size_t OFF_WS13T = al256(OFF_WOUTT + (size_t)1024 * 1024 * 2);
constexpr size_t OFF_WS2T  = al256(OFF_WS13T + (size_t)512 * 1024 * 2);
constexpr size_t OFF_H1B   = al256(OFF_WS2T + (size_t)1024 * 256 * 2);
constexpr size_t OFF_MQ    = al256(OFF_H1B + (size_t)T * 1024 * 2);
constexpr size_t OFF_MK    = al256(OFF_MQ + (size_t)T * 512 * 2);
constexpr size_t OFF_VT    = al256(OFF_MK + (size_t)T * 512 * 2);
constexpr size_t OFF_GQ    = al256(OFF_VT + (size_t)T * 512 * 2);
constexpr size_t OFF_GK    = al256(OFF_GQ + (size_t)T * 256 * 2);
constexpr size_t OFF_GKT   = al256(OFF_GK + (size_t)T * 256 * 2);
constexpr size_t OFF_GVT   = al256(OFF_GKT + (size_t)T * 256 * 2);
constexpr size_t OFF_SG    = al256(OFF_GVT + (size_t)T * 512 * 2);
constexpr size_t OFF_BC    = al256(OFF_SG + (size_t)T * 512 * 2);
constexpr size_t OFF_BCT   = al256(OFF_BC + (size_t)T * 256 * 4);
constexpr size_t OFF_UT    = al256(OFF_BCT + (size_t)T * 256 * 4);
constexpr size_t OFF_DEC   = al256(OFF_UT + (size_t)16 * 64 * 128 * 64 * 4);
constexpr size_t OFF_ST    = al256(OFF_DEC + (size_t)16 * 64 * 64 * 4);
constexpr size_t OFF_MIX   = al256(OFF_ST + (size_t)16 * 64 * 128 * 64 * 2);
constexpr size_t OFF_X1    = al256(OFF_MIX + (size_t)T * 1024 * 2);
constexpr size_t OFF_H2B   = al256(OFF_X1 + (size_t)T * 1024 * 4);
constexpr size_t OFF_LIST  = al256(OFF_H2B + (size_t)T * 1024 * 2);
constexpr size_t OFF_TOPW  = al256(OFF_LIST + (size_t)256 * LISTCAP * 4);
constexpr size_t OFF_ACT   = al256(OFF_TOPW + (size_t)T * 8 * 4);
constexpr size_t OFF_ACTS  = al256(OFF_ACT + (size_t)T * 8 * 256 * 2);
constexpr size_t OFF_Y     = al256(OFF_ACTS + (size_t)T * 256 * 2);
constexpr size_t WS_END    = al256(OFF_Y + (size_t)T * 8 * 1024 * 2);

constexpr int LDS_C = 256 * 132 * 4;
constexpr int LDS_TBL = LDS_C;
constexpr int LDS_BYTES = LDS_C + 4096;

struct Params {
  const float *x, *c, *w_ada, *b_ada, *norm1_w, *norm2_w, *w_in, *q_norm_w, *k_norm_w, *rel_bias, *w_alpha, *b_alpha,
      *moba_out_w, *gla_out_w, *w_out, *w_router, *e_bias, *w1, *w3, *w2, *ws1, *ws3, *ws2;
  float* out;
  unsigned char* ws;
};

DI unsigned pack2(float a, float b) { f32x2_t v = {a, b}; return __builtin_bit_cast(unsigned, __builtin_convertvector(v, bf16x2_t)); }
DI float bflo(unsigned u) { return __uint_as_float(u << 16); }
DI float bfhi(unsigned u) { return __uint_as_float(u & 0xffff0000u); }
DI int opaque_tid() { int t = threadIdx.x; asm volatile("" : "+v"(t)); return t; }
DI int crow(int reg, int h) { return (reg & 3) + 8 * (reg >> 2) + 4 * h; }
DI int swz(int row) { return ((row >> 2) ^ (row >> 1)) & 7; }
DI u32x4 pack8(float a0, float a1, float a2, float a3, float a4, float a5, float a6, float a7) {
  u32x4 r; r[0] = pack2(a0, a1); r[1] = pack2(a2, a3); r[2] = pack2(a4, a5); r[3] = pack2(a6, a7); return r;
}
DI float wave_sum(float v) {
  v += __shfl_xor(v, 32); v += __shfl_xor(v, 16); v += __shfl_xor(v, 8); v += __shfl_xor(v, 4); v += __shfl_xor(v, 2); v += __shfl_xor(v, 1);
  return v;
}
DI float siluf(float x) { return x / (1.f + __expf(-x)); }

typedef __attribute__((address_space(3))) void* lds_ptr_t;
typedef const __attribute__((address_space(1))) void* glb_ptr_t;
template <int NR>
struct LoadBf16 {
  const u16* rp[NR];
  DI void issue(int kt, char* sX, int tid) {
#pragma unroll
    for (int i = 0; i < NR; ++i)
      __builtin_amdgcn_global_load_lds((glb_ptr_t)(rp[i] + kt * 64), (lds_ptr_t)(sX + i * 8192 + tid * 16), 16, 0, 0);
  }
  DI void commit(char*, int) {}
};
DI int src_chunk(int tid) { return ((tid & 7) ^ swz(tid >> 3)) * 8; }

struct BLoadF32 {
  const float* p;
  size_t ldb;
  f32x4 v[8];
  DI void issue(int kt, char*, int) {
    const float* q = p + (size_t)kt * 64 * ldb;
#pragma unroll
    for (int i = 0; i < 8; ++i) v[i] = *(const f32x4*)(q + (size_t)i * ldb);
  }
  DI void commit(char* sB, int tid) {
    const int n4 = (tid & 63) * 4, kg = tid >> 6;
#pragma unroll
    for (int j = 0; j < 4; ++j) {
      const int n = n4 + j;
      u32x4 w = pack8(v[0][j], v[1][j], v[2][j], v[3][j], v[4][j], v[5][j], v[6][j], v[7][j]);
      *(u32x4*)(sB + n * 128 + ((kg ^ swz(n)) << 4)) = w;
    }
  }
};

template <int MT>
DI void mma_step(const char* sA, const char* sB, f32x16 (&acc)[MT][2], int lane, int wm, int wn) {
  const int r = lane & 31, h = lane >> 5, f = swz(r);
  const char* a0 = sA + (wm * (MT * 32) + r) * 128;
  const char* b0 = sB + (wn * 64 + r) * 128;
#pragma unroll
  for (int kk = 0; kk < 4; ++kk) {
    const int off = (((kk * 2 + h) ^ f) << 4);
    const bf16x8 fb0 = *(const bf16x8*)(b0 + off);
    const bf16x8 fb1 = *(const bf16x8*)(b0 + 32 * 128 + off);
#pragma unroll
    for (int mt = 0; mt < MT; ++mt) {
      const bf16x8 fa = *(const bf16x8*)(a0 + mt * 32 * 128 + off);
      acc[mt][0] = MFMA32(fa, fb0, acc[mt][0]);
      acc[mt][1] = MFMA32(fa, fb1, acc[mt][1]);
    }
  }
}

template <int MT, class AL, class BL>
DI void gemm_mainloop(AL& al, BL& bl, int nk, char* smem, f32x16 (&acc)[MT][2]) {
  const int tid = opaque_tid(), lane = tid & 63, w = tid >> 6, wm = w >> 2, wn = w & 3;
#pragma unroll
  for (int i = 0; i < MT; ++i)
#pragma unroll
    for (int j = 0; j < 2; ++j)
#pragma unroll
      for (int r = 0; r < 16; ++r) acc[i][j][r] = 0.f;
  __syncthreads();
  al.issue(0, smem, tid); bl.issue(0, smem + 32768, tid);
  al.commit(smem, tid); bl.commit(smem + 32768, tid);
  asm volatile("s_waitcnt vmcnt(0)" ::: "memory");
  __syncthreads();
  for (int kt = 0; kt < nk; ++kt) {
    const int cur = kt & 1;
    const bool more = (kt + 1 < nk);
    char* nxt = smem + (cur ^ 1) * 65536;
    if (more) { al.issue(kt + 1, nxt, tid); bl.issue(kt + 1, nxt + 32768, tid); }
    mma_step<MT>(smem + cur * 65536, smem + cur * 65536 + 32768, acc, lane, wm, wn);
    if (more) { al.commit(nxt, tid); bl.commit(nxt + 32768, tid); }
    asm volatile("s_waitcnt vmcnt(0)" ::: "memory");
    __syncthreads();
  }
}

template <int MT>
DI void stage_nat(float* cs, const f32x16 (&acc)[MT][2], int half) {
  const int tid_ = opaque_tid(); const int lane = tid_ & 63, w = tid_ >> 6, wm = w >> 2, wn = w & 3, r = lane & 31, h = lane >> 5;
  if (MT == 4 && wm != half) return;
  const int rb = (MT == 4) ? 0 : wm * 64;
#pragma unroll
  for (int mt = 0; mt < MT; ++mt)
#pragma unroll
    for (int nt = 0; nt < 2; ++nt)
#pragma unroll
      for (int g = 0; g < 16; ++g) cs[(rb + mt * 32 + crow(g, h)) * 260 + wn * 64 + nt * 32 + r] = acc[mt][nt][g];
}
DI void stage_tr(float* cs, const f32x16 (&acc)[4][2], int half) {
  const int tid_ = opaque_tid(); const int lane = tid_ & 63, w = tid_ >> 6, wm = w >> 2, wn = w & 3, r = lane & 31, h = lane >> 5;
  if (wm != half) return;
#pragma unroll
  for (int mt = 0; mt < 4; ++mt)
#pragma unroll
    for (int nt = 0; nt < 2; ++nt)
#pragma unroll
      for (int g = 0; g < 4; ++g) {
        f32x4 v = {acc[mt][nt][4 * g], acc[mt][nt][4 * g + 1], acc[mt][nt][4 * g + 2], acc[mt][nt][4 * g + 3]};
        *(f32x4*)(cs + (wn * 64 + nt * 32 + r) * 132 + mt * 32 + 8 * g + 4 * h) = v;
      }
}

DI void transpose_item(const float* src, int ld, int n_src_col, u16* dst_row, int k8) {
  float v[8];
#pragma unroll
  for (int j = 0; j < 8; ++j) v[j] = src[(size_t)(k8 + j) * ld + n_src_col];
  *(u32x4*)(dst_row + k8) = pack8(v[0], v[1], v[2], v[3], v[4], v[5], v[6], v[7]);
}

DI void phase0(const Params& p, char* smem) {
  const int tid = opaque_tid(), lane = tid & 63, w = tid >> 6;
  float* mod = (float*)(p.ws + OFF_MOD);
  float* sil = (float*)smem;
  float* red = sil + 4096;
  for (int task = blockIdx.x; task < 96; task += gridDim.x) {
    __syncthreads();
    for (int i = tid; i < 4096; i += NTHR) sil[i] = siluf(p.c[i]);
    __syncthreads();
    const int col = task * 64 + lane;
    float a0 = 0.f, a1 = 0.f, a2 = 0.f, a3 = 0.f;
    const float* wp = p.w_ada + (size_t)(w * 128) * 6144 + col;
#pragma unroll 8
    for (int k = 0; k < 128; ++k) {
      const float wv = wp[(size_t)k * 6144];
      const int kk = w * 128 + k;
      a0 += sil[kk] * wv; a1 += sil[1024 + kk] * wv; a2 += sil[2048 + kk] * wv; a3 += sil[3072 + kk] * wv;
    }
    red[(w * 4 + 0) * 64 + lane] = a0; red[(w * 4 + 1) * 64 + lane] = a1; red[(w * 4 + 2) * 64 + lane] = a2; red[(w * 4 + 3) * 64 + lane] = a3;
    __syncthreads();
    if (w < 4) {
      const int b = w;
      float s = 0.f;
#pragma unroll
      for (int q = 0; q < 8; ++q) s += red[(q * 4 + b) * 64 + lane];
      mod[b * 6144 + col] = s + p.b_ada[col];
    }
  }
  const int gsz = gridDim.x * NTHR, gid = blockIdx.x * NTHR + tid;
  u16* wrT = (u16*)(p.ws + OFF_WRT);
  for (int i = gid; i < 256 * 128; i += gsz) { const int n = i & 255, k8 = (i >> 8) * 8; transpose_item(p.w_router, 256, n, wrT + (size_t)n * 1024, k8); }
  u16* winT = (u16*)(p.ws + OFF_WINT);
  for (int i = gid; i < 3088 * 128; i += gsz) { const int n = i % 3088, k8 = (i / 3088) * 8; transpose_item(p.w_in, DIN, n, winT + (size_t)n * 1024, k8); }
  u16* woutT = (u16*)(p.ws + OFF_WOUTT);
  for (int i = gid; i < 1024 * 128; i += gsz) { const int n = i & 1023, k8 = (i >> 10) * 8; transpose_item(p.w_out, 1024, n, woutT + (size_t)n * 1024, k8); }
  u16* ws13T = (u16*)(p.ws + OFF_WS13T);
  for (int i = gid; i < 512 * 128; i += gsz) {
    const int n = i & 511, k8 = (i >> 9) * 8;
    const int col = (n >> 8) * 128 + ((n >> 6) & 3) * 32 + (n & 31);
    transpose_item(((n >> 5) & 1) ? p.ws3 : p.ws1, 256, col, ws13T + (size_t)n * 1024, k8);
  }
  u16* ws2T = (u16*)(p.ws + OFF_WS2T);
  for (int i = gid; i < 1024 * 32; i += gsz) { const int n = i & 1023, k8 = (i >> 10) * 8; transpose_item(p.ws2, 1024, n, ws2T + (size_t)n * 256, k8); }
}

DI void phase1(const Params& p) {
  const int tid = opaque_tid(), lane = tid & 63, w = tid >> 6;
  const float* mod = (const float*)(p.ws + OFF_MOD);
  u16* h1b = (u16*)(p.ws + OFF_H1B);
  const int nW = gridDim.x * 8;
  for (int t = blockIdx.x * 8 + w; t < T; t += nW) {
    const int b = t >> 12;
    f32x4 xv[4]; float ssq = 0.f;
#pragma unroll
    for (int i = 0; i < 4; ++i) {
      xv[i] = *(const f32x4*)(p.x + (size_t)t * 1024 + i * 256 + lane * 4);
      ssq += xv[i][0] * xv[i][0] + xv[i][1] * xv[i][1] + xv[i][2] * xv[i][2] + xv[i][3] * xv[i][3];
    }
    ssq = wave_sum(ssq);
    const float r = rsqrtf(ssq * (1.f / 1024.f) + EPS);
#pragma unroll
    for (int i = 0; i < 4; ++i) {
      const int k = i * 256 + lane * 4;
      const f32x4 nw = *(const f32x4*)(p.norm1_w + k);
      const f32x4 sc = *(const f32x4*)(mod + b * 6144 + 1024 + k);
      const f32x4 sh = *(const f32x4*)(mod + b * 6144 + k);
      float o[4];
#pragma unroll
      for (int j = 0; j < 4; ++j) o[j] = xv[i][j] * r * nw[j] * (1.f + sc[j]) + sh[j];
      u32x2 pk = {pack2(o[0], o[1]), pack2(o[2], o[3])};
      *(u32x2*)(h1b + (size_t)t * 1024 + k) = pk;
    }
  }
}

DI float logsig(float z) { return fminf(z, 0.f) - log1pf(__expf(-fabsf(z))); }

DI void phase2(const Params& p, char* smem) {
  const int tid = opaque_tid();
  const u16* h1b = (const u16*)(p.ws + OFF_H1B);
  const u16* winT = (const u16*)(p.ws + OFF_WINT);
  float* cs = (float*)smem;
  for (int id = blockIdx.x; id < 768; id += gridDim.x) {
    const int mtile = id / 12, ntile = id % 12;
    const int row0 = mtile * 256, b = row0 >> 12, s0 = row0 & 4095;
    LoadBf16<4> al; LoadBf16<4> bl;
#pragma unroll
    for (int i = 0; i < 4; ++i) {
      al.rp[i] = h1b + (size_t)(row0 + (tid >> 3) + 64 * i) * 1024 + src_chunk(tid);
      bl.rp[i] = winT + (size_t)(ntile * 256 + (tid >> 3) + 64 * i) * 1024 + src_chunk(tid);
    }
    f32x16 acc[4][2];
    gemm_mainloop<4>(al, bl, 16, smem, acc);
    const bool nat = (ntile < 4) || ntile == 6 || ntile == 7 || ntile >= 10;
    const bool tr = (ntile == 4 || ntile == 5 || (ntile >= 7 && ntile < 10));
    if (nat) {
      float ksum[8];
#pragma unroll
      for (int q = 0; q < 8; ++q) ksum[q] = 0.f;
#pragma unroll 1
      for (int half = 0; half < 2; ++half) {
        __syncthreads();
        stage_nat<4>(cs, acc, half);
        __syncthreads();
#pragma unroll 1
        for (int it = 0; it < 8; ++it) {
          const int i = it * NTHR + tid, row = i >> 5, c8 = (i & 31) * 8;
          const int srow = s0 + half * 128 + row;
          const f32x4 va = *(const f32x4*)(cs + row * 260 + c8), vb = *(const f32x4*)(cs + row * 260 + c8 + 4);
          float v[8] = {va[0], va[1], va[2], va[3], vb[0], vb[1], vb[2], vb[3]};
          const int d0 = c8 & 63;
          if (ntile < 4) {
            float ssq = 0.f;
#pragma unroll
            for (int q = 0; q < 8; ++q) ssq += v[q] * v[q];
            ssq += __shfl_xor(ssq, 1); ssq += __shfl_xor(ssq, 2); ssq += __shfl_xor(ssq, 4);
            const float sc = rsqrtf(ssq * (1.f / 64.f) + EPS);
            const float* nw = (ntile < 2) ? p.q_norm_w : p.k_norm_w;
#pragma unroll
            for (int q = 0; q < 8; ++q) v[q] = v[q] * sc * nw[d0 + q];
            const int hd = (ntile & 1) * 4 + (c8 >> 6);
            u16* dst = (u16*)(p.ws + (ntile < 2 ? OFF_MQ : OFF_MK)) + ((size_t)(b * 8 + hd) * S + srow) * 64 + d0;
            *(u32x4*)dst = pack8(v[0], v[1], v[2], v[3], v[4], v[5], v[6], v[7]);
            if (ntile >= 2) {
#pragma unroll
              for (int q = 0; q < 8; ++q) ksum[q] += v[q];
            }
          } else if (ntile < 8) {
            const int hd = c8 >> 6;
            if (ntile == 6) {
#pragma unroll
              for (int q = 0; q < 8; ++q) v[q] *= 0.125f;
            }
            u16* dst = (u16*)(p.ws + (ntile == 6 ? OFF_GQ : OFF_GK)) + ((size_t)(b * 4 + hd) * S + srow) * 64 + d0;
            *(u32x4*)dst = pack8(v[0], v[1], v[2], v[3], v[4], v[5], v[6], v[7]);
          } else {
#pragma unroll
            for (int q = 0; q < 8; ++q) v[q] = siluf(v[q]);
            u16* dst = (u16*)(p.ws + OFF_SG) + (size_t)(row0 + half * 128 + row) * 512 + (ntile - 10) * 256 + c8;
            *(u32x4*)dst = pack8(v[0], v[1], v[2], v[3], v[4], v[5], v[6], v[7]);
          }
        }
      }
      if (ntile == 2 || ntile == 3) {
        __syncthreads();
        const int c8 = (tid & 31) * 8;
#pragma unroll
        for (int q = 0; q < 8; ++q) cs[(tid >> 5) * 256 + c8 + q] = ksum[q];
        __syncthreads();
        if (tid < 256) {
          float s = 0.f;
#pragma unroll
          for (int q = 0; q < 16; ++q) s += cs[q * 256 + tid];
          const int hd = (ntile - 2) * 4 + (tid >> 6);
          float* km = (float*)(p.ws + OFF_KMEAN);
          km[((size_t)(b * 8 + hd) * 16 + (s0 >> 8)) * 64 + (tid & 63)] = s * (1.f / 256.f);
        }
      }
    }
    if (tr) {
#pragma unroll 1
      for (int half = 0; half < 2; ++half) {
        __syncthreads();
        stage_tr(cs, acc, half);
        __syncthreads();
#pragma unroll 1
        for (int it = 0; it < 8; ++it) {
          const int i = it * NTHR + tid, col = i >> 4, r8 = (i & 15) * 8;
          const int srow = s0 + half * 128 + r8;
          const f32x4 va = *(const f32x4*)(cs + col * 132 + r8), vb = *(const f32x4*)(cs + col * 132 + r8 + 4);
          u16* dst;
          if (ntile < 6)       dst = (u16*)(p.ws + OFF_VT) + ((size_t)(b * 8 + (ntile - 4) * 4 + (col >> 6)) * 64 + (col & 63)) * S + srow;
          else if (ntile == 7) dst = (u16*)(p.ws + OFF_GKT) + ((size_t)(b * 4 + (col >> 6)) * 64 + (col & 63)) * S + srow;
          else                 dst = (u16*)(p.ws + OFF_GVT) + ((size_t)(b * 4 + (ntile - 8) * 2 + (col >> 7)) * 128 + (col & 127)) * S + srow;
          *(u32x4*)dst = pack8(va[0], va[1], va[2], va[3], vb[0], vb[1], vb[2], vb[3]);
        }
      }
    }
  }
}

DI void phase2_ga(const Params& p, char* smem) {
  const int tid = opaque_tid(), lane = tid & 63, w = tid >> 6, r = lane & 31, h5 = lane >> 5;
  const u16* h1b = (const u16*)(p.ws + OFF_H1B);
  const u16* winT = (const u16*)(p.ws + OFF_WINT);
  float* gs = (float*)smem;
  for (int task = blockIdx.x; task < 256; task += gridDim.x) {
    const int row0 = task * 64, b = row0 >> 12, s0 = row0 & 4095;
    __syncthreads();
    if (w < 2) {
      f32x16 acc;
#pragma unroll
      for (int i = 0; i < 16; ++i) acc[i] = 0.f;
      const u16* ap = h1b + (size_t)(row0 + w * 32 + r) * 1024 + h5 * 8;
      const u16* bp = winT + (size_t)(3072 + (r & 15)) * 1024 + h5 * 8;
#pragma unroll 4
      for (int ks = 0; ks < 64; ++ks) acc = MFMA32(*(const bf16x8*)(ap + ks * 16), *(const bf16x8*)(bp + ks * 16), acc);
      if (r < 16) {
#pragma unroll
        for (int i = 0; i < 16; ++i) gs[(w * 32 + crow(i, h5)) * 17 + r] = acc[i];
      }
    }
    __syncthreads();
    if (tid < 256) {
      float wa[16];
#pragma unroll
      for (int q = 0; q < 16; ++q) wa[q] = p.w_alpha[q * 256 + tid];
      const float ba = p.b_alpha[tid];
      const int hd = tid >> 6, d = tid & 63;
      float* bc = (float*)(p.ws + OFF_BC) + ((size_t)(b * 4 + hd) * S + s0) * 64 + d;
      float* bct = (float*)(p.ws + OFF_BCT) + ((size_t)(b * 4 + hd) * 64 + d) * S + s0;
      float cum = 0.f;
#pragma unroll 1
      for (int r4 = 0; r4 < 16; ++r4) {
        f32x4 o;
#pragma unroll
        for (int q4 = 0; q4 < 4; ++q4) {
          const int row = r4 * 4 + q4;
          float z = ba;
#pragma unroll
          for (int q = 0; q < 16; ++q) z += gs[row * 17 + q] * wa[q];
          cum += logsig(z) * (1.f / 16.f);
          bc[(size_t)row * 64] = cum;
          o[q4] = cum;
        }
        *(f32x4*)(bct + r4 * 4) = o;
      }
    }
  }
}

DI int t5_bucket(int rel) {
  if (rel < 16) return rel;
  int bkt = 16;
  bkt += (rel >= 19); bkt += (rel >= 21); bkt += (rel >= 24); bkt += (rel >= 27); bkt += (rel >= 31); bkt += (rel >= 35); bkt += (rel >= 40);
  bkt += (rel >= 46); bkt += (rel >= 52); bkt += (rel >= 59); bkt += (rel >= 67); bkt += (rel >= 77); bkt += (rel >= 87); bkt += (rel >= 99); bkt += (rel >= 113);
  return bkt;
}

struct MobaState { f32x16 o0, o1; float m, l; };
struct MobaFrags { bf16x8 k[4]; u32x2 vlo[4], vhi[4]; };

DI void moba_lds_load(MobaFrags& f, const char* sp, int sb, int r, int h5) {
  const int fz = swz(r);
  const char* kp = sp + (sb * 32 + r) * 128;
#pragma unroll
  for (int ks = 0; ks < 4; ++ks) f.k[ks] = *(const bf16x8*)(kp + (((ks * 2 + h5) ^ fz) << 4));
#pragma unroll
  for (int s2 = 0; s2 < 2; ++s2)
#pragma unroll
    for (int dt = 0; dt < 2; ++dt) {
      const char* vp = sp + 8192 + (dt * 32 + r) * 128 + h5 * 8;
      const int c = sb * 4 + s2 * 2;
      f.vlo[s2 * 2 + dt] = *(const u32x2*)(vp + ((c ^ fz) << 4));
      f.vhi[s2 * 2 + dt] = *(const u32x2*)(vp + (((c + 1) ^ fz) << 4));
    }
}

template <int MODE>
DI void moba_subtile(MobaState& st, const bf16x8 (&qf)[4], const MobaFrags& f, int kpos0, int qpos, bool sel,
                     const float* lut, float cb31, int r, int h5) {
  const float NEG = -__builtin_inff();
  f32x16 s;
#pragma unroll
  for (int i = 0; i < 16; ++i) s[i] = 0.f;
#pragma unroll
  for (int ks = 0; ks < 4; ++ks) s = MFMA32(f.k[ks], qf[ks], s);
  const float c1 = 0.125f * LOG2E;
  float t[16]; float tm = NEG;
  if (MODE == 0) {
    const float c1e = sel ? c1 : 0.f, cbe = sel ? cb31 : NEG;
    float sm = s[0];
#pragma unroll
    for (int i = 1; i < 16; ++i) sm = fmaxf(sm, s[i]);
    tm = sm * c1e + cbe;
    tm = fmaxf(tm, __shfl_xor(tm, 32));
    const float mn = fmaxf(st.m, tm);
    const float mu = (mn == NEG) ? 0.f : mn;
    const float alpha = exp2f(st.m - mu);
    const float off = cbe - mu;
    float psum = 0.f;
#pragma unroll
    for (int i = 0; i < 16; ++i) { t[i] = exp2f(s[i] * c1e + off); psum += t[i]; }
    st.l = st.l * alpha + psum; st.m = mn;
    if (__any(alpha != 1.f)) {
#pragma unroll
      for (int i = 0; i < 16; ++i) { st.o0[i] *= alpha; st.o1[i] *= alpha; }
    }
  } else {
#pragma unroll
    for (int i = 0; i < 16; ++i) {
      const int rel = qpos - (kpos0 + crow(i, h5));
      const float bias = (rel >= 128) ? cb31 : lut[rel < 0 ? 0 : rel];
      float tv = s[i] * c1 + bias;
      if (MODE == 2 && rel < 0) tv = NEG;
      if (MODE == 1 && !sel) tv = NEG;
      t[i] = tv; tm = fmaxf(tm, tv);
    }
    tm = fmaxf(tm, __shfl_xor(tm, 32));
    const float mn = fmaxf(st.m, tm);
    const float mu = (mn == NEG) ? 0.f : mn;
    const float alpha = exp2f(st.m - mu);
    float psum = 0.f;
#pragma unroll
    for (int i = 0; i < 16; ++i) { t[i] = exp2f(t[i] - mu); psum += t[i]; }
    st.l = st.l * alpha + psum; st.m = mn;
#pragma unroll
    for (int i = 0; i < 16; ++i) { st.o0[i] *= alpha; st.o1[i] *= alpha; }
  }
  const bf16x8 pf0 = __builtin_bit_cast(bf16x8, pack8(t[0], t[1], t[2], t[3], t[4], t[5], t[6], t[7]));
  const bf16x8 pf1 = __builtin_bit_cast(bf16x8, pack8(t[8], t[9], t[10], t[11], t[12], t[13], t[14], t[15]));
#pragma unroll
  for (int s2 = 0; s2 < 2; ++s2) {
#pragma unroll
    for (int dt = 0; dt < 2; ++dt) {
      u32x4 vv = {f.vlo[s2 * 2 + dt][0], f.vlo[s2 * 2 + dt][1], f.vhi[s2 * 2 + dt][0], f.vhi[s2 * 2 + dt][1]};
      const bf16x8 vf = __builtin_bit_cast(bf16x8, vv);
      if (dt == 0) st.o0 = MFMA32(vf, s2 ? pf1 : pf0, st.o0); else st.o1 = MFMA32(vf, s2 ? pf1 : pf0, st.o1);
    }
  }
}

DI void phase_moba(const Params& p, char* smem, int task_lo, int task_hi) {
  const int tid = opaque_tid(), lane = tid & 63, w = tid >> 6, r = lane & 31, h5 = lane >> 5;
  float* lut = (float*)(smem + 32768);
  unsigned* um = (unsigned*)(smem + 32768 + 512);
  const float NEG = -__builtin_inff();
  const u16* mq = (const u16*)(p.ws + OFF_MQ);
  const u16* mk = (const u16*)(p.ws + OFF_MK);
  const u16* vT = (const u16*)(p.ws + OFF_VT);
  const float* kmean = (const float*)(p.ws + OFF_KMEAN);
  u16* mix = (u16*)(p.ws + OFF_MIX);
  for (int task = task_lo + blockIdx.x; task < task_hi; task += gridDim.x) {
    const int blk = (task < 256) ? 15 - (task >> 5) : ((task - 256) >> 5);
    const int bh = task & 31, hd = bh & 7, b = bh >> 3;
    __syncthreads();
    if (tid < 128) lut[tid] = p.rel_bias[t5_bucket(tid) * 8 + hd] * LOG2E;
    __syncthreads();
    const float cb31 = p.rel_bias[31 * 8 + hd] * LOG2E;
    const int qpos = blk * 256 + w * 32 + r;
    const u16* qptr = mq + ((size_t)bh * S + qpos) * 64 + h5 * 8;
    bf16x8 qf[4];
#pragma unroll
    for (int ks = 0; ks < 4; ++ks) qf[ks] = *(const bf16x8*)(qptr + ks * 16);
    unsigned selmask = 0;
    if (blk > 0) {
      f32x16 g;
#pragma unroll
      for (int i = 0; i < 16; ++i) g[i] = 0.f;
      const int n = r < 15 ? r : 15;
      const float* kmp = kmean + ((size_t)bh * 16 + n) * 64 + h5 * 8;
#pragma unroll
      for (int ks = 0; ks < 4; ++ks) {
        const f32x4 v0 = *(const f32x4*)(kmp + ks * 16), v1 = *(const f32x4*)(kmp + ks * 16 + 4);
        const u32x4 hi = pack8(v0[0], v0[1], v0[2], v0[3], v1[0], v1[1], v1[2], v1[3]);
        const u32x4 lo = pack8(v0[0] - bflo(hi[0]), v0[1] - bfhi(hi[0]), v0[2] - bflo(hi[1]), v0[3] - bfhi(hi[1]),
                               v1[0] - bflo(hi[2]), v1[1] - bfhi(hi[2]), v1[2] - bflo(hi[3]), v1[3] - bfhi(hi[3]));
        g = MFMA32(__builtin_bit_cast(bf16x8, hi), qf[ks], g);
        g = MFMA32(__builtin_bit_cast(bf16x8, lo), qf[ks], g);
      }
      float gt[16];
#pragma unroll
      for (int nn = 0; nn < 16; ++nn) {
        const int x = (nn >> 2) & 1, rr = (nn & 3) + 4 * (nn >> 3);
        const float own = g[rr];
        const float par = __shfl_xor(own, 32);
        gt[nn] = (h5 == x) ? own : par;
      }
#pragma unroll
      for (int it = 0; it < 3; ++it) {
        float best = NEG; int bi = -1;
#pragma unroll
        for (int nn = 0; nn < 16; ++nn) {
          const bool ok = (nn < blk) && !((selmask >> nn) & 1u);
          if (ok && gt[nn] > best) { best = gt[nn]; bi = nn; }
        }
        if (bi >= 0) selmask |= 1u << bi;
      }
    }
    unsigned wmask = 0;
    for (int nn = 0; nn < blk; ++nn) if (__any((int)((selmask >> nn) & 1u))) wmask |= 1u << nn;
    if (lane == 0) um[w] = wmask;
    __syncthreads();
    unsigned bmask = 1u << blk;
#pragma unroll
    for (int q = 0; q < 8; ++q) bmask |= um[q];
    MobaState st;
#pragma unroll
    for (int i = 0; i < 16; ++i) { st.o0[i] = 0.f; st.o1[i] = 0.f; }
    st.m = NEG; st.l = 0.f;
    const u16* kbase = mk + (size_t)bh * S * 64;
    const u16* vbase = vT + (size_t)bh * 64 * S;
    LoadBf16<2> ld;
    int n = __builtin_ctz(bmask), j = 0;
    ld.rp[0] = kbase + (size_t)(n * 256 + (tid >> 3)) * 64 + src_chunk(tid);
    ld.rp[1] = vbase + (size_t)(tid >> 3) * S + n * 256 + src_chunk(tid);
    ld.issue(0, smem, tid);
    asm volatile("s_waitcnt vmcnt(0)" ::: "memory");
    __syncthreads();
    for (int it = 0;; ++it) {
      const char* sp = smem + (it & 1) * 16384;
      int n2 = n, j2 = j + 1;
      bool last = false;
      if (j2 == 4) {
        if (n == blk) last = true;
        else { j2 = 0; n2 = __builtin_ctz(bmask & ~((2u << n) - 1u)); }
      }
      if (!last) {
        ld.rp[0] = kbase + (size_t)(n2 * 256 + j2 * 64 + (tid >> 3)) * 64 + src_chunk(tid);
        ld.rp[1] = vbase + (size_t)(tid >> 3) * S + n2 * 256 + j2 * 64 + src_chunk(tid);
        ld.issue(0, smem + ((it + 1) & 1) * 16384, tid);
      }
      if (n == blk) {
#pragma unroll 1
        for (int sb = 0; sb < 2; ++sb) {
          if (2 * j + sb <= w) {
            MobaFrags f; moba_lds_load(f, sp, sb, r, h5);
            moba_subtile<2>(st, qf, f, n * 256 + j * 64 + sb * 32, qpos, true, lut, cb31, r, h5);
          }
        }
      } else if ((wmask >> n) & 1u) {
        const bool sel = (selmask >> n) & 1u;
#pragma unroll 1
        for (int sb = 0; sb < 2; ++sb) {
          MobaFrags f; moba_lds_load(f, sp, sb, r, h5);
          if (n == blk - 1) moba_subtile<1>(st, qf, f, n * 256 + j * 64 + sb * 32, qpos, sel, lut, cb31, r, h5);
          else              moba_subtile<0>(st, qf, f, n * 256 + j * 64 + sb * 32, qpos, sel, lut, cb31, r, h5);
        }
      }
      asm volatile("s_waitcnt vmcnt(0)" ::: "memory");
      __syncthreads();
      if (last) break;
      n = n2; j = j2;
    }
    float l = st.l + __shfl_xor(st.l, 32);
    const float inv = 1.f / l;
    float ssq = 0.f;
#pragma unroll
    for (int i = 0; i < 16; ++i) { st.o0[i] *= inv; st.o1[i] *= inv; ssq += st.o0[i] * st.o0[i] + st.o1[i] * st.o1[i]; }
    ssq += __shfl_xor(ssq, 32);
    const float rs = rsqrtf(ssq * (1.f / 64.f) + EPS);
    u16* op = mix + (size_t)(b * S + qpos) * 1024 + hd * 64;
#pragma unroll
    for (int dt = 0; dt < 2; ++dt)
#pragma unroll
      for (int g4 = 0; g4 < 4; ++g4) {
        const int d0 = dt * 32 + 8 * g4 + 4 * h5;
        const f32x4 mw = *(const f32x4*)(p.moba_out_w + d0);
        float o[4];
#pragma unroll
        for (int q = 0; q < 4; ++q) o[q] = (dt ? st.o1[4 * g4 + q] : st.o0[4 * g4 + q]) * rs * mw[q];
        u32x2 pk = {pack2(o[0], o[1]), pack2(o[2], o[3])};
        *(u32x2*)(op + d0) = pk;
      }
  }
}

DI void phase_gla_a(const Params& p) {
  const int tid = opaque_tid(), lane = tid & 63, w = tid >> 6, r = lane & 31, h5 = lane >> 5;
  const u16* gkT = (const u16*)(p.ws + OFF_GKT);
  const u16* gvT = (const u16*)(p.ws + OFF_GVT);
  const float* bcT = (const float*)(p.ws + OFF_BCT);
  float* UT = (float*)(p.ws + OFF_UT);
  float* dec = (float*)(p.ws + OFF_DEC);
  for (int task = blockIdx.x; task < 512; task += gridDim.x) {
    const int bh = task >> 5, c = (task & 31) * 2 + (w >> 2), vt = w & 3;
    f32x16 acc[2];
#pragma unroll
    for (int i = 0; i < 16; ++i) { acc[0][i] = 0.f; acc[1][i] = 0.f; }
    const u16* vp = gvT + ((size_t)bh * 128 + vt * 32 + r) * S + c * 64 + h5 * 8;
#pragma unroll
    for (int dt = 0; dt < 2; ++dt) {
      const int d = dt * 32 + r;
      const float* bp = bcT + ((size_t)bh * 64 + d) * S + c * 64;
      const u16* kp = gkT + ((size_t)bh * 64 + d) * S + c * 64;
      const float bl = bp[63];
      if (vt == 0 && h5 == 0) dec[((size_t)bh * 64 + c) * 64 + d] = __expf(bl);
#pragma unroll
      for (int ks = 0; ks < 4; ++ks) {
        const u32x4 kk = *(const u32x4*)(kp + ks * 16 + h5 * 8);
        const f32x4 b0 = *(const f32x4*)(bp + ks * 16 + h5 * 8), b1 = *(const f32x4*)(bp + ks * 16 + h5 * 8 + 4);
        const u32x4 kh = pack8(bflo(kk[0]) * __expf(bl - b0[0]), bfhi(kk[0]) * __expf(bl - b0[1]), bflo(kk[1]) * __expf(bl - b0[2]), bfhi(kk[1]) * __expf(bl - b0[3]),
                               bflo(kk[2]) * __expf(bl - b1[0]), bfhi(kk[2]) * __expf(bl - b1[1]), bflo(kk[3]) * __expf(bl - b1[2]), bfhi(kk[3]) * __expf(bl - b1[3]));
        const bf16x8 vf = *(const bf16x8*)(vp + ks * 16);
        acc[dt] = MFMA32(vf, __builtin_bit_cast(bf16x8, kh), acc[dt]);
      }
    }
    float* up = UT + ((size_t)bh * 64 + c) * 128 * 64;
#pragma unroll
    for (int dt = 0; dt < 2; ++dt)
#pragma unroll
      for (int i = 0; i < 16; ++i) up[(size_t)(vt * 32 + crow(i, h5)) * 64 + dt * 32 + r] = acc[dt][i];
  }
}

DI void phase_gla_b(const Params& p) {
  const float* UT = (const float*)(p.ws + OFF_UT);
  const float* dec = (const float*)(p.ws + OFF_DEC);
  u16* ST = (u16*)(p.ws + OFF_ST);
  for (int i = blockIdx.x * NTHR + threadIdx.x; i < 16 * 128 * 16; i += gridDim.x * NTHR) {
    const int d4 = (i & 15) * 4, v = (i >> 4) & 127, bh = i >> 11;
    f32x4 st = {0.f, 0.f, 0.f, 0.f};
#pragma unroll 8
    for (int c = 0; c < 64; ++c) {
      const size_t o = (((size_t)bh * 64 + c) * 128 + v) * 64 + d4;
      const f32x4 u = *(const f32x4*)(UT + o);
      const f32x4 a = *(const f32x4*)(dec + ((size_t)bh * 64 + c) * 64 + d4);
      u32x2 pk = {pack2(st[0], st[1]), pack2(st[2], st[3])};
      *(u32x2*)(ST + o) = pk;
      st[0] = a[0] * st[0] + u[0]; st[1] = a[1] * st[1] + u[1]; st[2] = a[2] * st[2] + u[2]; st[3] = a[3] * st[3] + u[3];
    }
  }
}

DI void phase_gla_c(const Params& p) {
  const int tid = opaque_tid(), lane = tid & 63, w = tid >> 6, r = lane & 31, h5 = lane >> 5;
  const u16* gq = (const u16*)(p.ws + OFF_GQ);
  const u16* gk = (const u16*)(p.ws + OFF_GK);
  const u16* gvT = (const u16*)(p.ws + OFF_GVT);
  const float* bc = (const float*)(p.ws + OFF_BC);
  const u16* ST = (const u16*)(p.ws + OFF_ST);
  const u16* sg = (const u16*)(p.ws + OFF_SG);
  u16* mix = (u16*)(p.ws + OFF_MIX);
  for (int task = blockIdx.x; task < 256; task += gridDim.x) {
    const int bh = task >> 4, c = (task & 15) * 4 + (w >> 1), ih = w & 1, b = bh >> 2, hd = bh & 3;
    const int tpos = c * 64 + ih * 32 + r;
    bf16x8 qt[4];
    {
      const u16* qp = gq + ((size_t)bh * S + tpos) * 64 + h5 * 8;
      const float* bp = bc + ((size_t)bh * S + tpos) * 64 + h5 * 8;
#pragma unroll
      for (int ks = 0; ks < 4; ++ks) {
        const u32x4 qq = *(const u32x4*)(qp + ks * 16);
        const f32x4 b0 = *(const f32x4*)(bp + ks * 16), b1 = *(const f32x4*)(bp + ks * 16 + 4);
        qt[ks] = __builtin_bit_cast(bf16x8, pack8(bflo(qq[0]) * __expf(b0[0]), bfhi(qq[0]) * __expf(b0[1]), bflo(qq[1]) * __expf(b0[2]), bfhi(qq[1]) * __expf(b0[3]),
                                                 bflo(qq[2]) * __expf(b1[0]), bfhi(qq[2]) * __expf(b1[1]), bflo(qq[3]) * __expf(b1[2]), bfhi(qq[3]) * __expf(b1[3])));
      }
    }
    f32x16 oacc[4];
#pragma unroll
    for (int vt = 0; vt < 4; ++vt)
#pragma unroll
      for (int i = 0; i < 16; ++i) oacc[vt][i] = 0.f;
#pragma unroll
    for (int jt = 0; jt < 2; ++jt) {
      if (jt <= ih) {
        f32x16 X;
#pragma unroll
        for (int i = 0; i < 16; ++i) X[i] = 0.f;
        const int jpos = c * 64 + jt * 32 + r;
        const u16* kp = gk + ((size_t)bh * S + jpos) * 64 + h5 * 8;
        const float* bp = bc + ((size_t)bh * S + jpos) * 64 + h5 * 8;
#pragma unroll
        for (int ks = 0; ks < 4; ++ks) {
          const u32x4 kk = *(const u32x4*)(kp + ks * 16);
          const f32x4 b0 = *(const f32x4*)(bp + ks * 16), b1 = *(const f32x4*)(bp + ks * 16 + 4);
          const u32x4 kt = pack8(bflo(kk[0]) * __expf(-b0[0]), bfhi(kk[0]) * __expf(-b0[1]), bflo(kk[1]) * __expf(-b0[2]), bfhi(kk[1]) * __expf(-b0[3]),
                                 bflo(kk[2]) * __expf(-b1[0]), bfhi(kk[2]) * __expf(-b1[1]), bflo(kk[3]) * __expf(-b1[2]), bfhi(kk[3]) * __expf(-b1[3]));
          X = MFMA32(__builtin_bit_cast(bf16x8, kt), qt[ks], X);
        }
        if (jt == ih) {
#pragma unroll
          for (int i = 0; i < 16; ++i) if (crow(i, h5) > r) X[i] = 0.f;
        }
        const bf16x8 pf0 = __builtin_bit_cast(bf16x8, pack8(X[0], X[1], X[2], X[3], X[4], X[5], X[6], X[7]));
        const bf16x8 pf1 = __builtin_bit_cast(bf16x8, pack8(X[8], X[9], X[10], X[11], X[12], X[13], X[14], X[15]));
#pragma unroll
        for (int vt = 0; vt < 4; ++vt) {
#pragma unroll
          for (int s2 = 0; s2 < 2; ++s2) {
            const u16* vp = gvT + ((size_t)bh * 128 + vt * 32 + r) * S + c * 64 + jt * 32 + 16 * s2 + 4 * h5;
            const u32x2 lo = *(const u32x2*)vp, hi = *(const u32x2*)(vp + 8);
            u32x4 vv = {lo[0], lo[1], hi[0], hi[1]};
            oacc[vt] = MFMA32(__builtin_bit_cast(bf16x8, vv), s2 ? pf1 : pf0, oacc[vt]);
          }
        }
      }
    }
    {
      const u16* sp = ST + (((size_t)bh * 64 + c) * 128 + r) * 64 + h5 * 8;
#pragma unroll
      for (int vt = 0; vt < 4; ++vt)
#pragma unroll
        for (int ks = 0; ks < 4; ++ks) oacc[vt] = MFMA32(*(const bf16x8*)(sp + (size_t)vt * 32 * 64 + ks * 16), qt[ks], oacc[vt]);
    }
    float ssq = 0.f;
#pragma unroll
    for (int vt = 0; vt < 4; ++vt)
#pragma unroll
      for (int i = 0; i < 16; ++i) ssq += oacc[vt][i] * oacc[vt][i];
    ssq += __shfl_xor(ssq, 32);
    const float rs = rsqrtf(ssq * (1.f / 128.f) + EPS);
    const size_t t = (size_t)b * S + tpos;
    const u16* sgp = sg + t * 512 + hd * 128;
    u16* op = mix + t * 1024 + 512 + hd * 128;
#pragma unroll
    for (int vt = 0; vt < 4; ++vt)
#pragma unroll
      for (int g4 = 0; g4 < 4; ++g4) {
        const int v0 = vt * 32 + 8 * g4 + 4 * h5;
        const f32x4 gw = *(const f32x4*)(p.gla_out_w + v0);
        const u32x2 sv = *(const u32x2*)(sgp + v0);
        const float o0 = oacc[vt][4 * g4 + 0] * rs * gw[0] * bflo(sv[0]);
        const float o1 = oacc[vt][4 * g4 + 1] * rs * gw[1] * bfhi(sv[0]);
        const float o2 = oacc[vt][4 * g4 + 2] * rs * gw[2] * bflo(sv[1]);
        const float o3 = oacc[vt][4 * g4 + 3] * rs * gw[3] * bfhi(sv[1]);
        u32x2 pk = {pack2(o0, o1), pack2(o2, o3)};
        *(u32x2*)(op + v0) = pk;
      }
  }
}

DI void phase6(const Params& p, char* smem) {
  const int tid = opaque_tid(), lane = tid & 63, w = tid >> 6, wm = w >> 2, wn = w & 3, r = lane & 31, h5 = lane >> 5;
  const u16* mix = (const u16*)(p.ws + OFF_MIX);
  const u16* woutT = (const u16*)(p.ws + OFF_WOUTT);
  const float* mod = (const float*)(p.ws + OFF_MOD);
  float* x1 = (float*)(p.ws + OFF_X1);
  for (int id = blockIdx.x; id < 256; id += gridDim.x) {
    const int mtile = id >> 2, ntile = id & 3, row0 = mtile * 256, b = row0 >> 12;
    LoadBf16<4> al; LoadBf16<4> bl;
#pragma unroll
    for (int i = 0; i < 4; ++i) {
      al.rp[i] = mix + (size_t)(row0 + (tid >> 3) + 64 * i) * 1024 + src_chunk(tid);
      bl.rp[i] = woutT + (size_t)(ntile * 256 + (tid >> 3) + 64 * i) * 1024 + src_chunk(tid);
    }
    f32x16 acc[4][2];
    gemm_mainloop<4>(al, bl, 16, smem, acc);
#pragma unroll
    for (int mt = 0; mt < 4; ++mt)
#pragma unroll
      for (int nt = 0; nt < 2; ++nt) {
        const int col = ntile * 256 + wn * 64 + nt * 32 + r;
        const float g1 = mod[b * 6144 + 2048 + col];
#pragma unroll
        for (int i = 0; i < 16; ++i) {
          const size_t o = (size_t)(row0 + wm * 128 + mt * 32 + crow(i, h5)) * 1024 + col;
          x1[o] = p.x[o] + g1 * acc[mt][nt][i];
        }
      }
  }
}

DI void phase7(const Params& p, char* smem, bool dry = false) {
  const int tid = opaque_tid(), lane = tid & 63, w = tid >> 6, r = lane & 31, h5 = lane >> 5;
  const float NEG = -__builtin_inff();
  const float* x1 = (const float*)(p.ws + OFF_X1);
  const float* mod = (const float*)(p.ws + OFF_MOD);
  u16* h2b = (u16*)(p.ws + OFF_H2B);
  const u16* wrT = (const u16*)(p.ws + OFF_WRT);
  int* cnt = (int*)(p.ws + OFF_CNT);
  int* list = (int*)(p.ws + OFF_LIST);
  float* topw = (float*)(p.ws + OFF_TOPW);
  float* lg = (float*)smem;
  for (int task = blockIdx.x; task < 256; task += gridDim.x) {
    const int row0 = task * 64, b = row0 >> 12;
    __syncthreads();
    {
      f32x4 gm[4], sh[4];
#pragma unroll
      for (int i = 0; i < 4; ++i) {
        const int k = i * 256 + lane * 4;
        const f32x4 nw = *(const f32x4*)(p.norm2_w + k);
        const f32x4 sc = *(const f32x4*)(mod + b * 6144 + 4096 + k);
        sh[i] = *(const f32x4*)(mod + b * 6144 + 3072 + k);
#pragma unroll
        for (int q = 0; q < 4; ++q) gm[i][q] = nw[q] * (1.f + sc[q]);
      }
#pragma unroll 1
      for (int rr = 0; rr < 8; ++rr) {
        const int row = w * 8 + rr; const size_t t = row0 + row;
        f32x4 xv[4]; float ssq = 0.f;
#pragma unroll
        for (int i = 0; i < 4; ++i) {
          xv[i] = *(const f32x4*)(x1 + t * 1024 + i * 256 + lane * 4);
          ssq += xv[i][0] * xv[i][0] + xv[i][1] * xv[i][1] + xv[i][2] * xv[i][2] + xv[i][3] * xv[i][3];
        }
        ssq = wave_sum(ssq);
        const float rn = rsqrtf(ssq * (1.f / 1024.f) + EPS);
#pragma unroll
        for (int i = 0; i < 4; ++i) {
          const int k = i * 256 + lane * 4;
          float o[4];
#pragma unroll
          for (int q = 0; q < 4; ++q) o[q] = xv[i][q] * rn * gm[i][q] + sh[i][q];
          u32x2 pk = {pack2(o[0], o[1]), pack2(o[2], o[3])};
          *(u32x2*)(h2b + t * 1024 + k) = pk;
          *(u32x2*)(smem + row * 2064 + k * 2) = pk;
        }
      }
    }
    __syncthreads();
    const int wq = w & 3, wh = w >> 2;
    f32x16 acc[2];
#pragma unroll
    for (int i = 0; i < 16; ++i) { acc[0][i] = 0.f; acc[1][i] = 0.f; }
    {
      const char* ap = smem + (wh * 32 + r) * 2064 + h5 * 16;
      const u16* bp0 = wrT + (size_t)(wq * 64 + r) * 1024 + h5 * 8;
      const u16* bp1 = bp0 + 32 * 1024;
#pragma unroll 4
      for (int ks = 0; ks < 64; ++ks) {
        const bf16x8 a = *(const bf16x8*)(ap + ks * 32);
        acc[0] = MFMA32(a, *(const bf16x8*)(bp0 + ks * 16), acc[0]);
        acc[1] = MFMA32(a, *(const bf16x8*)(bp1 + ks * 16), acc[1]);
      }
    }
    __syncthreads();
#pragma unroll
    for (int nt = 0; nt < 2; ++nt)
#pragma unroll
      for (int i = 0; i < 16; ++i) lg[(wh * 32 + crow(i, h5)) * 256 + wq * 64 + nt * 32 + r] = acc[nt][i];
    __syncthreads();
    const f32x4 eb = *(const f32x4*)(p.e_bias + lane * 4);
#pragma unroll 1
    for (int rr = 0; rr < 8; ++rr) {
      const int row = w * 8 + rr; const int t = row0 + row;
      const f32x4 lv = *(const f32x4*)(lg + row * 256 + lane * 4);
      float sc[4], ch[4];
#pragma unroll
      for (int q = 0; q < 4; ++q) { sc[q] = 1.f / (1.f + __expf(-lv[q])); ch[q] = sc[q] + eb[q]; }
      float m1 = fmaxf(ch[0], ch[1]), m2 = fminf(ch[0], ch[1]);
#pragma unroll
      for (int q = 2; q < 4; ++q) { const float v = ch[q]; m2 = fmaxf(m2, fminf(m1, v)); m1 = fmaxf(m1, v); }
#pragma unroll
      for (int sft = 1; sft < 8; sft <<= 1) {
        const float o1 = __shfl_xor(m1, sft), o2 = __shfl_xor(m2, sft);
        const float n1 = fmaxf(m1, o1); const float n2 = fmaxf(fminf(m1, o1), fmaxf(m2, o2));
        m1 = n1; m2 = n2;
      }
      const float gs = m1 + m2; const int mygrp = lane >> 3;
      int rank = 0;
#pragma unroll
      for (int q = 0; q < 8; ++q) { const float og = __shfl(gs, q * 8); rank += (og > gs || (og == gs && q < mygrp)) ? 1 : 0; }
      const bool allowed = rank < 4;
      float cand[4];
#pragma unroll
      for (int q = 0; q < 4; ++q) cand[q] = allowed ? ch[q] : NEG;
      float wsel = 0.f; int esel = 0; float wsum = 0.f;
#pragma unroll 1
      for (int k = 0; k < 8; ++k) {
        float bv = cand[0]; int bi = lane * 4;
#pragma unroll
        for (int q = 1; q < 4; ++q) if (cand[q] > bv) { bv = cand[q]; bi = lane * 4 + q; }
#pragma unroll
        for (int sft = 32; sft >= 1; sft >>= 1) {
          const float ov = __shfl_xor(bv, sft); const int oi = __shfl_xor(bi, sft);
          if (ov > bv || (ov == bv && oi < bi)) { bv = ov; bi = oi; }
        }
        float sv = 0.f;
        if ((bi >> 2) == lane) {
#pragma unroll
          for (int q = 0; q < 4; ++q) if ((bi & 3) == q) { sv = sc[q]; cand[q] = NEG; }
        }
        sv = __shfl(sv, bi >> 2);
        wsum += sv;
        if (lane == k) { wsel = sv; esel = bi; }
      }
      if (lane < 8 && !dry) {
        const float wgt = wsel / wsum * 2.5f;
        const int pos = atomicAdd(&cnt[esel], 1);
        list[(size_t)esel * LISTCAP + pos] = t * 8 + lane;
        topw[t * 8 + lane] = wgt;
      }
    }
  }
}

DI int perm_e(int o) { return (o & 31) * 8 + (o >> 5); }
DI void build_tables(const Params& p, int* tbl) {
  const int tid = opaque_tid();
  const int* cnt = (const int*)(p.ws + OFF_CNT);
  __syncthreads();
  if (tid < 256) tbl[520 + tid] = cnt[perm_e(tid)];
  __syncthreads();
  if (tid < 256) {
    int tp = 0, rp = 0;
    for (int o = 0; o < tid; ++o) { const int cc = tbl[520 + o]; tp += (cc + 255) >> 8; rp += cc; }
    tbl[tid] = tp; tbl[260 + tid] = rp;
    if (tid == 255) { const int cc = tbl[520 + 255]; tbl[256] = tp + ((cc + 255) >> 8); tbl[260 + 256] = rp + cc; }
  }
  __syncthreads();
}
DI int find_o(const int* tbl, int g, int item) {
  int lo = 32 * g, hi = 32 * g + 31;
  while (lo < hi) { const int mid = (lo + hi + 1) >> 1; if (tbl[mid] <= item) lo = mid; else hi = mid - 1; }
  return lo;
}

template <int MT>
DI void p8_tile(const Params& p, char* smem, int e, int rbeg, int cnt_e, int rowbase, int nchunk) {
  const int tid = opaque_tid(), lane = tid & 63, w = tid >> 6, wm = w >> 2, wn = w & 3, r = lane & 31, h5 = lane >> 5;
  const u16* h2b = (const u16*)(p.ws + OFF_H2B);
  const int* list = (const int*)(p.ws + OFF_LIST);
  LoadBf16<MT> al;
#pragma unroll
  for (int i = 0; i < MT; ++i) {
    const int rr = rbeg + (tid >> 3) + 64 * i;
    int tok = 0;
    if (rr < cnt_e) tok = (e < 256) ? (list[(size_t)e * LISTCAP + rr] >> 3) : rr;
    al.rp[i] = h2b + (size_t)tok * 1024 + src_chunk(tid);
  }
  f32x16 acc[MT][2];
  if (e < 256) {
    BLoadF32 bl;
    const int n4 = (tid & 63) * 4, kg = tid >> 6;
    const int twn = n4 >> 6, tnt = (n4 >> 5) & 1, jj = n4 & 31;
    const int col = nchunk * 128 + twn * 32 + jj;
    bl.ldb = 256; bl.p = (tnt ? p.w3 : p.w1) + (size_t)e * 1024 * 256 + (size_t)(kg * 8) * 256 + col;
    gemm_mainloop<MT>(al, bl, 16, smem, acc);
  } else {
    LoadBf16<4> bl;
    const u16* ws13T = (const u16*)(p.ws + OFF_WS13T);
#pragma unroll
    for (int i = 0; i < 4; ++i) bl.rp[i] = ws13T + (size_t)(nchunk * 256 + (tid >> 3) + 64 * i) * 1024 + src_chunk(tid);
    gemm_mainloop<MT>(al, bl, 16, smem, acc);
  }
  u16* actp = (e < 256) ? ((u16*)(p.ws + OFF_ACT) + (size_t)rowbase * 256) : (u16*)(p.ws + OFF_ACTS);
  float* cs = (float*)smem;
#pragma unroll 1
  for (int half = 0; half < (MT == 4 ? 2 : 1); ++half) {
    __syncthreads();
    if (MT == 2 || wm == half) {
      const int rb = (MT == 4) ? 0 : wm * 64;
#pragma unroll
      for (int mt = 0; mt < MT; ++mt)
#pragma unroll
        for (int i = 0; i < 16; ++i) cs[(rb + mt * 32 + crow(i, h5)) * 132 + wn * 32 + r] = siluf(acc[mt][0][i]) * acc[mt][1][i];
    }
    __syncthreads();
#pragma unroll 1
    for (int it = 0; it < 4; ++it) {
      const int i = it * NTHR + tid, row = i >> 4, c8 = (i & 15) * 8;
      const int rr = rbeg + half * 128 + row;
      if (rr < cnt_e) {
        const f32x4 va = *(const f32x4*)(cs + row * 132 + c8), vb = *(const f32x4*)(cs + row * 132 + c8 + 4);
        *(u32x4*)(actp + (size_t)rr * 256 + nchunk * 128 + c8) = pack8(va[0], va[1], va[2], va[3], vb[0], vb[1], vb[2], vb[3]);
      }
    }
  }
}

DI void phase8(const Params& p, char* smem) {
  const int g = blockIdx.x & 7, j = blockIdx.x >> 3, nj = gridDim.x >> 3;
  int* tbl = (int*)(smem + LDS_TBL);
  build_tables(p, tbl);
  const int t0 = tbl[32 * g], ntl = tbl[32 * g + 32] - t0;
  const int ntask = ntl * 2 + 16;
  for (int id = j; id < ntask; id += nj) {
    if (id < ntl * 2) {
      const int item = t0 + (id >> 1), nchunk = id & 1;
      const int o = find_o(tbl, g, item);
      const int e = perm_e(o), rbeg = (item - tbl[o]) * 256, cnt_e = tbl[520 + o], rowbase = tbl[260 + o];
      if (cnt_e - rbeg > 128) p8_tile<4>(p, smem, e, rbeg, cnt_e, rowbase, nchunk);
      else                    p8_tile<2>(p, smem, e, rbeg, cnt_e, rowbase, nchunk);
    } else {
      const int sid = id - ntl * 2;
      p8_tile<4>(p, smem, 256, (8 * g + (sid >> 1)) * 256, T, 0, sid & 1);
    }
  }
}

template <int MT>
DI void p9_tile(const Params& p, char* smem, int e, int rbeg, int cnt_e, int rowbase, int ntile) {
  const int tid = opaque_tid(), lane = tid & 63, w = tid >> 6, wm = w >> 2, wn = w & 3, r = lane & 31, h5 = lane >> 5;
  const int* list = (const int*)(p.ws + OFF_LIST);
  const float* topw = (const float*)(p.ws + OFF_TOPW);
  u16* y = (u16*)(p.ws + OFF_Y);
  const u16* actp = (const u16*)(p.ws + OFF_ACT) + (size_t)rowbase * 256;
  LoadBf16<MT> al; BLoadF32 bl;
#pragma unroll
  for (int i = 0; i < MT; ++i) {
    int rr = rbeg + (tid >> 3) + 64 * i;
    if (rr >= cnt_e) rr = 0;
    al.rp[i] = actp + (size_t)rr * 256 + src_chunk(tid);
  }
  bl.ldb = 1024;
  bl.p = p.w2 + (size_t)e * 256 * 1024 + (size_t)((tid >> 6) * 8) * 1024 + ntile * 256 + (tid & 63) * 4;
  f32x16 acc[MT][2];
  gemm_mainloop<MT>(al, bl, 4, smem, acc);
  float* cs = (float*)smem;
#pragma unroll 1
  for (int half = 0; half < (MT == 4 ? 2 : 1); ++half) {
    __syncthreads();
    stage_nat<MT>(cs, acc, half);
    __syncthreads();
#pragma unroll 1
    for (int it = 0; it < 8; ++it) {
      const int i = it * NTHR + tid, row = i >> 5, c8 = (i & 31) * 8;
      const int rr = rbeg + half * 128 + row;
      if (rr < cnt_e) {
        const int asg = list[(size_t)e * LISTCAP + rr];
        const float wg = topw[asg];
        const f32x4 va = *(const f32x4*)(cs + row * 260 + c8), vb = *(const f32x4*)(cs + row * 260 + c8 + 4);
        *(u32x4*)(y + (size_t)asg * 1024 + ntile * 256 + c8) = pack8(va[0] * wg, va[1] * wg, va[2] * wg, va[3] * wg, vb[0] * wg, vb[1] * wg, vb[2] * wg, vb[3] * wg);
      }
    }
  }
}

DI void phase9(const Params& p, char* smem) {
  const int g = blockIdx.x & 7, j = blockIdx.x >> 3, nj = gridDim.x >> 3;
  int* tbl = (int*)(smem + LDS_TBL);
  build_tables(p, tbl);
  const int t0 = tbl[32 * g], ntl = tbl[32 * g + 32] - t0;
  const int ntask = ntl * 4;
  for (int id = j; id < ntask; id += nj) {
    const int item = t0 + (id >> 2), ntile = id & 3;
    const int o = find_o(tbl, g, item);
    const int e = perm_e(o), rbeg = (item - tbl[o]) * 256, cnt_e = tbl[520 + o], rowbase = tbl[260 + o];
    if (cnt_e - rbeg > 128) p9_tile<4>(p, smem, e, rbeg, cnt_e, rowbase, ntile);
    else                    p9_tile<2>(p, smem, e, rbeg, cnt_e, rowbase, ntile);
  }
}

DI void phase10(const Params& p, char* smem) {
  const int tid = opaque_tid();
  const u16* acts = (const u16*)(p.ws + OFF_ACTS);
  const u16* ws2T = (const u16*)(p.ws + OFF_WS2T);
  const u16* y = (const u16*)(p.ws + OFF_Y);
  const float* x1 = (const float*)(p.ws + OFF_X1);
  const float* mod = (const float*)(p.ws + OFF_MOD);
  float* cs = (float*)smem;
  for (int id = blockIdx.x; id < 256; id += gridDim.x) {
    const int mtile = id >> 2, ntile = id & 3, row0 = mtile * 256, b = row0 >> 12;
    LoadBf16<4> al; LoadBf16<4> bl;
#pragma unroll
    for (int i = 0; i < 4; ++i) {
      al.rp[i] = acts + (size_t)(row0 + (tid >> 3) + 64 * i) * 256 + src_chunk(tid);
      bl.rp[i] = ws2T + (size_t)(ntile * 256 + (tid >> 3) + 64 * i) * 256 + src_chunk(tid);
    }
    f32x16 acc[4][2];
    gemm_mainloop<4>(al, bl, 4, smem, acc);
#pragma unroll 1
    for (int half = 0; half < 2; ++half) {
      __syncthreads();
      stage_nat<4>(cs, acc, half);
      __syncthreads();
#pragma unroll 1
      for (int it = 0; it < 8; ++it) {
        const int i = it * NTHR + tid, row = i >> 5, c8 = (i & 31) * 8;
        const size_t t = row0 + half * 128 + row; const int col = ntile * 256 + c8;
        float v[8];
        {
          const f32x4 va = *(const f32x4*)(cs + row * 260 + c8), vb = *(const f32x4*)(cs + row * 260 + c8 + 4);
          v[0] = va[0]; v[1] = va[1]; v[2] = va[2]; v[3] = va[3]; v[4] = vb[0]; v[5] = vb[1]; v[6] = vb[2]; v[7] = vb[3];
        }
#pragma unroll
        for (int k = 0; k < 8; ++k) {
          const u32x4 yy = *(const u32x4*)(y + (t * 8 + k) * 1024 + col);
          v[0] += bflo(yy[0]); v[1] += bfhi(yy[0]); v[2] += bflo(yy[1]); v[3] += bfhi(yy[1]);
          v[4] += bflo(yy[2]); v[5] += bfhi(yy[2]); v[6] += bflo(yy[3]); v[7] += bfhi(yy[3]);
        }
        const f32x4 g2a = *(const f32x4*)(mod + b * 6144 + 5120 + col), g2b = *(const f32x4*)(mod + b * 6144 + 5120 + col + 4);
        const f32x4 xa = *(const f32x4*)(x1 + t * 1024 + col), xb = *(const f32x4*)(x1 + t * 1024 + col + 4);
        f32x4 oa = {xa[0] + g2a[0] * v[0], xa[1] + g2a[1] * v[1], xa[2] + g2a[2] * v[2], xa[3] + g2a[3] * v[3]};
        f32x4 ob = {xb[0] + g2b[0] * v[4], xb[1] + g2b[1] * v[5], xb[2] + g2b[2] * v[6], xb[3] + g2b[3] * v[7]};
        *(f32x4*)(p.out + t * 1024 + col) = oa;
        *(f32x4*)(p.out + t * 1024 + col + 4) = ob;
      }
    }
  }
}

#define XB_TMO      128
#define XB_XCNT(j)  (256  + 64 * (j))
#define XB_XSUB(j)  (1280 + 64 * (j))
#define XB_XGEN(j)  (2304 + 64 * (j))
#define XB_TOP      3328
#define XB_TOPGEN   3392
#define XCD_BAR_WORDS 3456
#define XB_SPIN_CAP (1u << 22)
#define LAS __attribute__((address_space(3)))
DI unsigned xb_ld(unsigned* p)              { return __hip_atomic_load(p, __ATOMIC_RELAXED, __HIP_MEMORY_SCOPE_AGENT); }
DI unsigned xb_add(unsigned* p, unsigned v) { return __hip_atomic_fetch_add(p, v, __ATOMIC_RELAXED, __HIP_MEMORY_SCOPE_AGENT); }
DI unsigned xb_xcc_id() { return (unsigned)__builtin_amdgcn_s_getreg((3 << 11) | 20) & 0xFu; }
#define XB_SPIN(cond, bar) do { unsigned _sp = 0; while (cond) { __builtin_amdgcn_s_sleep(1); \
    if ((++_sp & 255u) == 0u) { if (xb_ld(&(bar)[XB_TMO])) break; if (_sp > XB_SPIN_CAP) { atomicAdd(&(bar)[XB_TMO], 1u); break; } } } } while (0)
struct XcdBarrier { unsigned* bar; unsigned x; volatile LAS unsigned* st; };
DI XcdBarrier xcd_barrier_post(unsigned* bar, volatile LAS unsigned* st) {
  XcdBarrier b; b.bar = bar; b.x = xb_xcc_id(); b.st = st;
  if (threadIdx.x == 0) (void)xb_add(&bar[XB_XCNT(b.x)], 1u);
  return b;
}
DI void xcd_barrier_complete(unsigned* bar, unsigned x, unsigned& nloc, unsigned& nx) {
  const unsigned G = gridDim.x * gridDim.y * gridDim.z;
  unsigned sum, cnt, mine, sp = 0u;
  for (;;) {
    sum = 0u; cnt = 0u; mine = 0u;
#pragma unroll
    for (unsigned j = 0; j < 16; ++j) { const unsigned c = xb_ld(&bar[XB_XCNT(j)]); sum += c; cnt += (c > 0u) ? 1u : 0u; mine = (j == x) ? c : mine; }
    if (sum == G) break;
    __builtin_amdgcn_s_sleep(1);
    if ((++sp & 255u) == 0u) { if (xb_ld(&bar[XB_TMO])) break; if (sp > XB_SPIN_CAP) { atomicAdd(&bar[XB_TMO], 1u); break; } }
  }
  nloc = mine > 0u ? mine : 1u; nx = cnt > 0u ? cnt : 1u;
}
DI void xcd_barrier(const XcdBarrier& b) {
  asm volatile("s_waitcnt vmcnt(0)" ::: "memory");
  __syncthreads();
  if (threadIdx.x == 0) {
    unsigned* bar = b.bar;
    __builtin_amdgcn_s_waitcnt(0);
    unsigned nloc = b.st[0], nx = b.st[1];
    if (nloc == 0u) { xcd_barrier_complete(bar, b.x, nloc, nx); b.st[0] = nloc; b.st[1] = nx; }
    const unsigned old = xb_add(&bar[XB_XSUB(b.x)], 1u);
    const unsigned gen = old / nloc;
    if (old + 1u == (gen + 1u) * nloc) {
      __builtin_amdgcn_fence(__ATOMIC_RELEASE, "agent");
      asm volatile("s_waitcnt vmcnt(0)" ::: "memory");
      const unsigned og = xb_add(&bar[XB_TOP], 1u);
      const unsigned tg = og / nx;
      if (og + 1u == (tg + 1u) * nx) xb_add(&bar[XB_TOPGEN], 1u);
      else XB_SPIN(xb_ld(&bar[XB_TOPGEN]) == tg, bar);
      __builtin_amdgcn_fence(__ATOMIC_ACQUIRE, "agent");
      xb_add(&bar[XB_XGEN(b.x)], 1u);
      asm volatile("s_waitcnt vmcnt(0)" ::: "memory");
    } else {
      XB_SPIN(xb_ld(&bar[XB_XGEN(b.x)]) == gen, bar);
      __builtin_amdgcn_fence(__ATOMIC_ACQUIRE, "agent");
      asm volatile("s_waitcnt vmcnt(0)" ::: "memory");
    }
  }
  __syncthreads();
}


#if !FUSED
#define PHASE_KERNEL(name, body)                                                 \
  __global__ void __launch_bounds__(NTHR, 2) name(Params p) {                    \
    __shared__ __attribute__((aligned(16))) char smem[LDS_BYTES];                \
    body;                                                                        \
  }
PHASE_KERNEL(k_p0, phase0(p, smem))
PHASE_KERNEL(k_p1, phase1(p); (void)smem)
PHASE_KERNEL(k_p2, phase2(p, smem); phase2_ga(p, smem))
PHASE_KERNEL(k_p3, phase_moba(p, smem, 0, 512); phase_gla_a(p))
PHASE_KERNEL(k_p4, phase_gla_b(p); (void)smem)
PHASE_KERNEL(k_p5, phase_gla_c(p); (void)smem)
PHASE_KERNEL(k_p6, phase6(p, smem))
PHASE_KERNEL(k_p7, phase7(p, smem))
PHASE_KERNEL(k_p8, phase8(p, smem))
PHASE_KERNEL(k_p9, phase9(p, smem))
PHASE_KERNEL(k_p10, phase10(p, smem))
#else
__global__ void __launch_bounds__(NTHR, 2) k_fused(Params p) {
  __shared__ __attribute__((aligned(16))) char smem[LDS_BYTES];
  volatile LAS unsigned* st = (volatile LAS unsigned*)(smem + LDS_BYTES - 16);
  if (threadIdx.x == 0) { st[0] = 0u; st[1] = 0u; st[2] = 0u; st[3] = 0u; }
  __syncthreads();
  (void)xcd_barrier_post((unsigned*)(p.ws + OFF_BAR), st);
#define GRID_BARRIER() do { XcdBarrier xb_; xb_.bar = (unsigned*)(p.ws + OFF_BAR); xb_.x = xb_xcc_id(); xb_.st = (volatile LAS unsigned*)(smem + LDS_BYTES - 16); xcd_barrier(xb_); } while (0)
  phase0(p, smem);
  if (DUPMASK & 64) phase0(p, smem);
  GRID_BARRIER();
  phase1(p);
  if (DUPMASK & 64) phase1(p);
  GRID_BARRIER();
  phase2(p, smem); phase2_ga(p, smem);
  if (DUPMASK & 1) { phase2(p, smem); phase2_ga(p, smem); }
  GRID_BARRIER();
  phase_moba(p, smem, 0, 512);
  if (DUPMASK & 2) phase_moba(p, smem, 0, 512);
  phase_gla_a(p);
  if (DUPMASK & 128) phase_gla_a(p);
  GRID_BARRIER();
  phase_gla_b(p);
  if (DUPMASK & 128) phase_gla_b(p);
  GRID_BARRIER();
  phase_gla_c(p);
  if (DUPMASK & 128) phase_gla_c(p);
  GRID_BARRIER();
  phase6(p, smem);
  if (DUPMASK & 4) phase6(p, smem);
  GRID_BARRIER();
  phase7(p, smem);
  if (DUPMASK & 256) phase7(p, smem, true);
  GRID_BARRIER();
  phase8(p, smem);
  if (DUPMASK & 8) phase8(p, smem);
  GRID_BARRIER();
  phase9(p, smem);
  if (DUPMASK & 16) phase9(p, smem);
  GRID_BARRIER();
  phase10(p, smem);
  if (DUPMASK & 32) phase10(p, smem);
}
#endif

extern "C" void kernel_launch(void* const* d_in, const int* in_sizes, int n_in, void* d_out, int out_size, void* d_ws, size_t ws_size,
                              hipStream_t stream) {
  if (n_in != 23 || out_size != T * D || ws_size < WS_END) {
    fprintf(stderr, "kernel_launch: unexpected problem (n_in %d, out %d, ws %zu, need %zu)\n", n_in, out_size, ws_size, (size_t)WS_END);
    return;
  }
  Params p{};
  const float** f = (const float**)&p;
  for (int i = 0; i < 23; ++i) f[i] = (const float*)d_in[i];
  p.out = (float*)d_out;
  p.ws = (unsigned char*)d_ws;
  (void)hipMemsetAsync(d_ws, 0, ZERO_BYTES, stream);
#if !FUSED
  const dim3 grid(256), blk(NTHR);
  hipLaunchKernelGGL(k_p0, grid, blk, 0, stream, p);
  hipLaunchKernelGGL(k_p1, grid, blk, 0, stream, p);
  hipLaunchKernelGGL(k_p2, grid, blk, 0, stream, p);
  hipLaunchKernelGGL(k_p3, grid, blk, 0, stream, p);
  hipLaunchKernelGGL(k_p4, grid, blk, 0, stream, p);
  hipLaunchKernelGGL(k_p5, grid, blk, 0, stream, p);
  hipLaunchKernelGGL(k_p6, grid, blk, 0, stream, p);
  hipLaunchKernelGGL(k_p7, grid, blk, 0, stream, p);
  hipLaunchKernelGGL(k_p8, grid, blk, 0, stream, p);
  hipLaunchKernelGGL(k_p9, grid, blk, 0, stream, p);
  hipLaunchKernelGGL(k_p10, grid, blk, 0, stream, p);
#else
  static int grid_blocks = 0;
  if (!grid_blocks) {
    int dev = 0, cus = 0, per_cu = 0;
    (void)hipGetDevice(&dev);
    (void)hipDeviceGetAttribute(&cus, hipDeviceAttributeMultiprocessorCount, dev);
    (void)hipOccupancyMaxActiveBlocksPerMultiprocessor(&per_cu, k_fused, NTHR, 0);
    if (per_cu < 1) fprintf(stderr, "kernel_launch: occupancy query reports %d blocks per CU\n", per_cu);
    grid_blocks = cus;
    grid_blocks -= grid_blocks % 8;
  }
  hipLaunchKernelGGL(k_fused, dim3(grid_blocks), dim3(NTHR), 0, stream, p);
#endif
}
```

```cpp
#include <hip/hip_runtime.h>
#include <stdint.h>
#include <stdio.h>

#ifndef FUSED
#define FUSED 1
#endif
#ifndef TPROBE
#define TPROBE 0
#endif

#define DI __device__ __forceinline__
typedef short bf16x8 __attribute__((ext_vector_type(8)));
typedef float f32x16 __attribute__((ext_vector_type(16)));
typedef float f32x4 __attribute__((ext_vector_type(4)));
typedef unsigned u32x4 __attribute__((ext_vector_type(4)));
typedef unsigned u32x2 __attribute__((ext_vector_type(2)));
typedef __bf16 bf16x2_t __attribute__((ext_vector_type(2)));
typedef float f32x2_t __attribute__((ext_vector_type(2)));
typedef unsigned short u16;

#define MFMA32(a, b, c) __builtin_amdgcn_mfma_f32_32x32x16_bf16((a), (b), (c), 0, 0, 0)

constexpr int Bn = 4, S = 4096, D = 1024, T = Bn * S;
constexpr int DIN = 3088;
constexpr int NE = 256;
constexpr float EPS = 1e-6f;
constexpr float LOG2E = 1.4426950408889634f;
constexpr int LISTCAP = 16384;
constexpr int NTHR = 512;

constexpr size_t al256(size_t x) { return (x + 255) & ~(size_t)255; }
constexpr size_t OFF_BAR   = 0;
constexpr size_t OFF_CNT   = 16384;
constexpr int CNT_STRIDE = 32;
constexpr size_t OFF_QC    = 16384 + 256 * 128;
constexpr size_t ZERO_BYTES = OFF_QC + 16 * 128;
constexpr size_t OFF_KMEAN = ZERO_BYTES;
constexpr size_t OFF_MOD   = al256(OFF_KMEAN + 4 * 8 * 16 * 64 * 4);
constexpr size_t OFF_WRT   = al256(OFF_MOD + 4 * 6144 * 4);
constexpr size_t OFF_WINT  = al256(OFF_WRT + 256 * 1024 * 2);
constexpr size_t OFF_WOUTT = al256(OFF_WINT + (size_t)3088 * 1024 * 2);
constexpr size_t OFF_WS13T = al256(OFF_WOUTT + (size_t)1024 * 1024 * 2);
constexpr size_t OFF_WS2T  = al256(OFF_WS13T + (size_t)512 * 1024 * 2);
constexpr size_t OFF_H1B   = al256(OFF_WS2T + (size_t)1024 * 256 * 2);
constexpr size_t OFF_MQ    = al256(OFF_H1B + (size_t)T * 1024 * 2);
constexpr size_t OFF_MK    = al256(OFF_MQ + (size_t)T * 512 * 2);
constexpr size_t OFF_VT    = al256(OFF_MK + (size_t)T * 512 * 2);
constexpr size_t OFF_GQ    = al256(OFF_VT + (size_t)T * 512 * 2);
constexpr size_t OFF_GK    = al256(OFF_GQ + (size_t)T * 256 * 2);
constexpr size_t OFF_GKT   = al256(OFF_GK + (size_t)T * 256 * 2);
constexpr size_t OFF_GVT   = al256(OFF_GKT + (size_t)T * 256 * 2);
constexpr size_t OFF_SG    = al256(OFF_GVT + (size_t)T * 512 * 2);
constexpr size_t OFF_BC    = al256(OFF_SG + (size_t)T * 512 * 2);
constexpr size_t OFF_BCT   = al256(OFF_BC + (size_t)T * 256 * 4);
constexpr size_t OFF_UT    = al256(OFF_BCT + (size_t)T * 256 * 4);
constexpr size_t OFF_DEC   = al256(OFF_UT + (size_t)16 * 64 * 128 * 64 * 4);
constexpr size_t OFF_ST    = al256(OFF_DEC + (size_t)16 * 64 * 64 * 4);
constexpr size_t OFF_MIX   = al256(OFF_ST + (size_t)16 * 64 * 128 * 64 * 2);
constexpr size_t OFF_D1    = al256(OFF_MIX + (size_t)T * 1024 * 2);
constexpr size_t OFF_H2B   = al256(OFF_D1 + (size_t)T * 1024 * 2);
constexpr size_t OFF_LIST  = al256(OFF_H2B + (size_t)T * 1024 * 2);
constexpr size_t OFF_TOPW  = al256(OFF_LIST + (size_t)256 * LISTCAP * 4);
constexpr size_t OFF_ACT   = al256(OFF_TOPW + (size_t)T * 8 * 4);
constexpr size_t OFF_ACTS  = al256(OFF_ACT + (size_t)T * 8 * 256 * 2);
constexpr size_t OFF_Y     = al256(OFF_ACTS + (size_t)T * 256 * 2);
constexpr size_t WS_END    = al256(OFF_Y + (size_t)T * 8 * 1024 * 2);

constexpr int LDS_C = 256 * 132 * 4;
constexpr int LDS_TBL = LDS_C;
constexpr int LDS_BYTES = LDS_C + 8192;

struct Params {
  const float *x, *c, *w_ada, *b_ada, *norm1_w, *norm2_w, *w_in, *q_norm_w, *k_norm_w, *rel_bias, *w_alpha, *b_alpha,
      *moba_out_w, *gla_out_w, *w_out, *w_router, *e_bias, *w1, *w3, *w2, *ws1, *ws3, *ws2;
  float* out;
  unsigned char* ws;
};

DI unsigned pack2(float a, float b) { f32x2_t v = {a, b}; return __builtin_bit_cast(unsigned, __builtin_convertvector(v, bf16x2_t)); }
DI float bflo(unsigned u) { return __uint_as_float(u << 16); }
DI float bfhi(unsigned u) { return __uint_as_float(u & 0xffff0000u); }
DI int opaque_tid() { int t = threadIdx.x; asm volatile("" : "+v"(t)); return t; }
DI int crow(int reg, int h) { return (reg & 3) + 8 * (reg >> 2) + 4 * h; }
DI int swz(int row) { return ((row >> 2) ^ (row >> 1)) & 7; }
DI u32x4 pack8(float a0, float a1, float a2, float a3, float a4, float a5, float a6, float a7) {
  u32x4 r; r[0] = pack2(a0, a1); r[1] = pack2(a2, a3); r[2] = pack2(a4, a5); r[3] = pack2(a6, a7); return r;
}
DI float wave_sum(float v) {
  v += __shfl_xor(v, 32); v += __shfl_xor(v, 16); v += __shfl_xor(v, 8); v += __shfl_xor(v, 4); v += __shfl_xor(v, 2); v += __shfl_xor(v, 1);
  return v;
}
DI float siluf(float x) { return x / (1.f + __expf(-x)); }

typedef __attribute__((address_space(3))) void* lds_ptr_t;
typedef const __attribute__((address_space(1))) void* glb_ptr_t;
template <int NR>
struct LoadBf16 {
  const u16* rp[NR];
  DI void issue(int kt, char* sX, int tid) {
#pragma unroll
    for (int i = 0; i < NR; ++i)
      __builtin_amdgcn_global_load_lds((glb_ptr_t)(rp[i] + kt * 64), (lds_ptr_t)(sX + i * 8192 + tid * 16), 16, 0, 0);
  }
  DI void prologue(char* s0, int nk, int tid) { issue(0, s0, tid); }
  DI void pre(int kt, int nk, char* nxt, int tid) { if (kt + 1 < nk) issue(kt + 1, nxt, tid); }
};
DI int src_chunk(int tid) { return ((tid & 7) ^ swz(tid >> 3)) * 8; }

struct BLoadF32 {
  const float* p;
  size_t ldb;
  f32x4 v[8];
  DI void issue(int kt) {
    const float* q = p + (size_t)kt * 64 * ldb;
#pragma unroll
    for (int i = 0; i < 8; ++i) v[i] = *(const f32x4*)(q + (size_t)i * ldb);
  }
  DI void commit(char* sB, int tid) {
    const int n4 = (tid & 63) * 4, kg = tid >> 6;
#pragma unroll
    for (int j = 0; j < 4; ++j) {
      const int n = n4 + j;
      u32x4 w = pack8(v[0][j], v[1][j], v[2][j], v[3][j], v[4][j], v[5][j], v[6][j], v[7][j]);
      *(u32x4*)(sB + n * 128 + ((kg ^ swz(n)) << 4)) = w;
    }
  }
  DI void prologue(char* s0, int nk, int tid) { issue(0); commit(s0, tid); if (nk > 1) issue(1); }
  DI void pre(int kt, int nk, char* nxt, int tid) {
    if (kt + 1 < nk) { commit(nxt, tid); if (kt + 2 < nk) issue(kt + 2); }
  }
};

template <int MT>
DI void mma_step(const char* sA, const char* sB, f32x16 (&acc)[MT][2], int lane, int wm, int wn) {
  const int r = lane & 31, h = lane >> 5, f = swz(r);
  const char* a0 = sA + (wm * (MT * 32) + r) * 128;
  const char* b0 = sB + (wn * 64 + r) * 128;
  bf16x8 fa[2][MT], fb[2][2];
  {
    const int off = ((h ^ f) << 4);
    fb[0][0] = *(const bf16x8*)(b0 + off); fb[0][1] = *(const bf16x8*)(b0 + 32 * 128 + off);
#pragma unroll
    for (int mt = 0; mt < MT; ++mt) fa[0][mt] = *(const bf16x8*)(a0 + mt * 32 * 128 + off);
  }
#pragma unroll
  for (int kk = 0; kk < 4; ++kk) {
    const int cb = kk & 1, nb = cb ^ 1;
    if (kk < 3) {
      const int off = ((((kk + 1) * 2 + h) ^ f) << 4);
      fb[nb][0] = *(const bf16x8*)(b0 + off); fb[nb][1] = *(const bf16x8*)(b0 + 32 * 128 + off);
#pragma unroll
      for (int mt = 0; mt < MT; ++mt) fa[nb][mt] = *(const bf16x8*)(a0 + mt * 32 * 128 + off);
    }
#pragma unroll
    for (int mt = 0; mt < MT; ++mt) {
      acc[mt][0] = MFMA32(fa[cb][mt], fb[cb][0], acc[mt][0]);
      acc[mt][1] = MFMA32(fa[cb][mt], fb[cb][1], acc[mt][1]);
    }
  }
}

template <int MT, class AL, class BL>
DI void gemm_mainloop(AL& al, BL& bl, int nk, char* smem, f32x16 (&acc)[MT][2]) {
  const int tid = opaque_tid(), lane = tid & 63, w = tid >> 6, wm = w >> 2, wn = w & 3;
#pragma unroll
  for (int i = 0; i < MT; ++i)
#pragma unroll
    for (int j = 0; j < 2; ++j)
#pragma unroll
      for (int r = 0; r < 16; ++r) acc[i][j][r] = 0.f;
  __syncthreads();
  al.prologue(smem, nk, tid); bl.prologue(smem + 32768, nk, tid);
  asm volatile("s_waitcnt vmcnt(0)" ::: "memory");
  __syncthreads();
  for (int kt = 0; kt < nk; ++kt) {
    const int cur = kt & 1;
    char* nxt = smem + (cur ^ 1) * 65536;
    al.pre(kt, nk, nxt, tid); bl.pre(kt, nk, nxt + 32768, tid);
    mma_step<MT>(smem + cur * 65536, smem + cur * 65536 + 32768, acc, lane, wm, wn);
    asm volatile("s_waitcnt vmcnt(0)" ::: "memory");
    __syncthreads();
  }
}

template <int MT>
DI void stage_nat(float* cs, const f32x16 (&acc)[MT][2], int half) {
  const int tid_ = opaque_tid(); const int lane = tid_ & 63, w = tid_ >> 6, wm = w >> 2, wn = w & 3, r = lane & 31, h = lane >> 5;
  if (MT == 4 && wm != half) return;
  const int rb = (MT == 4) ? 0 : wm * 64;
#pragma unroll
  for (int mt = 0; mt < MT; ++mt)
#pragma unroll
    for (int nt = 0; nt < 2; ++nt)
#pragma unroll
      for (int g = 0; g < 16; ++g) cs[(rb + mt * 32 + crow(g, h)) * 260 + wn * 64 + nt * 32 + r] = acc[mt][nt][g];
}
DI void stage_tr(float* cs, const f32x16 (&acc)[4][2], int half) {
  const int tid_ = opaque_tid(); const int lane = tid_ & 63, w = tid_ >> 6, wm = w >> 2, wn = w & 3, r = lane & 31, h = lane >> 5;
  if (wm != half) return;
#pragma unroll
  for (int mt = 0; mt < 4; ++mt)
#pragma unroll
    for (int nt = 0; nt < 2; ++nt)
#pragma unroll
      for (int g = 0; g < 4; ++g) {
        f32x4 v = {acc[mt][nt][4 * g], acc[mt][nt][4 * g + 1], acc[mt][nt][4 * g + 2], acc[mt][nt][4 * g + 3]};
        *(f32x4*)(cs + (wn * 64 + nt * 32 + r) * 132 + mt * 32 + 8 * g + 4 * h) = v;
      }
}

DI void transpose_item(const float* src, int ld, int n_src_col, u16* dst_row, int k8) {
  float v[8];
#pragma unroll
  for (int j = 0; j < 8; ++j) v[j] = src[(size_t)(k8 + j) * ld + n_src_col];
  *(u32x4*)(dst_row + k8) = pack8(v[0], v[1], v[2], v[3], v[4], v[5], v[6], v[7]);
}

DI void phase0(const Params& p, char* smem) {
  const int tid = opaque_tid(), lane = tid & 63, w = tid >> 6;
  float* mod = (float*)(p.ws + OFF_MOD);
  float* sil = (float*)smem;
  float* red = sil + 4096;
  for (int task = blockIdx.x; task < 96; task += gridDim.x) {
    __syncthreads();
    for (int i = tid; i < 4096; i += NTHR) sil[i] = siluf(p.c[i]);
    __syncthreads();
    const int col = task * 64 + lane;
    float a0 = 0.f, a1 = 0.f, a2 = 0.f, a3 = 0.f;
    const float* wp = p.w_ada + (size_t)(w * 128) * 6144 + col;
#pragma unroll 32
    for (int k = 0; k < 128; ++k) {
      const float wv = wp[(size_t)k * 6144];
      const int kk = w * 128 + k;
      a0 += sil[kk] * wv; a1 += sil[1024 + kk] * wv; a2 += sil[2048 + kk] * wv; a3 += sil[3072 + kk] * wv;
    }
    red[(w * 4 + 0) * 64 + lane] = a0; red[(w * 4 + 1) * 64 + lane] = a1; red[(w * 4 + 2) * 64 + lane] = a2; red[(w * 4 + 3) * 64 + lane] = a3;
    __syncthreads();
    if (w < 4) {
      const int b = w;
      float s = 0.f;
#pragma unroll
      for (int q = 0; q < 8; ++q) s += red[(q * 4 + b) * 64 + lane];
      mod[b * 6144 + col] = s + p.b_ada[col];
    }
  }
  const int gsz = gridDim.x * NTHR, gid = blockIdx.x * NTHR + tid;
  u16* wrT = (u16*)(p.ws + OFF_WRT);
  for (int i = gid; i < 256 * 128; i += gsz) { const int n = i & 255, k8 = (i >> 8) * 8; transpose_item(p.w_router, 256, n, wrT + (size_t)n * 1024, k8); }
  u16* winT = (u16*)(p.ws + OFF_WINT);
  for (int i = gid; i < 3088 * 128; i += gsz) { const int n = i % 3088, k8 = (i / 3088) * 8; transpose_item(p.w_in, DIN, n, winT + (size_t)n * 1024, k8); }
  u16* woutT = (u16*)(p.ws + OFF_WOUTT);
  for (int i = gid; i < 1024 * 128; i += gsz) { const int n = i & 1023, k8 = (i >> 10) * 8; transpose_item(p.w_out, 1024, n, woutT + (size_t)n * 1024, k8); }
  u16* ws13T = (u16*)(p.ws + OFF_WS13T);
  for (int i = gid; i < 512 * 128; i += gsz) {
    const int n = i & 511, k8 = (i >> 9) * 8;
    const int col = (n >> 8) * 128 + ((n >> 6) & 3) * 32 + (n & 31);
    transpose_item(((n >> 5) & 1) ? p.ws3 : p.ws1, 256, col, ws13T + (size_t)n * 1024, k8);
  }
  u16* ws2T = (u16*)(p.ws + OFF_WS2T);
  for (int i = gid; i < 1024 * 32; i += gsz) { const int n = i & 1023, k8 = (i >> 10) * 8; transpose_item(p.ws2, 1024, n, ws2T + (size_t)n * 256, k8); }
}

DI void phase1(const Params& p) {
  const int tid = opaque_tid(), lane = tid & 63, w = tid >> 6;
  const float* mod = (const float*)(p.ws + OFF_MOD);
  u16* h1b = (u16*)(p.ws + OFF_H1B);
  const int nW = gridDim.x * 8;
  for (int t0 = blockIdx.x * 8 + w; t0 < T; t0 += 4 * nW) {
    f32x4 xv[4][4]; float ssq[4];
#pragma unroll
    for (int q = 0; q < 4; ++q) {
      const int t = t0 + q * nW;
      ssq[q] = 0.f;
      if (t < T) {
#pragma unroll
        for (int i = 0; i < 4; ++i) xv[q][i] = *(const f32x4*)(p.x + (size_t)t * 1024 + i * 256 + lane * 4);
      }
    }
#pragma unroll
    for (int q = 0; q < 4; ++q) {
      const int t = t0 + q * nW;
      if (t < T) {
#pragma unroll
        for (int i = 0; i < 4; ++i) ssq[q] += xv[q][i][0] * xv[q][i][0] + xv[q][i][1] * xv[q][i][1] + xv[q][i][2] * xv[q][i][2] + xv[q][i][3] * xv[q][i][3];
      }
      ssq[q] = wave_sum(ssq[q]);
    }
#pragma unroll
    for (int q = 0; q < 4; ++q) {
      const int t = t0 + q * nW;
      if (t < T) {
        const int b = t >> 12;
        const float r = rsqrtf(ssq[q] * (1.f / 1024.f) + EPS);
#pragma unroll
        for (int i = 0; i < 4; ++i) {
          const int k = i * 256 + lane * 4;
          const f32x4 nw = *(const f32x4*)(p.norm1_w + k);
          const f32x4 sc = *(const f32x4*)(mod + b * 6144 + 1024 + k);
          const f32x4 sh = *(const f32x4*)(mod + b * 6144 + k);
          float o[4];
#pragma unroll
          for (int j = 0; j < 4; ++j) o[j] = xv[q][i][j] * r * nw[j] * (1.f + sc[j]) + sh[j];
          u32x2 pk = {pack2(o[0], o[1]), pack2(o[2], o[3])};
          *(u32x2*)(h1b + (size_t)t * 1024 + k) = pk;
        }
      }
    }
  }
}

DI float logsig(float z) { return fminf(z, 0.f) - log1pf(__expf(-fabsf(z))); }

DI void phase2(const Params& p, char* smem) {
  const int tid = opaque_tid();
  const u16* h1b = (const u16*)(p.ws + OFF_H1B);
  const u16* winT = (const u16*)(p.ws + OFF_WINT);
  float* cs = (float*)smem;
  const int xg = blockIdx.x & 7, xj = blockIdx.x >> 3, xn = gridDim.x >> 3;
  for (int l = xj; l < 96; l += xn) {
    const int mtile = xg * 8 + (l & 7), ntile = l >> 3;
    const int row0 = mtile * 256, b = row0 >> 12, s0 = row0 & 4095;
    LoadBf16<4> al; LoadBf16<4> bl;
#pragma unroll
    for (int i = 0; i < 4; ++i) {
      al.rp[i] = h1b + (size_t)(row0 + (tid >> 3) + 64 * i) * 1024 + src_chunk(tid);
      bl.rp[i] = winT + (size_t)(ntile * 256 + (tid >> 3) + 64 * i) * 1024 + src_chunk(tid);
    }
    f32x16 acc[4][2];
    gemm_mainloop<4>(al, bl, 16, smem, acc);
    const bool nat = (ntile < 4) || ntile == 6 || ntile == 7 || ntile >= 10;
    const bool tr = (ntile == 4 || ntile == 5 || (ntile >= 7 && ntile < 10));
    if (nat) {
      float ksum[8];
#pragma unroll
      for (int q = 0; q < 8; ++q) ksum[q] = 0.f;
#pragma unroll 1
      for (int half = 0; half < 2; ++half) {
        __syncthreads();
        stage_nat<4>(cs, acc, half);
        __syncthreads();
#pragma unroll 1
        for (int it = 0; it < 8; ++it) {
          const int i = it * NTHR + tid, row = i >> 5, c8 = (i & 31) * 8;
          const int srow = s0 + half * 128 + row;
          const f32x4 va = *(const f32x4*)(cs + row * 260 + c8), vb = *(const f32x4*)(cs + row * 260 + c8 + 4);
          float v[8] = {va[0], va[1], va[2], va[3], vb[0], vb[1], vb[2], vb[3]};
          const int d0 = c8 & 63;
          if (ntile < 4) {
            float ssq = 0.f;
#pragma unroll
            for (int q = 0; q < 8; ++q) ssq += v[q] * v[q];
            ssq += __shfl_xor(ssq, 1); ssq += __shfl_xor(ssq, 2); ssq += __shfl_xor(ssq, 4);
            const float sc = rsqrtf(ssq * (1.f / 64.f) + EPS);
            const float* nw = (ntile < 2) ? p.q_norm_w : p.k_norm_w;
#pragma unroll
            for (int q = 0; q < 8; ++q) v[q] = v[q] * sc * nw[d0 + q];
            const int hd = (ntile & 1) * 4 + (c8 >> 6);
            u16* dst = (u16*)(p.ws + (ntile < 2 ? OFF_MQ : OFF_MK)) + ((size_t)(b * 8 + hd) * S + srow) * 64 + d0;
            *(u32x4*)dst = pack8(v[0], v[1], v[2], v[3], v[4], v[5], v[6], v[7]);
            if (ntile >= 2) {
#pragma unroll
              for (int q = 0; q < 8; ++q) ksum[q] += v[q];
            }
          } else if (ntile < 8) {
            const int hd = c8 >> 6;
            if (ntile == 6) {
#pragma unroll
              for (int q = 0; q < 8; ++q) v[q] *= 0.125f;
            }
            u16* dst = (u16*)(p.ws + (ntile == 6 ? OFF_GQ : OFF_GK)) + ((size_t)(b * 4 + hd) * S + srow) * 64 + d0;
            *(u32x4*)dst = pack8(v[0], v[1], v[2], v[3], v[4], v[5], v[6], v[7]);
          } else {
#pragma unroll
            for (int q = 0; q < 8; ++q) v[q] = siluf(v[q]);
            u16* dst = (u16*)(p.ws + OFF_SG) + (size_t)(row0 + half * 128 + row) * 512 + (ntile - 10) * 256 + c8;
            *(u32x4*)dst = pack8(v[0], v[1], v[2], v[3], v[4], v[5], v[6], v[7]);
          }
        }
      }
      if (ntile == 2 || ntile == 3) {
        __syncthreads();
        const int c8 = (tid & 31) * 8;
#pragma unroll
        for (int q = 0; q < 8; ++q) cs[(tid >> 5) * 256 + c8 + q] = ksum[q];
        __syncthreads();
        if (tid < 256) {
          float s = 0.f;
#pragma unroll
          for (int q = 0; q < 16; ++q) s += cs[q * 256 + tid];
          const int hd = (ntile - 2) * 4 + (tid >> 6);
          float* km = (float*)(p.ws + OFF_KMEAN);
          km[((size_t)(b * 8 + hd) * 16 + (s0 >> 8)) * 64 + (tid & 63)] = s * (1.f / 256.f);
        }
      }
    }
    if (tr) {
#pragma unroll 1
      for (int half = 0; half < 2; ++half) {
        __syncthreads();
        stage_tr(cs, acc, half);
        __syncthreads();
#pragma unroll 1
        for (int it = 0; it < 8; ++it) {
          const int i = it * NTHR + tid, col = i >> 4, r8 = (i & 15) * 8;
          const int srow = s0 + half * 128 + r8;
          const f32x4 va = *(const f32x4*)(cs + col * 132 + r8), vb = *(const f32x4*)(cs + col * 132 + r8 + 4);
          u16* dst;
          if (ntile < 6)       dst = (u16*)(p.ws + OFF_VT) + ((size_t)(b * 8 + (ntile - 4) * 4 + (col >> 6)) * 64 + (col & 63)) * S + srow;
          else if (ntile == 7) dst = (u16*)(p.ws + OFF_GKT) + ((size_t)(b * 4 + (col >> 6)) * 64 + (col & 63)) * S + srow;
          else                 dst = (u16*)(p.ws + OFF_GVT) + ((size_t)(b * 4 + (ntile - 8) * 2 + (col >> 7)) * 128 + (col & 127)) * S + srow;
          *(u32x4*)dst = pack8(va[0], va[1], va[2], va[3], vb[0], vb[1], vb[2], vb[3]);
        }
      }
    }
  }
}

DI void phase2_ga(const Params& p, char* smem) {
  const int tid = opaque_tid(), lane = tid & 63, w = tid >> 6, r = lane & 31, h5 = lane >> 5;
  const u16* h1b = (const u16*)(p.ws + OFF_H1B);
  const u16* winT = (const u16*)(p.ws + OFF_WINT);
  float* gs = (float*)smem;
  for (int task = blockIdx.x; task < 256; task += gridDim.x) {
    const int row0 = task * 64, b = row0 >> 12, s0 = row0 & 4095;
    __syncthreads();
    if (w < 2) {
      f32x16 acc;
#pragma unroll
      for (int i = 0; i < 16; ++i) acc[i] = 0.f;
      const u16* ap = h1b + (size_t)(row0 + w * 32 + r) * 1024 + h5 * 8;
      const u16* bp = winT + (size_t)(3072 + (r & 15)) * 1024 + h5 * 8;
#pragma unroll 4
      for (int ks = 0; ks < 64; ++ks) acc = MFMA32(*(const bf16x8*)(ap + ks * 16), *(const bf16x8*)(bp + ks * 16), acc);
      if (r < 16) {
#pragma unroll
        for (int i = 0; i < 16; ++i) gs[(w * 32 + crow(i, h5)) * 17 + r] = acc[i];
      }
    }
    __syncthreads();
    if (tid < 256) {
      float wa[16];
#pragma unroll
      for (int q = 0; q < 16; ++q) wa[q] = p.w_alpha[q * 256 + tid];
      const float ba = p.b_alpha[tid];
      const int hd = tid >> 6, d = tid & 63;
      float* bc = (float*)(p.ws + OFF_BC) + ((size_t)(b * 4 + hd) * S + s0) * 64 + d;
      float* bct = (float*)(p.ws + OFF_BCT) + ((size_t)(b * 4 + hd) * 64 + d) * S + s0;
      float cum = 0.f;
#pragma unroll 1
      for (int r4 = 0; r4 < 16; ++r4) {
        f32x4 o;
#pragma unroll
        for (int q4 = 0; q4 < 4; ++q4) {
          const int row = r4 * 4 + q4;
          float z = ba;
#pragma unroll
          for (int q = 0; q < 16; ++q) z += gs[row * 17 + q] * wa[q];
          cum += logsig(z) * (1.f / 16.f);
          bc[(size_t)row * 64] = cum;
          o[q4] = cum;
        }
        *(f32x4*)(bct + r4 * 4) = o;
      }
    }
  }
}

DI int t5_bucket(int rel) {
  if (rel < 16) return rel;
  int bkt = 16;
  bkt += (rel >= 19); bkt += (rel >= 21); bkt += (rel >= 24); bkt += (rel >= 27); bkt += (rel >= 31); bkt += (rel >= 35); bkt += (rel >= 40);
  bkt += (rel >= 46); bkt += (rel >= 52); bkt += (rel >= 59); bkt += (rel >= 67); bkt += (rel >= 77); bkt += (rel >= 87); bkt += (rel >= 99); bkt += (rel >= 113);
  return bkt;
}

struct MobaState { f32x16 o0, o1; float m, l; };
struct MobaFrags { bf16x8 k[4]; u32x2 vlo[4], vhi[4]; };

DI void moba_lds_load(MobaFrags& f, const char* sp, int sb, int r, int h5) {
  const int fz = swz(r);
  const char* kp = sp + (sb * 32 + r) * 128;
#pragma unroll
  for (int ks = 0; ks < 4; ++ks) f.k[ks] = *(const bf16x8*)(kp + (((ks * 2 + h5) ^ fz) << 4));
#pragma unroll
  for (int s2 = 0; s2 < 2; ++s2)
#pragma unroll
    for (int dt = 0; dt < 2; ++dt) {
      const char* vp = sp + 8192 + (dt * 32 + r) * 128 + h5 * 8;
      const int c = sb * 4 + s2 * 2;
      f.vlo[s2 * 2 + dt] = *(const u32x2*)(vp + ((c ^ fz) << 4));
      f.vhi[s2 * 2 + dt] = *(const u32x2*)(vp + (((c + 1) ^ fz) << 4));
    }
}

template <int MODE>
DI void moba_subtile(MobaState& st, const bf16x8 (&qf)[4], const MobaFrags& f, int kpos0, int qpos, bool sel,
                     const float* lut, float cb31, int r, int h5) {
  const float NEG = -__builtin_inff();
  f32x16 s;
#pragma unroll
  for (int i = 0; i < 16; ++i) s[i] = 0.f;
#pragma unroll
  for (int ks = 0; ks < 4; ++ks) s = MFMA32(f.k[ks], qf[ks], s);
  const float c1 = 0.125f * LOG2E;
  float t[16]; float tm = NEG;
  if (MODE == 0) {
    const float c1e = sel ? c1 : 0.f, cbe = sel ? cb31 : NEG;
    float sm = s[0];
#pragma unroll
    for (int i = 1; i < 16; ++i) sm = fmaxf(sm, s[i]);
    tm = sm * c1e + cbe;
    tm = fmaxf(tm, __shfl_xor(tm, 32));
    const float mn = fmaxf(st.m, tm);
    const float mu = (mn == NEG) ? 0.f : mn;
    const float alpha = __builtin_amdgcn_exp2f(st.m - mu);
    const float off = cbe - mu;
    float psum = 0.f;
#pragma unroll
    for (int i = 0; i < 16; ++i) { t[i] = __builtin_amdgcn_exp2f(s[i] * c1e + off); psum += t[i]; }
    st.l = st.l * alpha + psum; st.m = mn;
    if (__any(alpha != 1.f)) {
#pragma unroll
      for (int i = 0; i < 16; ++i) { st.o0[i] *= alpha; st.o1[i] *= alpha; }
    }
  } else {
#pragma unroll
    for (int i = 0; i < 16; ++i) {
      const int rel = qpos - (kpos0 + crow(i, h5));
      const float bias = (rel >= 128) ? cb31 : lut[rel < 0 ? 0 : rel];
      float tv = s[i] * c1 + bias;
      if (MODE == 2 && rel < 0) tv = NEG;
      if (MODE == 1 && !sel) tv = NEG;
      t[i] = tv; tm = fmaxf(tm, tv);
    }
    tm = fmaxf(tm, __shfl_xor(tm, 32));
    const float mn = fmaxf(st.m, tm);
    const float mu = (mn == NEG) ? 0.f : mn;
    const float alpha = __builtin_amdgcn_exp2f(st.m - mu);
    float psum = 0.f;
#pragma unroll
    for (int i = 0; i < 16; ++i) { t[i] = __builtin_amdgcn_exp2f(t[i] - mu); psum += t[i]; }
    st.l = st.l * alpha + psum; st.m = mn;
#pragma unroll
    for (int i = 0; i < 16; ++i) { st.o0[i] *= alpha; st.o1[i] *= alpha; }
  }
  const bf16x8 pf0 = __builtin_bit_cast(bf16x8, pack8(t[0], t[1], t[2], t[3], t[4], t[5], t[6], t[7]));
  const bf16x8 pf1 = __builtin_bit_cast(bf16x8, pack8(t[8], t[9], t[10], t[11], t[12], t[13], t[14], t[15]));
#pragma unroll
  for (int s2 = 0; s2 < 2; ++s2) {
#pragma unroll
    for (int dt = 0; dt < 2; ++dt) {
      u32x4 vv = {f.vlo[s2 * 2 + dt][0], f.vlo[s2 * 2 + dt][1], f.vhi[s2 * 2 + dt][0], f.vhi[s2 * 2 + dt][1]};
      const bf16x8 vf = __builtin_bit_cast(bf16x8, vv);
      if (dt == 0) st.o0 = MFMA32(vf, s2 ? pf1 : pf0, st.o0); else st.o1 = MFMA32(vf, s2 ? pf1 : pf0, st.o1);
    }
  }
}

template <int MODE>
DI void moba_tile(MobaState& st, const bf16x8 (&qf)[4], const char* sp, int kpos0, int qpos, bool sel,
                  const float* lut, float cb31, int r, int h5) {
  const float NEG = -__builtin_inff();
  MobaFrags f0, f1;
  moba_lds_load(f0, sp, 0, r, h5);
  moba_lds_load(f1, sp, 1, r, h5);
  f32x16 s0, s1;
#pragma unroll
  for (int i = 0; i < 16; ++i) { s0[i] = 0.f; s1[i] = 0.f; }
#pragma unroll
  for (int ks = 0; ks < 4; ++ks) { s0 = MFMA32(f0.k[ks], qf[ks], s0); s1 = MFMA32(f1.k[ks], qf[ks], s1); }
  const float c1 = 0.125f * LOG2E;
  float t0[16], t1[16]; float tm;
  float alpha;
  if (MODE == 0) {
    const float c1e = sel ? c1 : 0.f, cbe = sel ? cb31 : NEG;
    float sm = fmaxf(s0[0], s1[0]);
#pragma unroll
    for (int i = 1; i < 16; ++i) sm = fmaxf(sm, fmaxf(s0[i], s1[i]));
    tm = sm * c1e + cbe;
    tm = fmaxf(tm, __shfl_xor(tm, 32));
    const float mn = fmaxf(st.m, tm);
    const float mu = (mn == NEG) ? 0.f : mn;
    alpha = __builtin_amdgcn_exp2f(st.m - mu);
    const float off = cbe - mu;
    float psum = 0.f;
#pragma unroll
    for (int i = 0; i < 16; ++i) { t0[i] = __builtin_amdgcn_exp2f(s0[i] * c1e + off); t1[i] = __builtin_amdgcn_exp2f(s1[i] * c1e + off); psum += t0[i] + t1[i]; }
    st.l = st.l * alpha + psum; st.m = mn;
  } else {
    tm = NEG;
#pragma unroll
    for (int i = 0; i < 16; ++i) {
      const int rel0 = qpos - (kpos0 + crow(i, h5)), rel1 = rel0 - 32;
      const float b0 = lut[min(max(rel0, 0), 127)];
      const float b1 = lut[min(max(rel1, 0), 127)];
      float v0 = s0[i] * c1 + b0, v1 = s1[i] * c1 + b1;
      if (MODE == 2) { if (rel0 < 0) v0 = NEG; if (rel1 < 0) v1 = NEG; }
      if (MODE == 1 && !sel) { v0 = NEG; v1 = NEG; }
      t0[i] = v0; t1[i] = v1; tm = fmaxf(tm, fmaxf(v0, v1));
    }
    tm = fmaxf(tm, __shfl_xor(tm, 32));
    const float mn = fmaxf(st.m, tm);
    const float mu = (mn == NEG) ? 0.f : mn;
    alpha = __builtin_amdgcn_exp2f(st.m - mu);
    float psum = 0.f;
#pragma unroll
    for (int i = 0; i < 16; ++i) { t0[i] = __builtin_amdgcn_exp2f(t0[i] - mu); t1[i] = __builtin_amdgcn_exp2f(t1[i] - mu); psum += t0[i] + t1[i]; }
    st.l = st.l * alpha + psum; st.m = mn;
  }
  if (__any(alpha != 1.f)) {
#pragma unroll
    for (int i = 0; i < 16; ++i) { st.o0[i] *= alpha; st.o1[i] *= alpha; }
  }
  const bf16x8 p00 = __builtin_bit_cast(bf16x8, pack8(t0[0], t0[1], t0[2], t0[3], t0[4], t0[5], t0[6], t0[7]));
  const bf16x8 p01 = __builtin_bit_cast(bf16x8, pack8(t0[8], t0[9], t0[10], t0[11], t0[12], t0[13], t0[14], t0[15]));
  const bf16x8 p10 = __builtin_bit_cast(bf16x8, pack8(t1[0], t1[1], t1[2], t1[3], t1[4], t1[5], t1[6], t1[7]));
  const bf16x8 p11 = __builtin_bit_cast(bf16x8, pack8(t1[8], t1[9], t1[10], t1[11], t1[12], t1[13], t1[14], t1[15]));
#pragma unroll
  for (int s2 = 0; s2 < 2; ++s2) {
#pragma unroll
    for (int dt = 0; dt < 2; ++dt) {
      u32x4 va = {f0.vlo[s2 * 2 + dt][0], f0.vlo[s2 * 2 + dt][1], f0.vhi[s2 * 2 + dt][0], f0.vhi[s2 * 2 + dt][1]};
      u32x4 vb = {f1.vlo[s2 * 2 + dt][0], f1.vlo[s2 * 2 + dt][1], f1.vhi[s2 * 2 + dt][0], f1.vhi[s2 * 2 + dt][1]};
      if (dt == 0) { st.o0 = MFMA32(__builtin_bit_cast(bf16x8, va), s2 ? p01 : p00, st.o0); st.o0 = MFMA32(__builtin_bit_cast(bf16x8, vb), s2 ? p11 : p10, st.o0); }
      else         { st.o1 = MFMA32(__builtin_bit_cast(bf16x8, va), s2 ? p01 : p00, st.o1); st.o1 = MFMA32(__builtin_bit_cast(bf16x8, vb), s2 ? p11 : p10, st.o1); }
    }
  }
}

DI void phase_moba(const Params& p, char* smem, int task_lo, int task_hi) {
  const int tid = opaque_tid(), lane = tid & 63, w = tid >> 6, r = lane & 31, h5 = lane >> 5;
  float* lut = (float*)(smem + 65536);
  unsigned* um = (unsigned*)(smem + 65536 + 512);
  const float NEG = -__builtin_inff();
  const u16* mq = (const u16*)(p.ws + OFF_MQ);
  const u16* mk = (const u16*)(p.ws + OFF_MK);
  const u16* vT = (const u16*)(p.ws + OFF_VT);
  const float* kmean = (const float*)(p.ws + OFF_KMEAN);
  u16* mix = (u16*)(p.ws + OFF_MIX);
  for (int task = task_lo + blockIdx.x; task < task_hi; task += gridDim.x) {
    const int blk = (task < 256) ? 15 - (task >> 5) : ((task - 256) >> 5);
    const int bh = task & 31, hd = bh & 7, b = bh >> 3;
    __syncthreads();
    if (tid < 128) lut[tid] = p.rel_bias[t5_bucket(tid) * 8 + hd] * LOG2E;
    __syncthreads();
    const float cb31 = p.rel_bias[31 * 8 + hd] * LOG2E;
    const int qpos = blk * 256 + w * 32 + r;
    const u16* qptr = mq + ((size_t)bh * S + qpos) * 64 + h5 * 8;
    bf16x8 qf[4];
#pragma unroll
    for (int ks = 0; ks < 4; ++ks) qf[ks] = *(const bf16x8*)(qptr + ks * 16);
    unsigned selmask = 0;
    if (blk > 0) {
      f32x16 g;
#pragma unroll
      for (int i = 0; i < 16; ++i) g[i] = 0.f;
      const int n = r < 15 ? r : 15;
      const float* kmp = kmean + ((size_t)bh * 16 + n) * 64 + h5 * 8;
#pragma unroll
      for (int ks = 0; ks < 4; ++ks) {
        const f32x4 v0 = *(const f32x4*)(kmp + ks * 16), v1 = *(const f32x4*)(kmp + ks * 16 + 4);
        const u32x4 hi = pack8(v0[0], v0[1], v0[2], v0[3], v1[0], v1[1], v1[2], v1[3]);
        const u32x4 lo = pack8(v0[0] - bflo(hi[0]), v0[1] - bfhi(hi[0]), v0[2] - bflo(hi[1]), v0[3] - bfhi(hi[1]),
                               v1[0] - bflo(hi[2]), v1[1] - bfhi(hi[2]), v1[2] - bflo(hi[3]), v1[3] - bfhi(hi[3]));
        g = MFMA32(__builtin_bit_cast(bf16x8, hi), qf[ks], g);
        g = MFMA32(__builtin_bit_cast(bf16x8, lo), qf[ks], g);
      }
      float gt[16];
#pragma unroll
      for (int nn = 0; nn < 16; ++nn) {
        const int x = (nn >> 2) & 1, rr = (nn & 3) + 4 * (nn >> 3);
        const float own = g[rr];
        const float par = __shfl_xor(own, 32);
        gt[nn] = (h5 == x) ? own : par;
      }
#pragma unroll
      for (int it = 0; it < 3; ++it) {
        float best = NEG; int bi = -1;
#pragma unroll
        for (int nn = 0; nn < 16; ++nn) {
          const bool ok = (nn < blk) && !((selmask >> nn) & 1u);
          if (ok && gt[nn] > best) { best = gt[nn]; bi = nn; }
        }
        if (bi >= 0) selmask |= 1u << bi;
      }
    }
    unsigned wmask = 0;
    for (int nn = 0; nn < blk; ++nn) if (__any((int)((selmask >> nn) & 1u))) wmask |= 1u << nn;
    if (lane == 0) um[w] = wmask;
    __syncthreads();
    unsigned bmask = 1u << blk;
#pragma unroll
    for (int q = 0; q < 8; ++q) bmask |= um[q];
    MobaState st;
#pragma unroll
    for (int i = 0; i < 16; ++i) { st.o0[i] = 0.f; st.o1[i] = 0.f; }
    st.m = NEG; st.l = 0.f;
    const u16* kbase = mk + (size_t)bh * S * 64;
    const u16* vbase = vT + (size_t)bh * 64 * S;
    const int ntile = __builtin_popcount(bmask) * 4;
    LoadBf16<2> ld;
    int pn = __builtin_ctz(bmask), pj = 0, pit = 0;
    auto issue_next = [&]() {
      if (pit < ntile) {
        ld.rp[0] = kbase + (size_t)(pn * 256 + pj * 64 + (tid >> 3)) * 64 + src_chunk(tid);
        ld.rp[1] = vbase + (size_t)(tid >> 3) * S + pn * 256 + pj * 64 + src_chunk(tid);
        ld.issue(0, smem + (pit & 3) * 16384, tid);
        ++pit;
        if (++pj == 4) { pj = 0; if (pn != blk) pn = __builtin_ctz(bmask & ~((2u << pn) - 1u)); }
      }
    };
    issue_next(); issue_next(); issue_next();
    int n = __builtin_ctz(bmask), j = 0;
    for (int it = 0; it < ntile; ++it) {
      const int ahead = pit - it - 1;
      if (ahead >= 2) asm volatile("s_waitcnt vmcnt(4)" ::: "memory");
      else if (ahead == 1) asm volatile("s_waitcnt vmcnt(2)" ::: "memory");
      else asm volatile("s_waitcnt vmcnt(0)" ::: "memory");
      __builtin_amdgcn_s_barrier();
      issue_next();
      const char* sp = smem + (it & 3) * 16384;
      const int kp0 = n * 256 + j * 64;
      if (n == blk) {
        if (2 * j <= w) moba_tile<2>(st, qf, sp, kp0, qpos, true, lut, cb31, r, h5);
      } else if ((wmask >> n) & 1u) {
        const bool sel = (selmask >> n) & 1u;
        if (n == blk - 1) moba_tile<1>(st, qf, sp, kp0, qpos, sel, lut, cb31, r, h5);
        else              moba_tile<0>(st, qf, sp, kp0, qpos, sel, lut, cb31, r, h5);
      }
      if (++j == 4) { j = 0; if (n != blk) n = __builtin_ctz(bmask & ~((2u << n) - 1u)); }
    }
    __syncthreads();
    float l = st.l + __shfl_xor(st.l, 32);
    const float inv = 1.f / l;
    float ssq = 0.f;
#pragma unroll
    for (int i = 0; i < 16; ++i) { st.o0[i] *= inv; st.o1[i] *= inv; ssq += st.o0[i] * st.o0[i] + st.o1[i] * st.o1[i]; }
    ssq += __shfl_xor(ssq, 32);
    const float rs = rsqrtf(ssq * (1.f / 64.f) + EPS);
    u16* op = mix + (size_t)(b * S + qpos) * 1024 + hd * 64;
#pragma unroll
    for (int dt = 0; dt < 2; ++dt)
#pragma unroll
      for (int g4 = 0; g4 < 4; ++g4) {
        const int d0 = dt * 32 + 8 * g4 + 4 * h5;
        const f32x4 mw = *(const f32x4*)(p.moba_out_w + d0);
        float o[4];
#pragma unroll
        for (int q = 0; q < 4; ++q) o[q] = (dt ? st.o1[4 * g4 + q] : st.o0[4 * g4 + q]) * rs * mw[q];
        u32x2 pk = {pack2(o[0], o[1]), pack2(o[2], o[3])};
        *(u32x2*)(op + d0) = pk;
      }
  }
}

DI void phase_gla_a(const Params& p) {
  const int tid = opaque_tid(), lane = tid & 63, w = tid >> 6, r = lane & 31, h5 = lane >> 5;
  const u16* gkT = (const u16*)(p.ws + OFF_GKT);
  const u16* gvT = (const u16*)(p.ws + OFF_GVT);
  const float* bcT = (const float*)(p.ws + OFF_BCT);
  float* UT = (float*)(p.ws + OFF_UT);
  float* dec = (float*)(p.ws + OFF_DEC);
  for (int task = blockIdx.x; task < 512; task += gridDim.x) {
    const int bh = task >> 5, c = (task & 31) * 2 + (w >> 2), vt = w & 3;
    f32x16 acc[2];
#pragma unroll
    for (int i = 0; i < 16; ++i) { acc[0][i] = 0.f; acc[1][i] = 0.f; }
    const u16* vp = gvT + ((size_t)bh * 128 + vt * 32 + r) * S + c * 64 + h5 * 8;
#pragma unroll
    for (int dt = 0; dt < 2; ++dt) {
      const int d = dt * 32 + r;
      const float* bp = bcT + ((size_t)bh * 64 + d) * S + c * 64;
      const u16* kp = gkT + ((size_t)bh * 64 + d) * S + c * 64;
      const float bl = bp[63];
      if (vt == 0 && h5 == 0) dec[((size_t)bh * 64 + c) * 64 + d] = __expf(bl);
#pragma unroll
      for (int ks = 0; ks < 4; ++ks) {
        const u32x4 kk = *(const u32x4*)(kp + ks * 16 + h5 * 8);
        const f32x4 b0 = *(const f32x4*)(bp + ks * 16 + h5 * 8), b1 = *(const f32x4*)(bp + ks * 16 + h5 * 8 + 4);
        const u32x4 kh = pack8(bflo(kk[0]) * __expf(bl - b0[0]), bfhi(kk[0]) * __expf(bl - b0[1]), bflo(kk[1]) * __expf(bl - b0[2]), bfhi(kk[1]) * __expf(bl - b0[3]),
                               bflo(kk[2]) * __expf(bl - b1[0]), bfhi(kk[2]) * __expf(bl - b1[1]), bflo(kk[3]) * __expf(bl - b1[2]), bfhi(kk[3]) * __expf(bl - b1[3]));
        const bf16x8 vf = *(const bf16x8*)(vp + ks * 16);
        acc[dt] = MFMA32(vf, __builtin_bit_cast(bf16x8, kh), acc[dt]);
      }
    }
    float* up = UT + ((size_t)bh * 64 + c) * 128 * 64;
#pragma unroll
    for (int dt = 0; dt < 2; ++dt)
#pragma unroll
      for (int i = 0; i < 16; ++i) up[(size_t)(vt * 32 + crow(i, h5)) * 64 + dt * 32 + r] = acc[dt][i];
  }
}

DI void phase_gla_b(const Params& p) {
  const float* UT = (const float*)(p.ws + OFF_UT);
  const float* dec = (const float*)(p.ws + OFF_DEC);
  u16* ST = (u16*)(p.ws + OFF_ST);
  for (int i = blockIdx.x * NTHR + threadIdx.x; i < 16 * 128 * 16; i += gridDim.x * NTHR) {
    const int d4 = (i & 15) * 4, v = (i >> 4) & 127, bh = i >> 11;
    f32x4 st = {0.f, 0.f, 0.f, 0.f};
#pragma unroll 8
    for (int c = 0; c < 64; ++c) {
      const size_t o = (((size_t)bh * 64 + c) * 128 + v) * 64 + d4;
      const f32x4 u = *(const f32x4*)(UT + o);
      const f32x4 a = *(const f32x4*)(dec + ((size_t)bh * 64 + c) * 64 + d4);
      u32x2 pk = {pack2(st[0], st[1]), pack2(st[2], st[3])};
      *(u32x2*)(ST + o) = pk;
      st[0] = a[0] * st[0] + u[0]; st[1] = a[1] * st[1] + u[1]; st[2] = a[2] * st[2] + u[2]; st[3] = a[3] * st[3] + u[3];
    }
  }
}

DI void phase_gla_c(const Params& p) {
  const int tid = opaque_tid(), lane = tid & 63, w = tid >> 6, r = lane & 31, h5 = lane >> 5;
  const u16* gq = (const u16*)(p.ws + OFF_GQ);
  const u16* gk = (const u16*)(p.ws + OFF_GK);
  const u16* gvT = (const u16*)(p.ws + OFF_GVT);
  const float* bc = (const float*)(p.ws + OFF_BC);
  const u16* ST = (const u16*)(p.ws + OFF_ST);
  const u16* sg = (const u16*)(p.ws + OFF_SG);
  u16* mix = (u16*)(p.ws + OFF_MIX);
  for (int task = blockIdx.x; task < 256; task += gridDim.x) {
    const int bh = task >> 4, c = (task & 15) * 4 + (w >> 1), ih = w & 1, b = bh >> 2, hd = bh & 3;
    const int tpos = c * 64 + ih * 32 + r;
    bf16x8 qt[4];
    {
      const u16* qp = gq + ((size_t)bh * S + tpos) * 64 + h5 * 8;
      const float* bp = bc + ((size_t)bh * S + tpos) * 64 + h5 * 8;
#pragma unroll
      for (int ks = 0; ks < 4; ++ks) {
        const u32x4 qq = *(const u32x4*)(qp + ks * 16);
        const f32x4 b0 = *(const f32x4*)(bp + ks * 16), b1 = *(const f32x4*)(bp + ks * 16 + 4);
        qt[ks] = __builtin_bit_cast(bf16x8, pack8(bflo(qq[0]) * __expf(b0[0]), bfhi(qq[0]) * __expf(b0[1]), bflo(qq[1]) * __expf(b0[2]), bfhi(qq[1]) * __expf(b0[3]),
                                                 bflo(qq[2]) * __expf(b1[0]), bfhi(qq[2]) * __expf(b1[1]), bflo(qq[3]) * __expf(b1[2]), bfhi(qq[3]) * __expf(b1[3])));
      }
    }
    f32x16 oacc[4];
#pragma unroll
    for (int vt = 0; vt < 4; ++vt)
#pragma unroll
      for (int i = 0; i < 16; ++i) oacc[vt][i] = 0.f;
#pragma unroll
    for (int jt = 0; jt < 2; ++jt) {
      if (jt <= ih) {
        f32x16 X;
#pragma unroll
        for (int i = 0; i < 16; ++i) X[i] = 0.f;
        const int jpos = c * 64 + jt * 32 + r;
        const u16* kp = gk + ((size_t)bh * S + jpos) * 64 + h5 * 8;
        const float* bp = bc + ((size_t)bh * S + jpos) * 64 + h5 * 8;
#pragma unroll
        for (int ks = 0; ks < 4; ++ks) {
          const u32x4 kk = *(const u32x4*)(kp + ks * 16);
          const f32x4 b0 = *(const f32x4*)(bp + ks * 16), b1 = *(const f32x4*)(bp + ks * 16 + 4);
          const u32x4 kt = pack8(bflo(kk[0]) * __expf(-b0[0]), bfhi(kk[0]) * __expf(-b0[1]), bflo(kk[1]) * __expf(-b0[2]), bfhi(kk[1]) * __expf(-b0[3]),
                                 bflo(kk[2]) * __expf(-b1[0]), bfhi(kk[2]) * __expf(-b1[1]), bflo(kk[3]) * __expf(-b1[2]), bfhi(kk[3]) * __expf(-b1[3]));
          X = MFMA32(__builtin_bit_cast(bf16x8, kt), qt[ks], X);
        }
        if (jt == ih) {
#pragma unroll
          for (int i = 0; i < 16; ++i) if (crow(i, h5) > r) X[i] = 0.f;
        }
        const bf16x8 pf0 = __builtin_bit_cast(bf16x8, pack8(X[0], X[1], X[2], X[3], X[4], X[5], X[6], X[7]));
        const bf16x8 pf1 = __builtin_bit_cast(bf16x8, pack8(X[8], X[9], X[10], X[11], X[12], X[13], X[14], X[15]));
#pragma unroll
        for (int vt = 0; vt < 4; ++vt) {
#pragma unroll
          for (int s2 = 0; s2 < 2; ++s2) {
            const u16* vp = gvT + ((size_t)bh * 128 + vt * 32 + r) * S + c * 64 + jt * 32 + 16 * s2 + 4 * h5;
            const u32x2 lo = *(const u32x2*)vp, hi = *(const u32x2*)(vp + 8);
            u32x4 vv = {lo[0], lo[1], hi[0], hi[1]};
            oacc[vt] = MFMA32(__builtin_bit_cast(bf16x8, vv), s2 ? pf1 : pf0, oacc[vt]);
          }
        }
      }
    }
    {
      const u16* sp = ST + (((size_t)bh * 64 + c) * 128 + r) * 64 + h5 * 8;
#pragma unroll
      for (int vt = 0; vt < 4; ++vt)
#pragma unroll
        for (int ks = 0; ks < 4; ++ks) oacc[vt] = MFMA32(*(const bf16x8*)(sp + (size_t)vt * 32 * 64 + ks * 16), qt[ks], oacc[vt]);
    }
    float ssq = 0.f;
#pragma unroll
    for (int vt = 0; vt < 4; ++vt)
#pragma unroll
      for (int i = 0; i < 16; ++i) ssq += oacc[vt][i] * oacc[vt][i];
    ssq += __shfl_xor(ssq, 32);
    const float rs = rsqrtf(ssq * (1.f / 128.f) + EPS);
    const size_t t = (size_t)b * S + tpos;
    const u16* sgp = sg + t * 512 + hd * 128;
    u16* op = mix + t * 1024 + 512 + hd * 128;
#pragma unroll
    for (int vt = 0; vt < 4; ++vt)
#pragma unroll
      for (int g4 = 0; g4 < 4; ++g4) {
        const int v0 = vt * 32 + 8 * g4 + 4 * h5;
        const f32x4 gw = *(const f32x4*)(p.gla_out_w + v0);
        const u32x2 sv = *(const u32x2*)(sgp + v0);
        const float o0 = oacc[vt][4 * g4 + 0] * rs * gw[0] * bflo(sv[0]);
        const float o1 = oacc[vt][4 * g4 + 1] * rs * gw[1] * bfhi(sv[0]);
        const float o2 = oacc[vt][4 * g4 + 2] * rs * gw[2] * bflo(sv[1]);
        const float o3 = oacc[vt][4 * g4 + 3] * rs * gw[3] * bfhi(sv[1]);
        u32x2 pk = {pack2(o0, o1), pack2(o2, o3)};
        *(u32x2*)(op + v0) = pk;
      }
  }
}

DI void phase6(const Params& p, char* smem) {
  const int tid = opaque_tid();
  const u16* mix = (const u16*)(p.ws + OFF_MIX);
  const u16* woutT = (const u16*)(p.ws + OFF_WOUTT);
  const float* mod = (const float*)(p.ws + OFF_MOD);
  u16* d1 = (u16*)(p.ws + OFF_D1);
  float* cs = (float*)smem;
  const int xg = blockIdx.x & 7, xj = blockIdx.x >> 3, xn = gridDim.x >> 3;
  for (int l = xj; l < 32; l += xn) {
    const int mtile = xg * 8 + (l & 7), ntile = l >> 3, row0 = mtile * 256, b = row0 >> 12;
    LoadBf16<4> al; LoadBf16<4> bl;
#pragma unroll
    for (int i = 0; i < 4; ++i) {
      al.rp[i] = mix + (size_t)(row0 + (tid >> 3) + 64 * i) * 1024 + src_chunk(tid);
      bl.rp[i] = woutT + (size_t)(ntile * 256 + (tid >> 3) + 64 * i) * 1024 + src_chunk(tid);
    }
    f32x16 acc[4][2];
    gemm_mainloop<4>(al, bl, 16, smem, acc);
    const int c8 = (tid & 31) * 8, col = ntile * 256 + c8;
    const f32x4 ga = *(const f32x4*)(mod + b * 6144 + 2048 + col), gb = *(const f32x4*)(mod + b * 6144 + 2048 + col + 4);
#pragma unroll 1
    for (int half = 0; half < 2; ++half) {
      __syncthreads();
      stage_nat<4>(cs, acc, half);
      __syncthreads();
#pragma unroll 2
      for (int it = 0; it < 8; ++it) {
        const int i = it * NTHR + tid, row = i >> 5;
        const f32x4 va = *(const f32x4*)(cs + row * 260 + c8), vb = *(const f32x4*)(cs + row * 260 + c8 + 4);
        *(u32x4*)(d1 + (size_t)(row0 + half * 128 + row) * 1024 + col) =
            pack8(va[0] * ga[0], va[1] * ga[1], va[2] * ga[2], va[3] * ga[3], vb[0] * gb[0], vb[1] * gb[1], vb[2] * gb[2], vb[3] * gb[3]);
      }
    }
  }
}

DI void phase7_rows(const Params& p) {
  const int tid = opaque_tid(), lane = tid & 63, w = tid >> 6;
  const u16* d1 = (const u16*)(p.ws + OFF_D1);
  const float* mod = (const float*)(p.ws + OFF_MOD);
  u16* h2b = (u16*)(p.ws + OFF_H2B);
  for (int task = blockIdx.x; task < 256; task += gridDim.x) {
    const int row0 = task * 64, b = row0 >> 12;
    {
#pragma unroll 1
      for (int rr0 = 0; rr0 < 8; rr0 += 4) {
        f32x4 xv[4][4]; float ssq[4];
#pragma unroll
        for (int q = 0; q < 4; ++q) {
          const size_t t = row0 + w * 8 + rr0 + q;
#pragma unroll
          for (int i = 0; i < 4; ++i) {
            const f32x4 xx = *(const f32x4*)(p.x + t * 1024 + i * 256 + lane * 4);
            const u32x2 dd = *(const u32x2*)(d1 + t * 1024 + i * 256 + lane * 4);
            xv[q][i][0] = xx[0] + bflo(dd[0]); xv[q][i][1] = xx[1] + bfhi(dd[0]); xv[q][i][2] = xx[2] + bflo(dd[1]); xv[q][i][3] = xx[3] + bfhi(dd[1]);
          }
        }
#pragma unroll
        for (int q = 0; q < 4; ++q) {
          float a = 0.f;
#pragma unroll
          for (int i = 0; i < 4; ++i) a += xv[q][i][0] * xv[q][i][0] + xv[q][i][1] * xv[q][i][1] + xv[q][i][2] * xv[q][i][2] + xv[q][i][3] * xv[q][i][3];
          ssq[q] = wave_sum(a);
        }
#pragma unroll
        for (int i = 0; i < 4; ++i) {
          const int k = i * 256 + lane * 4;
          const f32x4 nw = *(const f32x4*)(p.norm2_w + k);
          const f32x4 sc = *(const f32x4*)(mod + b * 6144 + 4096 + k);
          const f32x4 sh = *(const f32x4*)(mod + b * 6144 + 3072 + k);
#pragma unroll
          for (int q = 0; q < 4; ++q) {
            const size_t t = row0 + w * 8 + rr0 + q;
            const float rn = rsqrtf(ssq[q] * (1.f / 1024.f) + EPS);
            float o[4];
#pragma unroll
            for (int j = 0; j < 4; ++j) o[j] = xv[q][i][j] * rn * (nw[j] * (1.f + sc[j])) + sh[j];
            u32x2 pk = {pack2(o[0], o[1]), pack2(o[2], o[3])};
            *(u32x2*)(h2b + t * 1024 + k) = pk;
          }
        }
      }
    }
  }
}

DI void phase7(const Params& p, char* smem) {
  const int tid = opaque_tid(), lane = tid & 63, w = tid >> 6, wm = w >> 2, wn = w & 3, r = lane & 31, h5 = lane >> 5;
  const float NEG = -__builtin_inff();
  const u16* d1 = (const u16*)(p.ws + OFF_D1);
  const float* mod = (const float*)(p.ws + OFF_MOD);
  u16* h2b = (u16*)(p.ws + OFF_H2B);
  const u16* wrT = (const u16*)(p.ws + OFF_WRT);
  int* cnt = (int*)(p.ws + OFF_CNT);
  int* list = (int*)(p.ws + OFF_LIST);
  float* topw = (float*)(p.ws + OFF_TOPW);
  float* lg = (float*)smem;
  for (int task = blockIdx.x; task < 256; task += gridDim.x) {
    const int row0 = task * 64, b = row0 >> 12;
    asm volatile("s_waitcnt vmcnt(0)" ::: "memory");
    __syncthreads();
    LoadBf16<1> al; LoadBf16<4> bl;
    al.rp[0] = h2b + (size_t)(row0 + (tid >> 3)) * 1024 + src_chunk(tid);
#pragma unroll
    for (int i = 0; i < 4; ++i) bl.rp[i] = wrT + (size_t)((tid >> 3) + 64 * i) * 1024 + src_chunk(tid);
    f32x16 acc[1][2];
    gemm_mainloop<1>(al, bl, 16, smem, acc);
#pragma unroll
    for (int nt = 0; nt < 2; ++nt)
#pragma unroll
      for (int i = 0; i < 16; ++i) lg[(wm * 32 + crow(i, h5)) * 256 + wn * 64 + nt * 32 + r] = acc[0][nt][i];
    __syncthreads();
    const f32x4 eb = *(const f32x4*)(p.e_bias + lane * 4);
    const int mygrp = lane >> 3;
#pragma unroll 1
    for (int rr0 = 0; rr0 < 8; rr0 += 2) {
      float sc[2][4], cand[2][4];
#pragma unroll
      for (int u = 0; u < 2; ++u) {
        const int row = w * 8 + rr0 + u;
        const f32x4 lv = *(const f32x4*)(lg + row * 256 + lane * 4);
        float ch[4];
#pragma unroll
        for (int q = 0; q < 4; ++q) { sc[u][q] = 1.f / (1.f + __expf(-lv[q])); ch[q] = sc[u][q] + eb[q]; }
        float m1 = fmaxf(ch[0], ch[1]), m2 = fminf(ch[0], ch[1]);
#pragma unroll
        for (int q = 2; q < 4; ++q) { const float v = ch[q]; m2 = fmaxf(m2, fminf(m1, v)); m1 = fmaxf(m1, v); }
#pragma unroll
        for (int sft = 1; sft < 8; sft <<= 1) {
          const float o1 = __shfl_xor(m1, sft), o2 = __shfl_xor(m2, sft);
          const float n1 = fmaxf(m1, o1); const float n2 = fmaxf(fminf(m1, o1), fmaxf(m2, o2));
          m1 = n1; m2 = n2;
        }
        const float gs = m1 + m2;
        int rank = 0;
#pragma unroll
        for (int q = 0; q < 8; ++q) { const float og = __shfl(gs, q * 8); rank += (og > gs || (og == gs && q < mygrp)) ? 1 : 0; }
        const bool allowed = rank < 4;
#pragma unroll
        for (int q = 0; q < 4; ++q) cand[u][q] = allowed ? ch[q] : NEG;
      }
      float wsel[2], wsum[2]; int esel[2];
#pragma unroll
      for (int u = 0; u < 2; ++u) { wsel[u] = 0.f; wsum[u] = 0.f; esel[u] = 0; }
#pragma unroll 1
      for (int k = 0; k < 8; ++k) {
#pragma unroll
        for (int u = 0; u < 2; ++u) {
          float bv = cand[u][0]; int bi = lane * 4;
#pragma unroll
          for (int q = 1; q < 4; ++q) if (cand[u][q] > bv) { bv = cand[u][q]; bi = lane * 4 + q; }
#pragma unroll
          for (int sft = 32; sft >= 1; sft >>= 1) {
            const float ov = __shfl_xor(bv, sft); const int oi = __shfl_xor(bi, sft);
            if (ov > bv || (ov == bv && oi < bi)) { bv = ov; bi = oi; }
          }
          float sv = 0.f;
          if ((bi >> 2) == lane) {
#pragma unroll
            for (int q = 0; q < 4; ++q) if ((bi & 3) == q) { sv = sc[u][q]; cand[u][q] = NEG; }
          }
          sv = __shfl(sv, bi >> 2);
          wsum[u] += sv;
          if (lane == k) { wsel[u] = sv; esel[u] = bi; }
        }
      }
      if (lane < 8) {
#pragma unroll
        for (int u = 0; u < 2; ++u) {
          const int t = row0 + w * 8 + rr0 + u;
          const float wgt = wsel[u] / wsum[u] * 2.5f;
          const int pos = atomicAdd(&cnt[esel[u] * CNT_STRIDE], 1);
          list[(size_t)esel[u] * LISTCAP + pos] = t * 8 + lane;
          topw[t * 8 + lane] = wgt;
        }
      }
    }
  }
}

DI int perm_e(int o) { return (o & 31) * 8 + (o >> 5); }
DI void build_tables(const Params& p, int* tbl) {
  const int tid = opaque_tid();
  const int* cnt = (const int*)(p.ws + OFF_CNT);
  __syncthreads();
  if (tid < 256) tbl[520 + tid] = cnt[perm_e(tid) * CNT_STRIDE];
  __syncthreads();
  if (tid < 256) {
    int tp = 0, rp = 0;
    for (int o = 0; o < tid; ++o) { const int cc = tbl[520 + o]; tp += (cc + 255) >> 8; rp += cc; }
    tbl[tid] = tp; tbl[260 + tid] = rp;
    if (tid == 255) { const int cc = tbl[520 + 255]; tbl[256] = tp + ((cc + 255) >> 8); tbl[260 + 256] = rp + cc; }
  }
  __syncthreads();
}
DI int find_o(const int* tb, int g, int item) {
  int lo = 32 * g, hi = 32 * g + 31;
  while (lo < hi) { const int mid = (lo + hi + 1) >> 1; if (tb[mid] <= item) lo = mid; else hi = mid - 1; }
  return lo;
}
DI int queue_first(int* qc, volatile int* slot) {
  if (opaque_tid() == 0) *slot = atomicAdd(qc, 1);
  __syncthreads();
  const int v = *slot;
  __syncthreads();
  return v;
}

template <int MT>
DI void p8_tile(const Params& p, char* smem, int e, int rbeg, int cnt_e, int rowbase, int nchunk) {
  const int tid = opaque_tid(), lane = tid & 63, w = tid >> 6, wm = w >> 2, wn = w & 3, r = lane & 31, h5 = lane >> 5;
  const u16* h2b = (const u16*)(p.ws + OFF_H2B);
  const int* list = (const int*)(p.ws + OFF_LIST);
  LoadBf16<MT> al;
#pragma unroll
  for (int i = 0; i < MT; ++i) {
    const int rr = rbeg + (tid >> 3) + 64 * i;
    int tok = 0;
    if (rr < cnt_e) tok = (e < 256) ? (list[(size_t)e * LISTCAP + rr] >> 3) : rr;
    al.rp[i] = h2b + (size_t)tok * 1024 + src_chunk(tid);
  }
  f32x16 acc[MT][2];
  if (e < 256) {
    BLoadF32 bl;
    const int n4 = (tid & 63) * 4, kg = tid >> 6;
    const int twn = n4 >> 6, tnt = (n4 >> 5) & 1, jj = n4 & 31;
    const int col = nchunk * 128 + twn * 32 + jj;
    bl.ldb = 256; bl.p = (tnt ? p.w3 : p.w1) + (size_t)e * 1024 * 256 + (size_t)(kg * 8) * 256 + col;
    gemm_mainloop<MT>(al, bl, 16, smem, acc);
  } else {
    LoadBf16<4> bl;
    const u16* ws13T = (const u16*)(p.ws + OFF_WS13T);
#pragma unroll
    for (int i = 0; i < 4; ++i) bl.rp[i] = ws13T + (size_t)(nchunk * 256 + (tid >> 3) + 64 * i) * 1024 + src_chunk(tid);
    gemm_mainloop<MT>(al, bl, 16, smem, acc);
  }
  u16* actp = (e < 256) ? ((u16*)(p.ws + OFF_ACT) + (size_t)rowbase * 256) : (u16*)(p.ws + OFF_ACTS);
  float* cs = (float*)smem;
#pragma unroll 1
  for (int half = 0; half < (MT == 4 ? 2 : 1); ++half) {
    __syncthreads();
    if (MT == 2 || wm == half) {
      const int rb = (MT == 4) ? 0 : wm * 64;
#pragma unroll
      for (int mt = 0; mt < MT; ++mt)
#pragma unroll
        for (int i = 0; i < 16; ++i) cs[(rb + mt * 32 + crow(i, h5)) * 132 + wn * 32 + r] = siluf(acc[mt][0][i]) * acc[mt][1][i];
    }
    __syncthreads();
#pragma unroll 1
    for (int it = 0; it < 4; ++it) {
      const int i = it * NTHR + tid, row = i >> 4, c8 = (i & 15) * 8;
      const int rr = rbeg + half * 128 + row;
      if (rr < cnt_e) {
        const f32x4 va = *(const f32x4*)(cs + row * 132 + c8), vb = *(const f32x4*)(cs + row * 132 + c8 + 4);
        *(u32x4*)(actp + (size_t)rr * 256 + nchunk * 128 + c8) = pack8(va[0], va[1], va[2], va[3], vb[0], vb[1], vb[2], vb[3]);
      }
    }
  }
}

DI void phase8(const Params& p, char* smem) {
  const int g = blockIdx.x & 7;
  int* tbl = (int*)(smem + LDS_TBL);
  volatile int* slot = (volatile int*)(smem + LDS_TBL + 8160);
  int* qc = (int*)(p.ws + OFF_QC) + g * 32;
  build_tables(p, tbl);
  const int t0 = tbl[32 * g], ntl = tbl[32 * g + 32] - t0;
  const int ntask = ntl * 2 + 16;
  int id = queue_first(qc, slot);
  while (id < ntask) {
    int nxt = 0;
    if (opaque_tid() == 0) nxt = atomicAdd(qc, 1);
    if (id < ntl * 2) {
      const int item = t0 + (id >> 1), nchunk = id & 1;
      const int o = find_o(tbl, g, item);
      const int e = perm_e(o), rbeg = (item - tbl[o]) * 256, cnt_e = tbl[520 + o], rowbase = tbl[260 + o];
      if (cnt_e - rbeg > 128) p8_tile<4>(p, smem, e, rbeg, cnt_e, rowbase, nchunk);
      else                    p8_tile<2>(p, smem, e, rbeg, cnt_e, rowbase, nchunk);
    } else {
      const int sid = id - ntl * 2;
      p8_tile<4>(p, smem, 256, (8 * g + (sid >> 1)) * 256, T, 0, sid & 1);
    }
    __syncthreads();
    if (opaque_tid() == 0) *slot = nxt;
    __syncthreads();
    id = *slot;
    __syncthreads();
  }
}

template <int MT>
DI void p9_tile(const Params& p, char* smem, int e, int rbeg, int cnt_e, int rowbase, int ntile) {
  const int tid = opaque_tid(), lane = tid & 63, w = tid >> 6, wm = w >> 2, wn = w & 3, r = lane & 31, h5 = lane >> 5;
  const int* list = (const int*)(p.ws + OFF_LIST);
  const float* topw = (const float*)(p.ws + OFF_TOPW);
  u16* y = (u16*)(p.ws + OFF_Y);
  const u16* actp = (const u16*)(p.ws + OFF_ACT) + (size_t)rowbase * 256;
  LoadBf16<MT> al; BLoadF32 bl;
#pragma unroll
  for (int i = 0; i < MT; ++i) {
    int rr = rbeg + (tid >> 3) + 64 * i;
    if (rr >= cnt_e) rr = 0;
    al.rp[i] = actp + (size_t)rr * 256 + src_chunk(tid);
  }
  bl.ldb = 1024;
  bl.p = p.w2 + (size_t)e * 256 * 1024 + (size_t)((tid >> 6) * 8) * 1024 + ntile * 256 + (tid & 63) * 4;
  int* rasg = (int*)(smem + LDS_TBL + 4096);
  float* rwg = (float*)(rasg + 256);
  __syncthreads();
  if (tid < MT * 64) {
    const int rr = rbeg + tid;
    int asg = -1; float wg = 0.f;
    if (rr < cnt_e) { asg = list[(size_t)e * LISTCAP + rr]; wg = topw[asg]; }
    rasg[tid] = asg; rwg[tid] = wg;
  }
  f32x16 acc[MT][2];
  gemm_mainloop<MT>(al, bl, 4, smem, acc);
  float* cs = (float*)smem;
#pragma unroll 1
  for (int half = 0; half < (MT == 4 ? 2 : 1); ++half) {
    __syncthreads();
    stage_nat<MT>(cs, acc, half);
    __syncthreads();
#pragma unroll 1
    for (int it = 0; it < 8; ++it) {
      const int i = it * NTHR + tid, row = i >> 5, c8 = (i & 31) * 8;
      const int asg = rasg[half * 128 + row];
      if (asg >= 0) {
        const float wg = rwg[half * 128 + row];
        const f32x4 va = *(const f32x4*)(cs + row * 260 + c8), vb = *(const f32x4*)(cs + row * 260 + c8 + 4);
        *(u32x4*)(y + (size_t)asg * 1024 + ntile * 256 + c8) = pack8(va[0] * wg, va[1] * wg, va[2] * wg, va[3] * wg, vb[0] * wg, vb[1] * wg, vb[2] * wg, vb[3] * wg);
      }
    }
  }
}

DI void phase9(const Params& p, char* smem) {
  const int g = blockIdx.x & 7;
  int* tbl = (int*)(smem + LDS_TBL);
  volatile int* slot = (volatile int*)(smem + LDS_TBL + 8160);
  int* qc = (int*)(p.ws + OFF_QC) + (8 + g) * 32;
  build_tables(p, tbl);
  const int t0 = tbl[32 * g], ntl = tbl[32 * g + 32] - t0;
  const int ntask = ntl * 4;
  int id = queue_first(qc, slot);
  while (id < ntask) {
    int nxt = 0;
    if (opaque_tid() == 0) nxt = atomicAdd(qc, 1);
    const int item = t0 + (id >> 2), ntile = id & 3;
    const int o = find_o(tbl, g, item);
    const int e = perm_e(o), rbeg = (item - tbl[o]) * 256, cnt_e = tbl[520 + o], rowbase = tbl[260 + o];
    if (cnt_e - rbeg > 128) p9_tile<4>(p, smem, e, rbeg, cnt_e, rowbase, ntile);
    else                    p9_tile<2>(p, smem, e, rbeg, cnt_e, rowbase, ntile);
    __syncthreads();
    if (opaque_tid() == 0) *slot = nxt;
    __syncthreads();
    id = *slot;
    __syncthreads();
  }
}

DI void phase10(const Params& p, char* smem) {
  const int tid = opaque_tid();
  const u16* acts = (const u16*)(p.ws + OFF_ACTS);
  const u16* ws2T = (const u16*)(p.ws + OFF_WS2T);
  const u16* y = (const u16*)(p.ws + OFF_Y);
  const u16* d1 = (const u16*)(p.ws + OFF_D1);
  const float* mod = (const float*)(p.ws + OFF_MOD);
  float* cs = (float*)smem;
  const int xg = blockIdx.x & 7, xj = blockIdx.x >> 3, xn = gridDim.x >> 3;
  for (int l = xj; l < 32; l += xn) {
    const int mtile = xg * 8 + (l & 7), ntile = l >> 3, row0 = mtile * 256, b = row0 >> 12;
    LoadBf16<4> al; LoadBf16<4> bl;
#pragma unroll
    for (int i = 0; i < 4; ++i) {
      al.rp[i] = acts + (size_t)(row0 + (tid >> 3) + 64 * i) * 256 + src_chunk(tid);
      bl.rp[i] = ws2T + (size_t)(ntile * 256 + (tid >> 3) + 64 * i) * 256 + src_chunk(tid);
    }
    f32x16 acc[4][2];
    gemm_mainloop<4>(al, bl, 4, smem, acc);
#pragma unroll 1
    for (int half = 0; half < 2; ++half) {
      __syncthreads();
      stage_nat<4>(cs, acc, half);
      __syncthreads();
#pragma unroll 1
      for (int it = 0; it < 8; ++it) {
        const int i = it * NTHR + tid, row = i >> 5, c8 = (i & 31) * 8;
        const size_t t = row0 + half * 128 + row; const int col = ntile * 256 + c8;
        float v[8];
        {
          const f32x4 va = *(const f32x4*)(cs + row * 260 + c8), vb = *(const f32x4*)(cs + row * 260 + c8 + 4);
          v[0] = va[0]; v[1] = va[1]; v[2] = va[2]; v[3] = va[3]; v[4] = vb[0]; v[5] = vb[1]; v[6] = vb[2]; v[7] = vb[3];
        }
#pragma unroll
        for (int k = 0; k < 8; ++k) {
          const u32x4 yy = *(const u32x4*)(y + (t * 8 + k) * 1024 + col);
          v[0] += bflo(yy[0]); v[1] += bfhi(yy[0]); v[2] += bflo(yy[1]); v[3] += bfhi(yy[1]);
          v[4] += bflo(yy[2]); v[5] += bfhi(yy[2]); v[6] += bflo(yy[3]); v[7] += bfhi(yy[3]);
        }
        const f32x4 g2a = *(const f32x4*)(mod + b * 6144 + 5120 + col), g2b = *(const f32x4*)(mod + b * 6144 + 5120 + col + 4);
        f32x4 xa = *(const f32x4*)(p.x + t * 1024 + col), xb = *(const f32x4*)(p.x + t * 1024 + col + 4);
        {
          const u32x4 dd = *(const u32x4*)(d1 + t * 1024 + col);
          xa[0] += bflo(dd[0]); xa[1] += bfhi(dd[0]); xa[2] += bflo(dd[1]); xa[3] += bfhi(dd[1]);
          xb[0] += bflo(dd[2]); xb[1] += bfhi(dd[2]); xb[2] += bflo(dd[3]); xb[3] += bfhi(dd[3]);
        }
        f32x4 oa = {xa[0] + g2a[0] * v[0], xa[1] + g2a[1] * v[1], xa[2] + g2a[2] * v[2], xa[3] + g2a[3] * v[3]};
        f32x4 ob = {xb[0] + g2b[0] * v[4], xb[1] + g2b[1] * v[5], xb[2] + g2b[2] * v[6], xb[3] + g2b[3] * v[7]};
        *(f32x4*)(p.out + t * 1024 + col) = oa;
        *(f32x4*)(p.out + t * 1024 + col + 4) = ob;
      }
    }
  }
}

#define XB_TMO      128
#define XB_XCNT(j)  (256  + 64 * (j))
#define XB_XSUB(j)  (1280 + 64 * (j))
#define XB_XGEN(j)  (2304 + 64 * (j))
#define XB_TOP      3328
#define XB_TOPGEN   3392
#define XCD_BAR_WORDS 3456
#define XB_SPIN_CAP (1u << 22)
#define LAS __attribute__((address_space(3)))
DI unsigned xb_ld(unsigned* p)              { return __hip_atomic_load(p, __ATOMIC_RELAXED, __HIP_MEMORY_SCOPE_AGENT); }
DI unsigned xb_add(unsigned* p, unsigned v) { return __hip_atomic_fetch_add(p, v, __ATOMIC_RELAXED, __HIP_MEMORY_SCOPE_AGENT); }
DI unsigned xb_xcc_id() { return (unsigned)__builtin_amdgcn_s_getreg((3 << 11) | 20) & 0xFu; }
#define XB_SPIN(cond, bar) do { unsigned _sp = 0; while (cond) { __builtin_amdgcn_s_sleep(1); \
    if ((++_sp & 255u) == 0u) { if (xb_ld(&(bar)[XB_TMO])) break; if (_sp > XB_SPIN_CAP) { atomicAdd(&(bar)[XB_TMO], 1u); break; } } } } while (0)
struct XcdBarrier { unsigned* bar; unsigned x; volatile LAS unsigned* st; };
DI XcdBarrier xcd_barrier_post(unsigned* bar, volatile LAS unsigned* st) {
  XcdBarrier b; b.bar = bar; b.x = xb_xcc_id(); b.st = st;
  if (threadIdx.x == 0) (void)xb_add(&bar[XB_XCNT(b.x)], 1u);
  return b;
}
DI void xcd_barrier_complete(unsigned* bar, unsigned x, unsigned& nloc, unsigned& nx) {
  const unsigned G = gridDim.x * gridDim.y * gridDim.z;
  unsigned sum, cnt, mine, sp = 0u;
  for (;;) {
    sum = 0u; cnt = 0u; mine = 0u;
#pragma unroll
    for (unsigned j = 0; j < 16; ++j) { const unsigned c = xb_ld(&bar[XB_XCNT(j)]); sum += c; cnt += (c > 0u) ? 1u : 0u; mine = (j == x) ? c : mine; }
    if (sum == G) break;
    __builtin_amdgcn_s_sleep(1);
    if ((++sp & 255u) == 0u) { if (xb_ld(&bar[XB_TMO])) break; if (sp > XB_SPIN_CAP) { atomicAdd(&bar[XB_TMO], 1u); break; } }
  }
  nloc = mine > 0u ? mine : 1u; nx = cnt > 0u ? cnt : 1u;
}
DI void xcd_barrier(const XcdBarrier& b) {
  asm volatile("s_waitcnt vmcnt(0)" ::: "memory");
  __syncthreads();
  if (threadIdx.x == 0) {
    unsigned* bar = b.bar;
    __builtin_amdgcn_s_waitcnt(0);
    unsigned nloc = b.st[0], nx = b.st[1];
    if (nloc == 0u) { xcd_barrier_complete(bar, b.x, nloc, nx); b.st[0] = nloc; b.st[1] = nx; }
    const unsigned old = xb_add(&bar[XB_XSUB(b.x)], 1u);
    const unsigned gen = old / nloc;
    if (old + 1u == (gen + 1u) * nloc) {
      __builtin_amdgcn_fence(__ATOMIC_RELEASE, "agent");
      asm volatile("s_waitcnt vmcnt(0)" ::: "memory");
      const unsigned og = xb_add(&bar[XB_TOP], 1u);
      const unsigned tg = og / nx;
      if (og + 1u == (tg + 1u) * nx) xb_add(&bar[XB_TOPGEN], 1u);
      else XB_SPIN(xb_ld(&bar[XB_TOPGEN]) == tg, bar);
      __builtin_amdgcn_fence(__ATOMIC_ACQUIRE, "agent");
      xb_add(&bar[XB_XGEN(b.x)], 1u);
      asm volatile("s_waitcnt vmcnt(0)" ::: "memory");
    } else {
      XB_SPIN(xb_ld(&bar[XB_XGEN(b.x)]) == gen, bar);
      __builtin_amdgcn_fence(__ATOMIC_ACQUIRE, "agent");
      asm volatile("s_waitcnt vmcnt(0)" ::: "memory");
    }
  }
  __syncthreads();
}


#if !FUSED
#define PHASE_KERNEL(name, body)                                                 \
  __global__ void __launch_bounds__(NTHR, 2) name(Params p) {                    \
    __shared__ __attribute__((aligned(16))) char smem[LDS_BYTES];                \
    body;                                                                        \
  }
PHASE_KERNEL(k_p0, phase0(p, smem))
PHASE_KERNEL(k_p1, phase1(p); (void)smem)
PHASE_KERNEL(k_p2, phase2(p, smem); phase2_ga(p, smem))
PHASE_KERNEL(k_p3, phase_moba(p, smem, 0, 512); phase_gla_a(p))
PHASE_KERNEL(k_p4, phase_gla_b(p); (void)smem)
PHASE_KERNEL(k_p5, phase_gla_c(p); (void)smem)
PHASE_KERNEL(k_p6, phase6(p, smem))
PHASE_KERNEL(k_p7, phase7_rows(p); phase7(p, smem))
PHASE_KERNEL(k_p8, phase8(p, smem))
PHASE_KERNEL(k_p9, phase9(p, smem))
PHASE_KERNEL(k_p10, phase10(p, smem))
#else
__global__ void __launch_bounds__(NTHR, 2) k_fused(Params p) {
  __shared__ __attribute__((aligned(16))) char smem[LDS_BYTES];
  volatile LAS unsigned* st = (volatile LAS unsigned*)(smem + LDS_BYTES - 16);
  if (threadIdx.x == 0) { st[0] = 0u; st[1] = 0u; st[2] = 0u; st[3] = 0u; }
  __syncthreads();
  (void)xcd_barrier_post((unsigned*)(p.ws + OFF_BAR), st);
#define GRID_BARRIER() do { XcdBarrier xb_; xb_.bar = (unsigned*)(p.ws + OFF_BAR); xb_.x = xb_xcc_id(); xb_.st = (volatile LAS unsigned*)(smem + LDS_BYTES - 16); xcd_barrier(xb_); } while (0)
#if TPROBE
  unsigned long long tp_prev = __builtin_amdgcn_s_memrealtime(), tp_extra = 0;
#define PHASE_END(bit) do { GRID_BARRIER(); const unsigned long long tn_ = __builtin_amdgcn_s_memrealtime(); if ((TPROBE >> (bit)) & 1) tp_extra += tn_ - tp_prev; tp_prev = tn_; } while (0)
#else
#define PHASE_END(bit) GRID_BARRIER()
#endif
  phase0(p, smem);                                    PHASE_END(0);
  phase1(p);                                          PHASE_END(1);
  phase2(p, smem); phase2_ga(p, smem);                PHASE_END(2);
  phase_moba(p, smem, 0, 512); phase_gla_a(p);        PHASE_END(3);
  phase_gla_b(p);                                     PHASE_END(4);
  phase_gla_c(p);                                     PHASE_END(5);
  phase6(p, smem);                                    PHASE_END(6);
  phase7_rows(p); phase7(p, smem);                    PHASE_END(7);
  phase8(p, smem);                                    PHASE_END(8);
  phase9(p, smem);                                    PHASE_END(9);
  phase10(p, smem);
#if TPROBE
  {
    __syncthreads();
    unsigned long long tn_ = __builtin_amdgcn_s_memrealtime();
    if ((TPROBE >> 10) & 1) tp_extra += tn_ - tp_prev;
    while (__builtin_amdgcn_s_memrealtime() - tn_ < tp_extra) __builtin_amdgcn_s_sleep(8);
  }
#endif
}
#endif

extern "C" void kernel_launch(void* const* d_in, const int* in_sizes, int n_in, void* d_out, int out_size, void* d_ws, size_t ws_size,
                              hipStream_t stream) {
  if (n_in != 23 || out_size != T * D || ws_size < WS_END) {
    fprintf(stderr, "kernel_launch: unexpected problem (n_in %d, out %d, ws %zu, need %zu)\n", n_in, out_size, ws_size, (size_t)WS_END);
    return;
  }
  Params p{};
  const float** f = (const float**)&p;
  for (int i = 0; i < 23; ++i) f[i] = (const float*)d_in[i];
  p.out = (float*)d_out;
  p.ws = (unsigned char*)d_ws;
  (void)hipMemsetAsync(d_ws, 0, ZERO_BYTES, stream);
#if !FUSED
  const dim3 grid(256), blk(NTHR);
  hipLaunchKernelGGL(k_p0, grid, blk, 0, stream, p);
  hipLaunchKernelGGL(k_p1, grid, blk, 0, stream, p);
  hipLaunchKernelGGL(k_p2, grid, blk, 0, stream, p);
  hipLaunchKernelGGL(k_p3, grid, blk, 0, stream, p);
  hipLaunchKernelGGL(k_p4, grid, blk, 0, stream, p);
  hipLaunchKernelGGL(k_p5, grid, blk, 0, stream, p);
  hipLaunchKernelGGL(k_p6, grid, blk, 0, stream, p);
  hipLaunchKernelGGL(k_p7, grid, blk, 0, stream, p);
  hipLaunchKernelGGL(k_p8, grid, blk, 0, stream, p);
  hipLaunchKernelGGL(k_p9, grid, blk, 0, stream, p);
  hipLaunchKernelGGL(k_p10, grid, blk, 0, stream, p);
#else
  static int grid_blocks = 0;
  if (!grid_blocks) {
    int dev = 0, cus = 0, per_cu = 0;
    (void)hipGetDevice(&dev);
    (void)hipDeviceGetAttribute(&cus, hipDeviceAttributeMultiprocessorCount, dev);
    (void)hipOccupancyMaxActiveBlocksPerMultiprocessor(&per_cu, k_fused, NTHR, 0);
    if (per_cu < 1) fprintf(stderr, "kernel_launch: occupancy query reports %d blocks per CU\n", per_cu);
    grid_blocks = cus;
    grid_blocks -= grid_blocks % 8;
  }
  hipLaunchKernelGGL(k_fused, dim3(grid_blocks), dim3(NTHR), 0, stream, p);
#endif
}
```

```cpp
#include <hip/hip_runtime.h>
#include <stdint.h>
#include <stdio.h>

#ifndef FUSED
#define FUSED 1
#endif
#ifndef TPROBE
#define TPROBE 0
#endif

#define DI __device__ __forceinline__
typedef short bf16x8 __attribute__((ext_vector_type(8)));
typedef float f32x16 __attribute__((ext_vector_type(16)));
typedef float f32x4 __attribute__((ext_vector_type(4)));
typedef unsigned u32x4 __attribute__((ext_vector_type(4)));
typedef unsigned u32x2 __attribute__((ext_vector_type(2)));
typedef __bf16 bf16x2_t __attribute__((ext_vector_type(2)));
typedef float f32x2_t __attribute__((ext_vector_type(2)));
typedef unsigned short u16;

#define MFMA32(a, b, c) __builtin_amdgcn_mfma_f32_32x32x16_bf16((a), (b), (c), 0, 0, 0)

constexpr int Bn = 4, S = 4096, D = 1024, T = Bn * S;
constexpr int DIN = 3088;
constexpr int NE = 256;
constexpr float EPS = 1e-6f;
constexpr float LOG2E = 1.4426950408889634f;
constexpr int LISTCAP = 16384;
constexpr float Y_SCALE = 32.f;
constexpr int NTHR = 512;

constexpr size_t al256(size_t x) { return (x + 255) & ~(size_t)255; }
constexpr size_t OFF_BAR   = 0;
constexpr size_t OFF_CNT   = 16384;
constexpr int CNT_STRIDE = 32;
constexpr size_t OFF_QC    = 16384 + 256 * 128;
constexpr size_t ZERO_BYTES = OFF_QC + 32 * 128;
constexpr size_t OFF_KMEAN = ZERO_BYTES;
constexpr size_t OFF_MOD   = al256(OFF_KMEAN + 4 * 8 * 16 * 64 * 4);
constexpr size_t OFF_WRT   = al256(OFF_MOD + 4 * 6144 * 4);
constexpr size_t OFF_WINT  = al256(OFF_WRT + 256 * 1024 * 2);
constexpr size_t OFF_WOUTT = al256(OFF_WINT + (size_t)3088 * 1024 * 2);
constexpr size_t OFF_WS13T = al256(OFF_WOUTT + (size_t)1024 * 1024 * 2);
constexpr size_t OFF_WS2T  = al256(OFF_WS13T + (size_t)512 * 1024 * 2);
constexpr size_t OFF_H1B   = al256(OFF_WS2T + (size_t)1024 * 256 * 2);
constexpr size_t OFF_MQ    = al256(OFF_H1B + (size_t)T * 1024 * 2);
constexpr size_t OFF_MK    = al256(OFF_MQ + (size_t)T * 512 * 2);
constexpr size_t OFF_VT    = al256(OFF_MK + (size_t)T * 512 * 2);
constexpr size_t OFF_GQ    = al256(OFF_VT + (size_t)T * 512 * 2);
constexpr size_t OFF_GK    = al256(OFF_GQ + (size_t)T * 256 * 2);
constexpr size_t OFF_GKT   = al256(OFF_GK + (size_t)T * 256 * 2);
constexpr size_t OFF_GVT   = al256(OFF_GKT + (size_t)T * 256 * 2);
constexpr size_t OFF_SG    = al256(OFF_GVT + (size_t)T * 512 * 2);
constexpr size_t OFF_BC    = al256(OFF_SG + (size_t)T * 512 * 2);
constexpr size_t OFF_BCT   = al256(OFF_BC + (size_t)T * 256 * 4);
constexpr size_t OFF_UT    = al256(OFF_BCT + (size_t)T * 256 * 4);
constexpr size_t OFF_DEC   = al256(OFF_UT + (size_t)16 * 64 * 128 * 64 * 4);
constexpr size_t OFF_ST    = al256(OFF_DEC + (size_t)16 * 64 * 64 * 4);
constexpr size_t OFF_MIX   = al256(OFF_ST + (size_t)16 * 64 * 128 * 64 * 2);
constexpr size_t OFF_D1    = al256(OFF_MIX + (size_t)T * 1024 * 2);
constexpr size_t OFF_H2B   = al256(OFF_D1 + (size_t)T * 1024 * 2);
constexpr size_t OFF_LIST  = al256(OFF_H2B + (size_t)T * 1024 * 2);
constexpr size_t OFF_TOPW  = al256(OFF_LIST + (size_t)256 * LISTCAP * 4);
constexpr size_t OFF_ACT   = al256(OFF_TOPW + (size_t)T * 8 * 4);
constexpr size_t OFF_ACTS  = al256(OFF_ACT + (size_t)T * 8 * 256 * 2);
constexpr size_t OFF_Y     = al256(OFF_ACTS + (size_t)T * 256 * 2);
constexpr size_t OFF_Y2    = al256(OFF_Y + (size_t)T * 8 * 1024);
constexpr size_t WS_END    = al256(OFF_Y2 + (size_t)T * 8 * 1024);

constexpr int LDS_C = 256 * 132 * 4;
constexpr int LDS_TBL = LDS_C;
constexpr int LDS_BYTES = LDS_C + 12288;

struct Params {
  const float *x, *c, *w_ada, *b_ada, *norm1_w, *norm2_w, *w_in, *q_norm_w, *k_norm_w, *rel_bias, *w_alpha, *b_alpha,
      *moba_out_w, *gla_out_w, *w_out, *w_router, *e_bias, *w1, *w3, *w2, *ws1, *ws3, *ws2;
  float* out;
  unsigned char* ws;
};

DI unsigned pack2(float a, float b) { f32x2_t v = {a, b}; return __builtin_bit_cast(unsigned, __builtin_convertvector(v, bf16x2_t)); }
DI float bflo(unsigned u) { return __uint_as_float(u << 16); }
DI float bfhi(unsigned u) { return __uint_as_float(u & 0xffff0000u); }
DI int opaque_tid() { int t = threadIdx.x; asm volatile("" : "+v"(t)); return t; }
DI int crow(int reg, int h) { return (reg & 3) + 8 * (reg >> 2) + 4 * h; }
DI int swz(int row) { return ((row >> 2) ^ (row >> 1)) & 7; }
DI u32x4 pack8(float a0, float a1, float a2, float a3, float a4, float a5, float a6, float a7) {
  u32x4 r; r[0] = pack2(a0, a1); r[1] = pack2(a2, a3); r[2] = pack2(a4, a5); r[3] = pack2(a6, a7); return r;
}
DI float wave_sum(float v) {
  v += __shfl_xor(v, 32); v += __shfl_xor(v, 16); v += __shfl_xor(v, 8); v += __shfl_xor(v, 4); v += __shfl_xor(v, 2); v += __shfl_xor(v, 1);
  return v;
}
DI float siluf(float x) { return x / (1.f + __expf(-x)); }
DI float max3f_mfma(float a, float b, float c) { float d; asm volatile("s_nop 15\n\tv_max3_f32 %0, %1, %2, %3" : "=v"(d) : "v"(a), "v"(b), "v"(c)); return d; }
DI float max3f(float a, float b, float c) { float d; asm("v_max3_f32 %0, %1, %2, %3" : "=v"(d) : "v"(a), "v"(b), "v"(c)); return d; }

typedef __attribute__((address_space(3))) void* lds_ptr_t;
typedef const __attribute__((address_space(1))) void* glb_ptr_t;
template <int NR>
struct LoadBf16 {
  const u16* rp[NR];
  DI void issue(int kt, char* sX, int tid) {
#pragma unroll
    for (int i = 0; i < NR; ++i)
      __builtin_amdgcn_global_load_lds((glb_ptr_t)(rp[i] + kt * 64), (lds_ptr_t)(sX + i * 8192 + tid * 16), 16, 0, 0);
  }
  DI void prefetch0(char* s0, int tid) { issue(0, s0, tid); }
  DI void finish0(char*, int, int) {}
  DI void prologue(char* s0, int nk, int tid) { issue(0, s0, tid); }
  DI void pre(int kt, int nk, char* nxt, int tid) { if (kt + 1 < nk) issue(kt + 1, nxt, tid); }
  DI void pre_commit(int, int, char*, int) {}
  DI void pre_dma(int kt, int nk, char* nxt, int tid) { if (kt + 1 < nk) issue(kt + 1, nxt, tid); }
  static constexpr bool kRegs = false;
  DI bool pre_regs(int, int) { return false; }
};
DI int src_chunk(int tid) { return ((tid & 7) ^ swz(tid >> 3)) * 8; }

struct BLoadF32 {
  const float* p;
  size_t ldb;
  f32x4 v[8];
  DI void issue(int kt) {
    const float* q = p + (size_t)kt * 64 * ldb;
#pragma unroll
    for (int i = 0; i < 8; ++i) v[i] = *(const f32x4*)(q + (size_t)i * ldb);
  }
  DI void commit(char* sB, int tid) {
    const int n4 = (tid & 63) * 4, kg = tid >> 6;
#pragma unroll
    for (int j = 0; j < 4; ++j) {
      const int n = n4 + j;
      u32x4 w = pack8(v[0][j], v[1][j], v[2][j], v[3][j], v[4][j], v[5][j], v[6][j], v[7][j]);
      *(u32x4*)(sB + n * 128 + ((kg ^ swz(n)) << 4)) = w;
    }
  }
  DI void prefetch0(char*, int) { issue(0); }
  DI void finish0(char* s0, int nk, int tid) { commit(s0, tid); if (nk > 1) issue(1); }
  DI void prologue(char* s0, int nk, int tid) { issue(0); commit(s0, tid); if (nk > 1) issue(1); }
  DI void pre(int kt, int nk, char* nxt, int tid) {
    if (kt + 1 < nk) { commit(nxt, tid); if (kt + 2 < nk) issue(kt + 2); }
  }
  DI void pre_commit(int kt, int nk, char* nxt, int tid) { if (kt + 1 < nk) commit(nxt, tid); }
  DI void pre_dma(int, int, char*, int) {}
  static constexpr bool kRegs = true;
  DI bool pre_regs(int kt, int nk) { if (kt + 2 < nk) { issue(kt + 2); return true; } return false; }
};

template <int MT, int MA>
DI void mma_step(const char* sA, const char* sB, f32x16 (&acc)[MA][2], int lane, int wm, int wn) {
  const int r = lane & 31, h = lane >> 5, f = swz(r);
  const char* a0 = sA + (wm * (MT * 32) + r) * 128;
  const char* b0 = sB + (wn * 64 + r) * 128;
  bf16x8 fa[2][MT], fb[2][2];
  {
    const int off = ((h ^ f) << 4);
    fb[0][0] = *(const bf16x8*)(b0 + off); fb[0][1] = *(const bf16x8*)(b0 + 32 * 128 + off);
#pragma unroll
    for (int mt = 0; mt < MT; ++mt) fa[0][mt] = *(const bf16x8*)(a0 + mt * 32 * 128 + off);
  }
#pragma unroll
  for (int kk = 0; kk < 4; ++kk) {
    const int cb = kk & 1, nb = cb ^ 1;
    if (kk < 3) {
      const int off = ((((kk + 1) * 2 + h) ^ f) << 4);
      fb[nb][0] = *(const bf16x8*)(b0 + off); fb[nb][1] = *(const bf16x8*)(b0 + 32 * 128 + off);
#pragma unroll
      for (int mt = 0; mt < MT; ++mt) fa[nb][mt] = *(const bf16x8*)(a0 + mt * 32 * 128 + off);
    }
#pragma unroll
    for (int mt = 0; mt < MT; ++mt) {
      acc[mt][0] = MFMA32(fa[cb][mt], fb[cb][0], acc[mt][0]);
      acc[mt][1] = MFMA32(fa[cb][mt], fb[cb][1], acc[mt][1]);
    }
  }
}

template <class AL, class BL, class F>
DI void kstep_loads(AL& al, BL& bl, int kt, int nk, char* nxt, int tid, F&& compute) {
  al.pre_commit(kt, nk, nxt, tid); bl.pre_commit(kt, nk, nxt + 32768, tid);
  al.pre_dma(kt, nk, nxt, tid);    bl.pre_dma(kt, nk, nxt + 32768, tid);
  const bool ra = al.pre_regs(kt, nk), rb = bl.pre_regs(kt, nk);
  compute();
  if (ra && rb)      asm volatile("s_waitcnt vmcnt(16)" ::: "memory");
  else if (ra || rb) asm volatile("s_waitcnt vmcnt(8)" ::: "memory");
  else               asm volatile("s_waitcnt vmcnt(0)" ::: "memory");
  asm volatile("s_waitcnt lgkmcnt(0)" ::: "memory");
  __builtin_amdgcn_s_barrier();
}

template <class AL, class BL>
DI void tile_start_wait(int nk) {
  constexpr int nreg = (AL::kRegs ? 8 : 0) + (BL::kRegs ? 8 : 0);
  if (nreg == 16 && nk > 1)     asm volatile("s_waitcnt vmcnt(16)" ::: "memory");
  else if (nreg == 8 && nk > 1) asm volatile("s_waitcnt vmcnt(8)" ::: "memory");
  else                          asm volatile("s_waitcnt vmcnt(0)" ::: "memory");
  asm volatile("s_waitcnt lgkmcnt(0)" ::: "memory");
  __builtin_amdgcn_s_barrier();
}

template <int MT, class AL, class BL>
DI void gemm_mainloop(AL& al, BL& bl, int nk, char* smem, f32x16 (&acc)[MT][2]) {
  const int tid = opaque_tid(), lane = tid & 63, w = tid >> 6, wm = w >> 2, wn = w & 3;
#pragma unroll
  for (int i = 0; i < MT; ++i)
#pragma unroll
    for (int j = 0; j < 2; ++j)
#pragma unroll
      for (int r = 0; r < 16; ++r) acc[i][j][r] = 0.f;
  __syncthreads();
  al.prologue(smem, nk, tid); bl.prologue(smem + 32768, nk, tid);
  tile_start_wait<AL, BL>(nk);
  for (int kt = 0; kt < nk; ++kt) {
    const int cur = kt & 1;
    char* nxt = smem + (cur ^ 1) * 65536;
    kstep_loads(al, bl, kt, nk, nxt, tid, [&]() { mma_step<MT, MT>(smem + cur * 65536, smem + cur * 65536 + 32768, acc, lane, wm, wn); });
  }
}

template <int MT, int MA, class AL, class BL, bool NOMMA = false>
DI void gemm_kloop_prefetched(AL& al, BL& bl, int nk, char* smem, f32x16 (&acc)[MA][2]) {
  const int tid = opaque_tid(), lane = tid & 63, w = tid >> 6, wm = w >> 2, wn = w & 3;
#pragma unroll
  for (int i = 0; i < MT; ++i)
#pragma unroll
    for (int j = 0; j < 2; ++j)
#pragma unroll
      for (int r = 0; r < 16; ++r) acc[i][j][r] = 0.f;
  al.finish0(smem, nk, tid); bl.finish0(smem + 32768, nk, tid);
  tile_start_wait<AL, BL>(nk);
  for (int kt = 0; kt < nk; ++kt) {
    const int cur = kt & 1;
    char* nxt = smem + (cur ^ 1) * 65536;
    kstep_loads(al, bl, kt, nk, nxt, tid, [&]() { if (!NOMMA) mma_step<MT, MA>(smem + cur * 65536, smem + cur * 65536 + 32768, acc, lane, wm, wn); });
  }
}
DI void lds_barrier() { asm volatile("s_waitcnt lgkmcnt(0)" ::: "memory"); __builtin_amdgcn_s_barrier(); }
template <int MT, int MA>
DI void stage_quarter(float* cs, const f32x16 (&acc)[MA][2], int q) {
  const int tid_ = opaque_tid(); const int lane = tid_ & 63, w = tid_ >> 6, wm = w >> 2, wn = w & 3, r = lane & 31, h = lane >> 5;
  if (MT == 4) {
    if (wm != (q >> 1)) return;
#pragma unroll
    for (int mt = 0; mt < 4; ++mt) {
      if ((mt >> 1) == (q & 1)) {
#pragma unroll
        for (int nt = 0; nt < 2; ++nt)
#pragma unroll
          for (int g = 0; g < 16; ++g) cs[((mt & 1) * 32 + crow(g, h)) * 260 + wn * 64 + nt * 32 + r] = acc[mt][nt][g];
      }
    }
  } else {
    if (wm != q) return;
#pragma unroll
    for (int mt = 0; mt < 2; ++mt)
#pragma unroll
      for (int nt = 0; nt < 2; ++nt)
#pragma unroll
        for (int g = 0; g < 16; ++g) cs[(mt * 32 + crow(g, h)) * 260 + wn * 64 + nt * 32 + r] = acc[mt][nt][g];
  }
}

template <int MT>
DI void stage_nat(float* cs, const f32x16 (&acc)[MT][2], int half) {
  const int tid_ = opaque_tid(); const int lane = tid_ & 63, w = tid_ >> 6, wm = w >> 2, wn = w & 3, r = lane & 31, h = lane >> 5;
  if (MT == 4 && wm != half) return;
  const int rb = (MT == 4) ? 0 : wm * 64;
#pragma unroll
  for (int mt = 0; mt < MT; ++mt)
#pragma unroll
    for (int nt = 0; nt < 2; ++nt)
#pragma unroll
      for (int g = 0; g < 16; ++g) cs[(rb + mt * 32 + crow(g, h)) * 260 + wn * 64 + nt * 32 + r] = acc[mt][nt][g];
}
DI void stage_tr(float* cs, const f32x16 (&acc)[4][2], int half) {
  const int tid_ = opaque_tid(); const int lane = tid_ & 63, w = tid_ >> 6, wm = w >> 2, wn = w & 3, r = lane & 31, h = lane >> 5;
  if (wm != half) return;
#pragma unroll
  for (int mt = 0; mt < 4; ++mt)
#pragma unroll
    for (int nt = 0; nt < 2; ++nt)
#pragma unroll
      for (int g = 0; g < 4; ++g) {
        f32x4 v = {acc[mt][nt][4 * g], acc[mt][nt][4 * g + 1], acc[mt][nt][4 * g + 2], acc[mt][nt][4 * g + 3]};
        *(f32x4*)(cs + (wn * 64 + nt * 32 + r) * 132 + mt * 32 + 8 * g + 4 * h) = v;
      }
}

DI void transpose_item(const float* src, int ld, int n_src_col, u16* dst_row, int k8) {
  float v[8];
#pragma unroll
  for (int j = 0; j < 8; ++j) v[j] = src[(size_t)(k8 + j) * ld + n_src_col];
  *(u32x4*)(dst_row + k8) = pack8(v[0], v[1], v[2], v[3], v[4], v[5], v[6], v[7]);
}

DI void phase0(const Params& p, char* smem) {
  const int tid = opaque_tid(), lane = tid & 63, w = tid >> 6;
  float* mod = (float*)(p.ws + OFF_MOD);
  float* sil = (float*)smem;
  float* red = sil + 4096;
  for (int task = blockIdx.x; task < 96; task += gridDim.x) {
    __syncthreads();
    for (int i = tid; i < 4096; i += NTHR) sil[i] = siluf(p.c[i]);
    __syncthreads();
    const int col = task * 64 + lane;
    float a0 = 0.f, a1 = 0.f, a2 = 0.f, a3 = 0.f;
    const float* wp = p.w_ada + (size_t)(w * 128) * 6144 + col;
#pragma unroll 32
    for (int k = 0; k < 128; ++k) {
      const float wv = wp[(size_t)k * 6144];
      const int kk = w * 128 + k;
      a0 += sil[kk] * wv; a1 += sil[1024 + kk] * wv; a2 += sil[2048 + kk] * wv; a3 += sil[3072 + kk] * wv;
    }
    red[(w * 4 + 0) * 64 + lane] = a0; red[(w * 4 + 1) * 64 + lane] = a1; red[(w * 4 + 2) * 64 + lane] = a2; red[(w * 4 + 3) * 64 + lane] = a3;
    __syncthreads();
    if (w < 4) {
      const int b = w;
      float s = 0.f;
#pragma unroll
      for (int q = 0; q < 8; ++q) s += red[(q * 4 + b) * 64 + lane];
      mod[b * 6144 + col] = s + p.b_ada[col];
    }
  }
  const int nfree = (int)gridDim.x > 96 ? (int)gridDim.x - 96 : (int)gridDim.x;
  const int fb = (int)gridDim.x > 96 ? (int)blockIdx.x - 96 : (int)blockIdx.x;
  if (fb < 0) return;
  const int gsz = nfree * NTHR, gid = fb * NTHR + tid;
  u16* wrT = (u16*)(p.ws + OFF_WRT);
  for (int i = gid; i < 256 * 128; i += gsz) { const int n = i & 255, k8 = (i >> 8) * 8; transpose_item(p.w_router, 256, n, wrT + (size_t)n * 1024, k8); }
  u16* winT = (u16*)(p.ws + OFF_WINT);
  for (int i = gid; i < 3088 * 128; i += gsz) { const int n = i % 3088, k8 = (i / 3088) * 8; transpose_item(p.w_in, DIN, n, winT + (size_t)n * 1024, k8); }
  u16* woutT = (u16*)(p.ws + OFF_WOUTT);
  for (int i = gid; i < 1024 * 128; i += gsz) { const int n = i & 1023, k8 = (i >> 10) * 8; transpose_item(p.w_out, 1024, n, woutT + (size_t)n * 1024, k8); }
  u16* ws13T = (u16*)(p.ws + OFF_WS13T);
  for (int i = gid; i < 512 * 128; i += gsz) {
    const int n = i & 511, k8 = (i >> 9) * 8;
    const int col = (n >> 8) * 128 + ((n >> 6) & 3) * 32 + (n & 31);
    transpose_item(((n >> 5) & 1) ? p.ws3 : p.ws1, 256, col, ws13T + (size_t)n * 1024, k8);
  }
  u16* ws2T = (u16*)(p.ws + OFF_WS2T);
  for (int i = gid; i < 1024 * 32; i += gsz) { const int n = i & 1023, k8 = (i >> 10) * 8; transpose_item(p.ws2, 1024, n, ws2T + (size_t)n * 256, k8); }
}

DI void phase1(const Params& p) {
  const int tid = opaque_tid(), lane = tid & 63, w = tid >> 6;
  const float* mod = (const float*)(p.ws + OFF_MOD);
  u16* h1b = (u16*)(p.ws + OFF_H1B);
  const int nW = gridDim.x * 8;
  for (int t0 = blockIdx.x * 8 + w; t0 < T; t0 += 4 * nW) {
    f32x4 xv[4][4]; float ssq[4];
#pragma unroll
    for (int q = 0; q < 4; ++q) {
      const int t = t0 + q * nW;
      ssq[q] = 0.f;
      if (t < T) {
#pragma unroll
        for (int i = 0; i < 4; ++i) xv[q][i] = *(const f32x4*)(p.x + (size_t)t * 1024 + i * 256 + lane * 4);
      }
    }
#pragma unroll
    for (int q = 0; q < 4; ++q) {
      const int t = t0 + q * nW;
      if (t < T) {
#pragma unroll
        for (int i = 0; i < 4; ++i) ssq[q] += xv[q][i][0] * xv[q][i][0] + xv[q][i][1] * xv[q][i][1] + xv[q][i][2] * xv[q][i][2] + xv[q][i][3] * xv[q][i][3];
      }
      ssq[q] = wave_sum(ssq[q]);
    }
#pragma unroll
    for (int q = 0; q < 4; ++q) {
      const int t = t0 + q * nW;
      if (t < T) {
        const int b = t >> 12;
        const float r = rsqrtf(ssq[q] * (1.f / 1024.f) + EPS);
#pragma unroll
        for (int i = 0; i < 4; ++i) {
          const int k = i * 256 + lane * 4;
          const f32x4 nw = *(const f32x4*)(p.norm1_w + k);
          const f32x4 sc = *(const f32x4*)(mod + b * 6144 + 1024 + k);
          const f32x4 sh = *(const f32x4*)(mod + b * 6144 + k);
          float o[4];
#pragma unroll
          for (int j = 0; j < 4; ++j) o[j] = xv[q][i][j] * r * nw[j] * (1.f + sc[j]) + sh[j];
          u32x2 pk = {pack2(o[0], o[1]), pack2(o[2], o[3])};
          *(u32x2*)(h1b + (size_t)t * 1024 + k) = pk;
        }
      }
    }
  }
}

DI float logsig(float z) { return fminf(z, 0.f) - log1pf(__expf(-fabsf(z))); }

DI void phase2(const Params& p, char* smem) {
  const int tid = opaque_tid();
  const u16* h1b = (const u16*)(p.ws + OFF_H1B);
  const u16* winT = (const u16*)(p.ws + OFF_WINT);
  float* cs = (float*)smem;
  const int xg = blockIdx.x & 7, xj = blockIdx.x >> 3, xn = gridDim.x >> 3;
  for (int l = xj; l < 96; l += xn) {
    const int mtile = xg * 8 + (l & 7), ntile = l >> 3;
    const int row0 = mtile * 256, b = row0 >> 12, s0 = row0 & 4095;
    LoadBf16<4> al; LoadBf16<4> bl;
#pragma unroll
    for (int i = 0; i < 4; ++i) {
      al.rp[i] = h1b + (size_t)(row0 + (tid >> 3) + 64 * i) * 1024 + src_chunk(tid);
      bl.rp[i] = winT + (size_t)(ntile * 256 + (tid >> 3) + 64 * i) * 1024 + src_chunk(tid);
    }
    f32x16 acc[4][2];
    gemm_mainloop<4>(al, bl, 16, smem, acc);
    const bool nat = (ntile < 4) || ntile == 6 || ntile == 7 || ntile >= 10;
    const bool tr = (ntile == 4 || ntile == 5 || (ntile >= 7 && ntile < 10));
    if (nat) {
      float ksum[8];
#pragma unroll
      for (int q = 0; q < 8; ++q) ksum[q] = 0.f;
#pragma unroll 1
      for (int half = 0; half < 2; ++half) {
        __syncthreads();
        stage_nat<4>(cs, acc, half);
        __syncthreads();
#pragma unroll 1
        for (int it = 0; it < 8; ++it) {
          const int i = it * NTHR + tid, row = i >> 5, c8 = (i & 31) * 8;
          const int srow = s0 + half * 128 + row;
          const f32x4 va = *(const f32x4*)(cs + row * 260 + c8), vb = *(const f32x4*)(cs + row * 260 + c8 + 4);
          float v[8] = {va[0], va[1], va[2], va[3], vb[0], vb[1], vb[2], vb[3]};
          const int d0 = c8 & 63;
          if (ntile < 4) {
            float ssq = 0.f;
#pragma unroll
            for (int q = 0; q < 8; ++q) ssq += v[q] * v[q];
            ssq += __shfl_xor(ssq, 1); ssq += __shfl_xor(ssq, 2); ssq += __shfl_xor(ssq, 4);
            const float sc = rsqrtf(ssq * (1.f / 64.f) + EPS);
            const float* nw = (ntile < 2) ? p.q_norm_w : p.k_norm_w;
#pragma unroll
            for (int q = 0; q < 8; ++q) v[q] = v[q] * sc * nw[d0 + q];
            const int hd = (ntile & 1) * 4 + (c8 >> 6);
            u16* dst = (u16*)(p.ws + (ntile < 2 ? OFF_MQ : OFF_MK)) + ((size_t)(b * 8 + hd) * S + srow) * 64 + d0;
            *(u32x4*)dst = pack8(v[0], v[1], v[2], v[3], v[4], v[5], v[6], v[7]);
            if (ntile >= 2) {
#pragma unroll
              for (int q = 0; q < 8; ++q) ksum[q] += v[q];
            }
          } else if (ntile < 8) {
            const int hd = c8 >> 6;
            if (ntile == 6) {
#pragma unroll
              for (int q = 0; q < 8; ++q) v[q] *= 0.125f;
            }
            u16* dst = (u16*)(p.ws + (ntile == 6 ? OFF_GQ : OFF_GK)) + ((size_t)(b * 4 + hd) * S + srow) * 64 + d0;
            *(u32x4*)dst = pack8(v[0], v[1], v[2], v[3], v[4], v[5], v[6], v[7]);
          } else {
#pragma unroll
            for (int q = 0; q < 8; ++q) v[q] = siluf(v[q]);
            u16* dst = (u16*)(p.ws + OFF_SG) + (size_t)(row0 + half * 128 + row) * 512 + (ntile - 10) * 256 + c8;
            *(u32x4*)dst = pack8(v[0], v[1], v[2], v[3], v[4], v[5], v[6], v[7]);
          }
        }
      }
      if (ntile == 2 || ntile == 3) {
        __syncthreads();
        const int c8 = (tid & 31) * 8;
#pragma unroll
        for (int q = 0; q < 8; ++q) cs[(tid >> 5) * 256 + c8 + q] = ksum[q];
        __syncthreads();
        if (tid < 256) {
          float s = 0.f;
#pragma unroll
          for (int q = 0; q < 16; ++q) s += cs[q * 256 + tid];
          const int hd = (ntile - 2) * 4 + (tid >> 6);
          float* km = (float*)(p.ws + OFF_KMEAN);
          km[((size_t)(b * 8 + hd) * 16 + (s0 >> 8)) * 64 + (tid & 63)] = s * (1.f / 256.f);
        }
      }
    }
    if (tr) {
#pragma unroll 1
      for (int half = 0; half < 2; ++half) {
        __syncthreads();
        stage_tr(cs, acc, half);
        __syncthreads();
#pragma unroll 1
        for (int it = 0; it < 8; ++it) {
          const int i = it * NTHR + tid, col = i >> 4, r8 = (i & 15) * 8;
          const int srow = s0 + half * 128 + r8;
          const f32x4 va = *(const f32x4*)(cs + col * 132 + r8), vb = *(const f32x4*)(cs + col * 132 + r8 + 4);
          u16* dst;
          if (ntile < 6)       dst = (u16*)(p.ws + OFF_VT) + ((size_t)(b * 8 + (ntile - 4) * 4 + (col >> 6)) * 64 + (col & 63)) * S + srow;
          else if (ntile == 7) dst = (u16*)(p.ws + OFF_GKT) + ((size_t)(b * 4 + (col >> 6)) * 64 + (col & 63)) * S + srow;
          else                 dst = (u16*)(p.ws + OFF_GVT) + ((size_t)(b * 4 + (ntile - 8) * 2 + (col >> 7)) * 128 + (col & 127)) * S + srow;
          *(u32x4*)dst = pack8(va[0], va[1], va[2], va[3], vb[0], vb[1], vb[2], vb[3]);
        }
      }
    }
  }
}

DI void phase2_ga(const Params& p, char* smem) {
  const int tid = opaque_tid(), lane = tid & 63, w = tid >> 6, r = lane & 31, h5 = lane >> 5;
  const u16* h1b = (const u16*)(p.ws + OFF_H1B);
  const u16* winT = (const u16*)(p.ws + OFF_WINT);
  float* gs = (float*)smem;
  for (int task = blockIdx.x; task < 256; task += gridDim.x) {
    const int row0 = task * 64, b = row0 >> 12, s0 = row0 & 4095;
    __syncthreads();
    if (w < 2) {
      f32x16 acc;
#pragma unroll
      for (int i = 0; i < 16; ++i) acc[i] = 0.f;
      const u16* ap = h1b + (size_t)(row0 + w * 32 + r) * 1024 + h5 * 8;
      const u16* bp = winT + (size_t)(3072 + (r & 15)) * 1024 + h5 * 8;
#pragma unroll 4
      for (int ks = 0; ks < 64; ++ks) acc = MFMA32(*(const bf16x8*)(ap + ks * 16), *(const bf16x8*)(bp + ks * 16), acc);
      if (r < 16) {
#pragma unroll
        for (int i = 0; i < 16; ++i) gs[(w * 32 + crow(i, h5)) * 17 + r] = acc[i];
      }
    }
    __syncthreads();
    if (tid < 256) {
      float wa[16];
#pragma unroll
      for (int q = 0; q < 16; ++q) wa[q] = p.w_alpha[q * 256 + tid];
      const float ba = p.b_alpha[tid];
      const int hd = tid >> 6, d = tid & 63;
      float* bc = (float*)(p.ws + OFF_BC) + ((size_t)(b * 4 + hd) * S + s0) * 64 + d;
      float* bct = (float*)(p.ws + OFF_BCT) + ((size_t)(b * 4 + hd) * 64 + d) * S + s0;
      float cum = 0.f;
#pragma unroll 1
      for (int r4 = 0; r4 < 16; ++r4) {
        f32x4 o;
#pragma unroll
        for (int q4 = 0; q4 < 4; ++q4) {
          const int row = r4 * 4 + q4;
          float z = ba;
#pragma unroll
          for (int q = 0; q < 16; ++q) z += gs[row * 17 + q] * wa[q];
          cum += logsig(z) * (1.f / 16.f);
          bc[(size_t)row * 64] = cum;
          o[q4] = cum;
        }
        *(f32x4*)(bct + r4 * 4) = o;
      }
    }
  }
}

DI int t5_bucket(int rel) {
  if (rel < 16) return rel;
  int bkt = 16;
  bkt += (rel >= 19); bkt += (rel >= 21); bkt += (rel >= 24); bkt += (rel >= 27); bkt += (rel >= 31); bkt += (rel >= 35); bkt += (rel >= 40);
  bkt += (rel >= 46); bkt += (rel >= 52); bkt += (rel >= 59); bkt += (rel >= 67); bkt += (rel >= 77); bkt += (rel >= 87); bkt += (rel >= 99); bkt += (rel >= 113);
  return bkt;
}

struct MobaState { f32x16 o0, o1; float m, l; };
struct MobaFrags { bf16x8 k[4]; bf16x8 v[4]; };

DI int swap23(int r) { return (r & ~12) | ((r & 4) << 1) | ((r & 8) >> 1); }
DI int kofs(int i, int h) { return (i & 3) + 4 * ((i >> 2) & 1) + 8 * h + 16 * (i >> 3); }
DI void moba_lds_load(MobaFrags& f, const char* sp, int sb, int r, int h5) {
  const int kr = swap23(r);
  const char* kp = sp + (sb * 32 + kr) * 128;
  const int fk = swz(kr), fz = swz(r);
#pragma unroll
  for (int ks = 0; ks < 4; ++ks) f.k[ks] = *(const bf16x8*)(kp + (((ks * 2 + h5) ^ fk) << 4));
#pragma unroll
  for (int s2 = 0; s2 < 2; ++s2)
#pragma unroll
    for (int dt = 0; dt < 2; ++dt)
      f.v[s2 * 2 + dt] = *(const bf16x8*)(sp + 8192 + (dt * 32 + r) * 128 + (((sb * 4 + s2 * 2 + h5) ^ fz) << 4));
}

template <int MODE, int VAR>
DI void moba_tile(MobaState& st, const bf16x8 (&qf)[4], const char* sp, int kpos0, int qpos, bool sel,
                  const float* lut, float cb31, int r, int h5) {
  const float NEG = -__builtin_inff();
  MobaFrags f0, f1;
  moba_lds_load(f0, sp, 0, r, h5);
  moba_lds_load(f1, sp, 1, r, h5);
  f32x16 s0, s1;
#pragma unroll
  for (int i = 0; i < 16; ++i) { s0[i] = 0.f; s1[i] = 0.f; }
#pragma unroll
  for (int ks = 0; ks < 4; ++ks) { if (VAR != 1) { s0 = MFMA32(f0.k[ks], qf[ks], s0); s1 = MFMA32(f1.k[ks], qf[ks], s1); } else { s0[ks] += __builtin_bit_cast(float, (int)f0.k[ks][0]); s1[ks] += __builtin_bit_cast(float, (int)f1.k[ks][1]); } }
  const float c1 = 0.125f * LOG2E;
  float t0[16], t1[16]; float tm;
  float alpha;
  if (VAR == 3) {
#pragma unroll
    for (int i = 0; i < 16; ++i) { t0[i] = s0[i]; t1[i] = s1[i]; }
    alpha = 1.f;
  } else if (MODE == 0) {
    const float c1e = sel ? c1 : 0.f, cbe = sel ? cb31 : NEG;
    float sm = max3f_mfma(s0[15], s1[15], s0[0]);
    sm = max3f(sm, s1[0], s0[1]);
#pragma unroll
    for (int i = 1; i < 14; ++i) sm = max3f(sm, s1[i], s0[i + 1]);
    sm = fmaxf(sm, s1[14]);
    tm = sm * c1e + cbe;
    tm = fmaxf(tm, __shfl_xor(tm, 32));
    const float mn = fmaxf(st.m, tm);
    const float mu = (mn == NEG) ? 0.f : mn;
    alpha = __builtin_amdgcn_exp2f(st.m - mu);
    const float off = cbe - mu;
    float psum = 0.f;
#pragma unroll
    for (int i = 0; i < 16; ++i) { t0[i] = __builtin_amdgcn_exp2f(s0[i] * c1e + off); t1[i] = __builtin_amdgcn_exp2f(s1[i] * c1e + off); psum += t0[i] + t1[i]; }
    st.l = st.l * alpha + psum; st.m = mn;
  } else {
    tm = NEG;
#pragma unroll
    for (int i = 0; i < 16; ++i) {
      const int rel0 = qpos - (kpos0 + kofs(i, h5)), rel1 = rel0 - 32;
      const float b0 = lut[min(max(rel0, 0), 127)];
      const float b1 = lut[min(max(rel1, 0), 127)];
      float v0 = s0[i] * c1 + b0, v1 = s1[i] * c1 + b1;
      if (MODE == 2) { if (rel0 < 0) v0 = NEG; if (rel1 < 0) v1 = NEG; }
      if (MODE == 1 && !sel) { v0 = NEG; v1 = NEG; }
      t0[i] = v0; t1[i] = v1; tm = max3f(tm, v0, v1);
    }
    tm = fmaxf(tm, __shfl_xor(tm, 32));
    const float mn = fmaxf(st.m, tm);
    const float mu = (mn == NEG) ? 0.f : mn;
    alpha = __builtin_amdgcn_exp2f(st.m - mu);
    float psum = 0.f;
#pragma unroll
    for (int i = 0; i < 16; ++i) { t0[i] = __builtin_amdgcn_exp2f(t0[i] - mu); t1[i] = __builtin_amdgcn_exp2f(t1[i] - mu); psum += t0[i] + t1[i]; }
    st.l = st.l * alpha + psum; st.m = mn;
  }
#pragma unroll
  for (int i = 0; i < 16; ++i) { st.o0[i] *= alpha; st.o1[i] *= alpha; }
  const bf16x8 p00 = __builtin_bit_cast(bf16x8, pack8(t0[0], t0[1], t0[2], t0[3], t0[4], t0[5], t0[6], t0[7]));
  const bf16x8 p01 = __builtin_bit_cast(bf16x8, pack8(t0[8], t0[9], t0[10], t0[11], t0[12], t0[13], t0[14], t0[15]));
  const bf16x8 p10 = __builtin_bit_cast(bf16x8, pack8(t1[0], t1[1], t1[2], t1[3], t1[4], t1[5], t1[6], t1[7]));
  const bf16x8 p11 = __builtin_bit_cast(bf16x8, pack8(t1[8], t1[9], t1[10], t1[11], t1[12], t1[13], t1[14], t1[15]));
#pragma unroll
  for (int s2 = 0; s2 < 2; ++s2) {
#pragma unroll
    for (int dt = 0; dt < 2; ++dt) {
      const bf16x8 va = f0.v[s2 * 2 + dt], vb = f1.v[s2 * 2 + dt];
      if (VAR == 2) { st.o0[s2 * 2 + dt] += __builtin_bit_cast(float, (int)va[0] ^ (int)vb[1]) + __builtin_bit_cast(float, (int)(s2 ? p01 : p00)[0] + (int)(s2 ? p11 : p10)[1]); }
      else if (dt == 0) { st.o0 = MFMA32(va, s2 ? p01 : p00, st.o0); st.o0 = MFMA32(vb, s2 ? p11 : p10, st.o0); }
      else              { st.o1 = MFMA32(va, s2 ? p01 : p00, st.o1); st.o1 = MFMA32(vb, s2 ? p11 : p10, st.o1); }
    }
  }
}

template <int VAR>
DI void phase_moba(const Params& p, char* smem, int task_lo, int task_hi, u16* mix) {
  const int tid = opaque_tid(), lane = tid & 63, w = tid >> 6, r = lane & 31, h5 = lane >> 5;
  float* lut = (float*)(smem + 65536);
  unsigned* um = (unsigned*)(smem + 65536 + 512);
  const float NEG = -__builtin_inff();
  const u16* mq = (const u16*)(p.ws + OFF_MQ);
  const u16* mk = (const u16*)(p.ws + OFF_MK);
  const u16* vT = (const u16*)(p.ws + OFF_VT);
  const float* kmean = (const float*)(p.ws + OFF_KMEAN);
  for (int task = task_lo + blockIdx.x; task < task_hi; task += gridDim.x) {
    const int blk = (task < 256) ? 15 - (task >> 5) : ((task - 256) >> 5);
    const int bh = task & 31, hd = bh & 7, b = bh >> 3;
    __syncthreads();
    if (tid < 128) lut[tid] = p.rel_bias[t5_bucket(tid) * 8 + hd] * LOG2E;
    __syncthreads();
    const float cb31 = p.rel_bias[31 * 8 + hd] * LOG2E;
    const int qpos = blk * 256 + w * 32 + r;
    const u16* qptr = mq + ((size_t)bh * S + qpos) * 64 + h5 * 8;
    bf16x8 qf[4];
#pragma unroll
    for (int ks = 0; ks < 4; ++ks) qf[ks] = *(const bf16x8*)(qptr + ks * 16);
    unsigned selmask = 0;
    if (blk > 0) {
      f32x16 g;
#pragma unroll
      for (int i = 0; i < 16; ++i) g[i] = 0.f;
      const int n = r < 15 ? r : 15;
      const float* kmp = kmean + ((size_t)bh * 16 + n) * 64 + h5 * 8;
#pragma unroll
      for (int ks = 0; ks < 4; ++ks) {
        const f32x4 v0 = *(const f32x4*)(kmp + ks * 16), v1 = *(const f32x4*)(kmp + ks * 16 + 4);
        const u32x4 hi = pack8(v0[0], v0[1], v0[2], v0[3], v1[0], v1[1], v1[2], v1[3]);
        const u32x4 lo = pack8(v0[0] - bflo(hi[0]), v0[1] - bfhi(hi[0]), v0[2] - bflo(hi[1]), v0[3] - bfhi(hi[1]),
                               v1[0] - bflo(hi[2]), v1[1] - bfhi(hi[2]), v1[2] - bflo(hi[3]), v1[3] - bfhi(hi[3]));
        g = MFMA32(__builtin_bit_cast(bf16x8, hi), qf[ks], g);
        g = MFMA32(__builtin_bit_cast(bf16x8, lo), qf[ks], g);
      }
      float gt[16];
#pragma unroll
      for (int nn = 0; nn < 16; ++nn) {
        const int x = (nn >> 2) & 1, rr = (nn & 3) + 4 * (nn >> 3);
        const float own = g[rr];
        const float par = __shfl_xor(own, 32);
        gt[nn] = (h5 == x) ? own : par;
      }
#pragma unroll
      for (int it = 0; it < 3; ++it) {
        float best = NEG; int bi = -1;
#pragma unroll
        for (int nn = 0; nn < 16; ++nn) {
          const bool ok = (nn < blk) && !((selmask >> nn) & 1u);
          if (ok && gt[nn] > best) { best = gt[nn]; bi = nn; }
        }
        if (bi >= 0) selmask |= 1u << bi;
      }
    }
    unsigned wmask = 0;
    for (int nn = 0; nn < blk; ++nn) if (__any((int)((selmask >> nn) & 1u))) wmask |= 1u << nn;
    if (lane == 0) um[w] = wmask;
    __syncthreads();
    unsigned bmask = 1u << blk;
#pragma unroll
    for (int q = 0; q < 8; ++q) bmask |= um[q];
    MobaState st;
#pragma unroll
    for (int i = 0; i < 16; ++i) { st.o0[i] = 0.f; st.o1[i] = 0.f; }
    st.m = NEG; st.l = 0.f;
    const u16* kbase = mk + (size_t)bh * S * 64;
    const u16* vbase = vT + (size_t)bh * 64 * S;
    const int ntile = __builtin_popcount(bmask) * 4;
    LoadBf16<2> ld;
    int pn = __builtin_ctz(bmask), pj = 0, pit = 0;
    auto issue_next = [&]() {
      if (pit < ntile) {
        ld.rp[0] = kbase + (size_t)(pn * 256 + pj * 64 + (tid >> 3)) * 64 + src_chunk(tid);
        ld.rp[1] = vbase + (size_t)(tid >> 3) * S + pn * 256 + pj * 64 + src_chunk(tid);
        ld.issue(0, smem + (pit & 3) * 16384, tid);
        ++pit;
        if (++pj == 4) { pj = 0; if (pn != blk) pn = __builtin_ctz(bmask & ~((2u << pn) - 1u)); }
      }
    };
    issue_next(); issue_next(); issue_next();
    int n = __builtin_ctz(bmask), j = 0;
    for (int it = 0; it < ntile; ++it) {
      const int ahead = pit - it - 1;
      if (ahead >= 2) asm volatile("s_waitcnt vmcnt(4)" ::: "memory");
      else if (ahead == 1) asm volatile("s_waitcnt vmcnt(2)" ::: "memory");
      else asm volatile("s_waitcnt vmcnt(0)" ::: "memory");
      __builtin_amdgcn_s_barrier();
      issue_next();
      const char* sp = smem + (it & 3) * 16384;
      const int kp0 = n * 256 + j * 64;
      if (n == blk) {
        if (2 * j <= w) moba_tile<2, VAR>(st, qf, sp, kp0, qpos, true, lut, cb31, r, h5);
      } else if ((wmask >> n) & 1u) {
        const bool sel = (selmask >> n) & 1u;
        if (n == blk - 1) moba_tile<1, VAR>(st, qf, sp, kp0, qpos, sel, lut, cb31, r, h5);
        else              moba_tile<0, VAR>(st, qf, sp, kp0, qpos, sel, lut, cb31, r, h5);
      }
      if (++j == 4) { j = 0; if (n != blk) n = __builtin_ctz(bmask & ~((2u << n) - 1u)); }
    }
    __syncthreads();
    float l = st.l + __shfl_xor(st.l, 32);
    const float inv = 1.f / l;
    float ssq = 0.f;
#pragma unroll
    for (int i = 0; i < 16; ++i) { st.o0[i] *= inv; st.o1[i] *= inv; ssq += st.o0[i] * st.o0[i] + st.o1[i] * st.o1[i]; }
    ssq += __shfl_xor(ssq, 32);
    const float rs = rsqrtf(ssq * (1.f / 64.f) + EPS);
    u16* op = mix + (size_t)(b * S + qpos) * 1024 + hd * 64;
#pragma unroll
    for (int dt = 0; dt < 2; ++dt)
#pragma unroll
      for (int g4 = 0; g4 < 4; ++g4) {
        const int d0 = dt * 32 + 8 * g4 + 4 * h5;
        const f32x4 mw = *(const f32x4*)(p.moba_out_w + d0);
        float o[4];
#pragma unroll
        for (int q = 0; q < 4; ++q) o[q] = (dt ? st.o1[4 * g4 + q] : st.o0[4 * g4 + q]) * rs * mw[q];
        u32x2 pk = {pack2(o[0], o[1]), pack2(o[2], o[3])};
        *(u32x2*)(op + d0) = pk;
      }
  }
}

DI void phase_gla_a(const Params& p) {
  const int tid = opaque_tid(), lane = tid & 63, w = tid >> 6, r = lane & 31, h5 = lane >> 5;
  const u16* gkT = (const u16*)(p.ws + OFF_GKT);
  const u16* gvT = (const u16*)(p.ws + OFF_GVT);
  const float* bcT = (const float*)(p.ws + OFF_BCT);
  float* UT = (float*)(p.ws + OFF_UT);
  float* dec = (float*)(p.ws + OFF_DEC);
  for (int task = blockIdx.x; task < 512; task += gridDim.x) {
    const int bh = task >> 5, c = (task & 31) * 2 + (w >> 2), vt = w & 3;
    f32x16 acc[2];
#pragma unroll
    for (int i = 0; i < 16; ++i) { acc[0][i] = 0.f; acc[1][i] = 0.f; }
    const u16* vp = gvT + ((size_t)bh * 128 + vt * 32 + r) * S + c * 64 + h5 * 8;
#pragma unroll
    for (int dt = 0; dt < 2; ++dt) {
      const int d = dt * 32 + r;
      const float* bp = bcT + ((size_t)bh * 64 + d) * S + c * 64;
      const u16* kp = gkT + ((size_t)bh * 64 + d) * S + c * 64;
      const float bl = bp[63];
      if (vt == 0 && h5 == 0) dec[((size_t)bh * 64 + c) * 64 + d] = __expf(bl);
#pragma unroll
      for (int ks = 0; ks < 4; ++ks) {
        const u32x4 kk = *(const u32x4*)(kp + ks * 16 + h5 * 8);
        const f32x4 b0 = *(const f32x4*)(bp + ks * 16 + h5 * 8), b1 = *(const f32x4*)(bp + ks * 16 + h5 * 8 + 4);
        const u32x4 kh = pack8(bflo(kk[0]) * __expf(bl - b0[0]), bfhi(kk[0]) * __expf(bl - b0[1]), bflo(kk[1]) * __expf(bl - b0[2]), bfhi(kk[1]) * __expf(bl - b0[3]),
                               bflo(kk[2]) * __expf(bl - b1[0]), bfhi(kk[2]) * __expf(bl - b1[1]), bflo(kk[3]) * __expf(bl - b1[2]), bfhi(kk[3]) * __expf(bl - b1[3]));
        const bf16x8 vf = *(const bf16x8*)(vp + ks * 16);
        acc[dt] = MFMA32(vf, __builtin_bit_cast(bf16x8, kh), acc[dt]);
      }
    }
    float* up = UT + ((size_t)bh * 64 + c) * 128 * 64;
#pragma unroll
    for (int dt = 0; dt < 2; ++dt)
#pragma unroll
      for (int i = 0; i < 16; ++i) up[(size_t)(vt * 32 + crow(i, h5)) * 64 + dt * 32 + r] = acc[dt][i];
  }
}

DI void phase_gla_b(const Params& p) {
  const float* UT = (const float*)(p.ws + OFF_UT);
  const float* dec = (const float*)(p.ws + OFF_DEC);
  u16* ST = (u16*)(p.ws + OFF_ST);
  for (int i = blockIdx.x * NTHR + threadIdx.x; i < 16 * 128 * 16; i += gridDim.x * NTHR) {
    const int d4 = (i & 15) * 4, v = (i >> 4) & 127, bh = i >> 11;
    f32x4 st = {0.f, 0.f, 0.f, 0.f};
#pragma unroll 8
    for (int c = 0; c < 64; ++c) {
      const size_t o = (((size_t)bh * 64 + c) * 128 + v) * 64 + d4;
      const f32x4 u = *(const f32x4*)(UT + o);
      const f32x4 a = *(const f32x4*)(dec + ((size_t)bh * 64 + c) * 64 + d4);
      u32x2 pk = {pack2(st[0], st[1]), pack2(st[2], st[3])};
      *(u32x2*)(ST + o) = pk;
      st[0] = a[0] * st[0] + u[0]; st[1] = a[1] * st[1] + u[1]; st[2] = a[2] * st[2] + u[2]; st[3] = a[3] * st[3] + u[3];
    }
  }
}

DI void phase_gla_c(const Params& p) {
  const int tid = opaque_tid(), lane = tid & 63, w = tid >> 6, r = lane & 31, h5 = lane >> 5;
  const u16* gq = (const u16*)(p.ws + OFF_GQ);
  const u16* gk = (const u16*)(p.ws + OFF_GK);
  const u16* gvT = (const u16*)(p.ws + OFF_GVT);
  const float* bc = (const float*)(p.ws + OFF_BC);
  const u16* ST = (const u16*)(p.ws + OFF_ST);
  const u16* sg = (const u16*)(p.ws + OFF_SG);
  u16* mix = (u16*)(p.ws + OFF_MIX);
  for (int task = blockIdx.x; task < 256; task += gridDim.x) {
    const int bh = task >> 4, c = (task & 15) * 4 + (w >> 1), ih = w & 1, b = bh >> 2, hd = bh & 3;
    const int tpos = c * 64 + ih * 32 + r;
    bf16x8 qt[4];
    {
      const u16* qp = gq + ((size_t)bh * S + tpos) * 64 + h5 * 8;
      const float* bp = bc + ((size_t)bh * S + tpos) * 64 + h5 * 8;
#pragma unroll
      for (int ks = 0; ks < 4; ++ks) {
        const u32x4 qq = *(const u32x4*)(qp + ks * 16);
        const f32x4 b0 = *(const f32x4*)(bp + ks * 16), b1 = *(const f32x4*)(bp + ks * 16 + 4);
        qt[ks] = __builtin_bit_cast(bf16x8, pack8(bflo(qq[0]) * __expf(b0[0]), bfhi(qq[0]) * __expf(b0[1]), bflo(qq[1]) * __expf(b0[2]), bfhi(qq[1]) * __expf(b0[3]),
                                                 bflo(qq[2]) * __expf(b1[0]), bfhi(qq[2]) * __expf(b1[1]), bflo(qq[3]) * __expf(b1[2]), bfhi(qq[3]) * __expf(b1[3])));
      }
    }
    f32x16 oacc[4];
#pragma unroll
    for (int vt = 0; vt < 4; ++vt)
#pragma unroll
      for (int i = 0; i < 16; ++i) oacc[vt][i] = 0.f;
#pragma unroll
    for (int jt = 0; jt < 2; ++jt) {
      if (jt <= ih) {
        f32x16 X;
#pragma unroll
        for (int i = 0; i < 16; ++i) X[i] = 0.f;
        const int jpos = c * 64 + jt * 32 + r;
        const u16* kp = gk + ((size_t)bh * S + jpos) * 64 + h5 * 8;
        const float* bp = bc + ((size_t)bh * S + jpos) * 64 + h5 * 8;
#pragma unroll
        for (int ks = 0; ks < 4; ++ks) {
          const u32x4 kk = *(const u32x4*)(kp + ks * 16);
          const f32x4 b0 = *(const f32x4*)(bp + ks * 16), b1 = *(const f32x4*)(bp + ks * 16 + 4);
          const u32x4 kt = pack8(bflo(kk[0]) * __expf(-b0[0]), bfhi(kk[0]) * __expf(-b0[1]), bflo(kk[1]) * __expf(-b0[2]), bfhi(kk[1]) * __expf(-b0[3]),
                                 bflo(kk[2]) * __expf(-b1[0]), bfhi(kk[2]) * __expf(-b1[1]), bflo(kk[3]) * __expf(-b1[2]), bfhi(kk[3]) * __expf(-b1[3]));
          X = MFMA32(__builtin_bit_cast(bf16x8, kt), qt[ks], X);
        }
        if (jt == ih) {
#pragma unroll
          for (int i = 0; i < 16; ++i) if (crow(i, h5) > r) X[i] = 0.f;
        }
        const bf16x8 pf0 = __builtin_bit_cast(bf16x8, pack8(X[0], X[1], X[2], X[3], X[4], X[5], X[6], X[7]));
        const bf16x8 pf1 = __builtin_bit_cast(bf16x8, pack8(X[8], X[9], X[10], X[11], X[12], X[13], X[14], X[15]));
#pragma unroll
        for (int vt = 0; vt < 4; ++vt) {
#pragma unroll
          for (int s2 = 0; s2 < 2; ++s2) {
            const u16* vp = gvT + ((size_t)bh * 128 + vt * 32 + r) * S + c * 64 + jt * 32 + 16 * s2 + 4 * h5;
            const u32x2 lo = *(const u32x2*)vp, hi = *(const u32x2*)(vp + 8);
            u32x4 vv = {lo[0], lo[1], hi[0], hi[1]};
            oacc[vt] = MFMA32(__builtin_bit_cast(bf16x8, vv), s2 ? pf1 : pf0, oacc[vt]);
          }
        }
      }
    }
    {
      const u16* sp = ST + (((size_t)bh * 64 + c) * 128 + r) * 64 + h5 * 8;
#pragma unroll
      for (int vt = 0; vt < 4; ++vt)
#pragma unroll
        for (int ks = 0; ks < 4; ++ks) oacc[vt] = MFMA32(*(const bf16x8*)(sp + (size_t)vt * 32 * 64 + ks * 16), qt[ks], oacc[vt]);
    }
    float ssq = 0.f;
#pragma unroll
    for (int vt = 0; vt < 4; ++vt)
#pragma unroll
      for (int i = 0; i < 16; ++i) ssq += oacc[vt][i] * oacc[vt][i];
    ssq += __shfl_xor(ssq, 32);
    const float rs = rsqrtf(ssq * (1.f / 128.f) + EPS);
    const size_t t = (size_t)b * S + tpos;
    const u16* sgp = sg + t * 512 + hd * 128;
    u16* op = mix + t * 1024 + 512 + hd * 128;
#pragma unroll
    for (int vt = 0; vt < 4; ++vt)
#pragma unroll
      for (int g4 = 0; g4 < 4; ++g4) {
        const int v0 = vt * 32 + 8 * g4 + 4 * h5;
        const f32x4 gw = *(const f32x4*)(p.gla_out_w + v0);
        const u32x2 sv = *(const u32x2*)(sgp + v0);
        const float o0 = oacc[vt][4 * g4 + 0] * rs * gw[0] * bflo(sv[0]);
        const float o1 = oacc[vt][4 * g4 + 1] * rs * gw[1] * bfhi(sv[0]);
        const float o2 = oacc[vt][4 * g4 + 2] * rs * gw[2] * bflo(sv[1]);
        const float o3 = oacc[vt][4 * g4 + 3] * rs * gw[3] * bfhi(sv[1]);
        u32x2 pk = {pack2(o0, o1), pack2(o2, o3)};
        *(u32x2*)(op + v0) = pk;
      }
  }
}

DI void phase6(const Params& p, char* smem) {
  const int tid = opaque_tid();
  const u16* mix = (const u16*)(p.ws + OFF_MIX);
  const u16* woutT = (const u16*)(p.ws + OFF_WOUTT);
  const float* mod = (const float*)(p.ws + OFF_MOD);
  u16* d1 = (u16*)(p.ws + OFF_D1);
  float* cs = (float*)smem;
  const int xg = blockIdx.x & 7, xj = blockIdx.x >> 3, xn = gridDim.x >> 3;
  for (int l = xj; l < 32; l += xn) {
    const int mtile = xg * 8 + (l & 7), ntile = l >> 3, row0 = mtile * 256, b = row0 >> 12;
    LoadBf16<4> al; LoadBf16<4> bl;
#pragma unroll
    for (int i = 0; i < 4; ++i) {
      al.rp[i] = mix + (size_t)(row0 + (tid >> 3) + 64 * i) * 1024 + src_chunk(tid);
      bl.rp[i] = woutT + (size_t)(ntile * 256 + (tid >> 3) + 64 * i) * 1024 + src_chunk(tid);
    }
    f32x16 acc[4][2];
    gemm_mainloop<4>(al, bl, 16, smem, acc);
    const int c8 = (tid & 31) * 8, col = ntile * 256 + c8;
    const f32x4 ga = *(const f32x4*)(mod + b * 6144 + 2048 + col), gb = *(const f32x4*)(mod + b * 6144 + 2048 + col + 4);
#pragma unroll 1
    for (int half = 0; half < 2; ++half) {
      __syncthreads();
      stage_nat<4>(cs, acc, half);
      __syncthreads();
#pragma unroll 2
      for (int it = 0; it < 8; ++it) {
        const int i = it * NTHR + tid, row = i >> 5;
        const f32x4 va = *(const f32x4*)(cs + row * 260 + c8), vb = *(const f32x4*)(cs + row * 260 + c8 + 4);
        *(u32x4*)(d1 + (size_t)(row0 + half * 128 + row) * 1024 + col) =
            pack8(va[0] * ga[0], va[1] * ga[1], va[2] * ga[2], va[3] * ga[3], vb[0] * gb[0], vb[1] * gb[1], vb[2] * gb[2], vb[3] * gb[3]);
      }
    }
  }
}

DI void phase7_rows(const Params& p) {
  const int tid = opaque_tid(), lane = tid & 63, w = tid >> 6;
  const u16* d1 = (const u16*)(p.ws + OFF_D1);
  const float* mod = (const float*)(p.ws + OFF_MOD);
  u16* h2b = (u16*)(p.ws + OFF_H2B);
  for (int task = blockIdx.x; task < 256; task += gridDim.x) {
    const int row0 = task * 64, b = row0 >> 12;
    {
#pragma unroll 1
      for (int rr0 = 0; rr0 < 8; rr0 += 4) {
        f32x4 xv[4][4]; float ssq[4];
#pragma unroll
        for (int q = 0; q < 4; ++q) {
          const size_t t = row0 + w * 8 + rr0 + q;
#pragma unroll
          for (int i = 0; i < 4; ++i) {
            const f32x4 xx = *(const f32x4*)(p.x + t * 1024 + i * 256 + lane * 4);
            const u32x2 dd = *(const u32x2*)(d1 + t * 1024 + i * 256 + lane * 4);
            xv[q][i][0] = xx[0] + bflo(dd[0]); xv[q][i][1] = xx[1] + bfhi(dd[0]); xv[q][i][2] = xx[2] + bflo(dd[1]); xv[q][i][3] = xx[3] + bfhi(dd[1]);
          }
        }
#pragma unroll
        for (int q = 0; q < 4; ++q) {
          float a = 0.f;
#pragma unroll
          for (int i = 0; i < 4; ++i) a += xv[q][i][0] * xv[q][i][0] + xv[q][i][1] * xv[q][i][1] + xv[q][i][2] * xv[q][i][2] + xv[q][i][3] * xv[q][i][3];
          ssq[q] = wave_sum(a);
        }
#pragma unroll
        for (int i = 0; i < 4; ++i) {
          const int k = i * 256 + lane * 4;
          const f32x4 nw = *(const f32x4*)(p.norm2_w + k);
          const f32x4 sc = *(const f32x4*)(mod + b * 6144 + 4096 + k);
          const f32x4 sh = *(const f32x4*)(mod + b * 6144 + 3072 + k);
#pragma unroll
          for (int q = 0; q < 4; ++q) {
            const size_t t = row0 + w * 8 + rr0 + q;
            const float rn = rsqrtf(ssq[q] * (1.f / 1024.f) + EPS);
            float o[4];
#pragma unroll
            for (int j = 0; j < 4; ++j) o[j] = xv[q][i][j] * rn * (nw[j] * (1.f + sc[j])) + sh[j];
            u32x2 pk = {pack2(o[0], o[1]), pack2(o[2], o[3])};
            *(u32x2*)(h2b + t * 1024 + k) = pk;
          }
        }
      }
    }
  }
}

DI void phase7(const Params& p, char* smem) {
  const int tid = opaque_tid(), lane = tid & 63, w = tid >> 6, wm = w >> 2, wn = w & 3, r = lane & 31, h5 = lane >> 5;
  const float NEG = -__builtin_inff();
  const u16* d1 = (const u16*)(p.ws + OFF_D1);
  const float* mod = (const float*)(p.ws + OFF_MOD);
  u16* h2b = (u16*)(p.ws + OFF_H2B);
  const u16* wrT = (const u16*)(p.ws + OFF_WRT);
  int* cnt = (int*)(p.ws + OFF_CNT);
  int* list = (int*)(p.ws + OFF_LIST);
  float* topw = (float*)(p.ws + OFF_TOPW);
  float* lg = (float*)smem;
  for (int task = blockIdx.x; task < 256; task += gridDim.x) {
    const int row0 = task * 64, b = row0 >> 12;
    asm volatile("s_waitcnt vmcnt(0)" ::: "memory");
    __syncthreads();
    LoadBf16<1> al; LoadBf16<4> bl;
    al.rp[0] = h2b + (size_t)(row0 + (tid >> 3)) * 1024 + src_chunk(tid);
#pragma unroll
    for (int i = 0; i < 4; ++i) bl.rp[i] = wrT + (size_t)((tid >> 3) + 64 * i) * 1024 + src_chunk(tid);
    f32x16 acc[1][2];
    gemm_mainloop<1>(al, bl, 16, smem, acc);
#pragma unroll
    for (int nt = 0; nt < 2; ++nt)
#pragma unroll
      for (int i = 0; i < 16; ++i) lg[(wm * 32 + crow(i, h5)) * 256 + wn * 64 + nt * 32 + r] = acc[0][nt][i];
    __syncthreads();
    int* lcnt = (int*)(smem + 65536);
    int* lbase = lcnt + 256;
    int* abuf = lbase + 256;
    if (tid < 256) lcnt[tid] = 0;
    __syncthreads();
    const f32x4 eb = *(const f32x4*)(p.e_bias + lane * 4);
    const int mygrp = lane >> 3;
#pragma unroll 1
    for (int rr0 = 0; rr0 < 8; rr0 += 4) {
      float sc[4][4], cand[4][4];
#pragma unroll
      for (int u = 0; u < 4; ++u) {
        const int row = w * 8 + rr0 + u;
        const f32x4 lv = *(const f32x4*)(lg + row * 256 + lane * 4);
        float ch[4];
#pragma unroll
        for (int q = 0; q < 4; ++q) { sc[u][q] = 1.f / (1.f + __expf(-lv[q])); ch[q] = sc[u][q] + eb[q]; }
        float m1 = fmaxf(ch[0], ch[1]), m2 = fminf(ch[0], ch[1]);
#pragma unroll
        for (int q = 2; q < 4; ++q) { const float v = ch[q]; m2 = fmaxf(m2, fminf(m1, v)); m1 = fmaxf(m1, v); }
#pragma unroll
        for (int sft = 1; sft < 8; sft <<= 1) {
          const float o1 = __shfl_xor(m1, sft), o2 = __shfl_xor(m2, sft);
          const float n1 = fmaxf(m1, o1); const float n2 = fmaxf(fminf(m1, o1), fmaxf(m2, o2));
          m1 = n1; m2 = n2;
        }
        const float gs = m1 + m2;
        int rank = 0;
#pragma unroll
        for (int q = 0; q < 8; ++q) { const float og = __shfl(gs, q * 8); rank += (og > gs || (og == gs && q < mygrp)) ? 1 : 0; }
        const bool allowed = rank < 4;
#pragma unroll
        for (int q = 0; q < 4; ++q) cand[u][q] = allowed ? ch[q] : NEG;
      }
      float wsel[4], wsum[4]; int esel[4];
#pragma unroll
      for (int u = 0; u < 4; ++u) { wsel[u] = 0.f; wsum[u] = 0.f; esel[u] = 0; }
#pragma unroll 1
      for (int k = 0; k < 8; ++k) {
#pragma unroll
        for (int u = 0; u < 4; ++u) {
          float bv = cand[u][0]; int bi = lane * 4;
#pragma unroll
          for (int q = 1; q < 4; ++q) if (cand[u][q] > bv) { bv = cand[u][q]; bi = lane * 4 + q; }
#pragma unroll
          for (int sft = 32; sft >= 1; sft >>= 1) {
            const float ov = __shfl_xor(bv, sft); const int oi = __shfl_xor(bi, sft);
            if (ov > bv || (ov == bv && oi < bi)) { bv = ov; bi = oi; }
          }
          float sv = 0.f;
          if ((bi >> 2) == lane) {
#pragma unroll
            for (int q = 0; q < 4; ++q) if ((bi & 3) == q) { sv = sc[u][q]; cand[u][q] = NEG; }
          }
          sv = __shfl(sv, bi >> 2);
          wsum[u] += sv;
          if (lane == k) { wsel[u] = sv; esel[u] = bi; }
        }
      }
      if (lane < 8) {
#pragma unroll
        for (int u = 0; u < 4; ++u) {
          const int rowl = w * 8 + rr0 + u;
          const int pl = atomicAdd(&lcnt[esel[u]], 1);
          abuf[rowl * 8 + lane] = esel[u] | (pl << 8);
          topw[(row0 + rowl) * 8 + lane] = wsel[u] / wsum[u] * 2.5f;
        }
      }
    }
    __syncthreads();
    if (tid < 256) { const int c = lcnt[tid]; lbase[tid] = (c > 0) ? atomicAdd(&cnt[tid * CNT_STRIDE], c) : 0; }
    __syncthreads();
    {
      const int en = abuf[tid], e = en & 255, pl = en >> 8;
      list[(size_t)e * LISTCAP + lbase[e] + pl] = (row0 + (tid >> 3)) * 8 + (tid & 7);
    }
  }
}

DI int perm_e(int o) { return (o & 31) * 8 + (o >> 5); }
DI void build_tables(const Params& p, int* tbl) {
  const int tid = opaque_tid();
  const int* cnt = (const int*)(p.ws + OFF_CNT);
  __syncthreads();
  if (tid < 256) tbl[520 + tid] = cnt[perm_e(tid) * CNT_STRIDE];
  __syncthreads();
  if (tid < 256) {
    int tp = 0, rp = 0;
    for (int o = 0; o < tid; ++o) { const int cc = tbl[520 + o]; tp += (cc + 255) >> 8; rp += cc; }
    tbl[tid] = tp; tbl[260 + tid] = rp;
    if (tid == 255) { const int cc = tbl[520 + 255]; tbl[256] = tp + ((cc + 255) >> 8); tbl[260 + 256] = rp + cc; }
  }
  __syncthreads();
}
DI int find_o(const int* tb, int g, int item) {
  int lo = 32 * g, hi = 32 * g + 31;
  while (lo < hi) { const int mid = (lo + hi + 1) >> 1; if (tb[mid] <= item) lo = mid; else hi = mid - 1; }
  return lo;
}
DI int queue_first(int* qc, volatile int* slot) {
  if (opaque_tid() == 0) *slot = atomicAdd(qc, 1);
  __syncthreads();
  const int v = *slot;
  __syncthreads();
  return v;
}

template <int MT>
DI void p8_tile(const Params& p, char* smem, int e, int rbeg, int cnt_e, int rowbase, int nchunk) {
  const int tid = opaque_tid(), lane = tid & 63, w = tid >> 6, wm = w >> 2, wn = w & 3, r = lane & 31, h5 = lane >> 5;
  const u16* h2b = (const u16*)(p.ws + OFF_H2B);
  const int* list = (const int*)(p.ws + OFF_LIST);
  LoadBf16<MT> al;
#pragma unroll
  for (int i = 0; i < MT; ++i) {
    const int rr = rbeg + (tid >> 3) + 64 * i;
    int tok = 0;
    if (rr < cnt_e) tok = (e < 256) ? (list[(size_t)e * LISTCAP + rr] >> 3) : rr;
    al.rp[i] = h2b + (size_t)tok * 1024 + src_chunk(tid);
  }
  f32x16 acc[MT][2];
  if (e < 256) {
    BLoadF32 bl;
    const int n4 = (tid & 63) * 4, kg = tid >> 6;
    const int twn = n4 >> 6, tnt = (n4 >> 5) & 1, jj = n4 & 31;
    const int col = nchunk * 128 + twn * 32 + jj;
    bl.ldb = 256; bl.p = (tnt ? p.w3 : p.w1) + (size_t)e * 1024 * 256 + (size_t)(kg * 8) * 256 + col;
    gemm_mainloop<MT>(al, bl, 16, smem, acc);
  } else {
    LoadBf16<4> bl;
    const u16* ws13T = (const u16*)(p.ws + OFF_WS13T);
#pragma unroll
    for (int i = 0; i < 4; ++i) bl.rp[i] = ws13T + (size_t)(nchunk * 256 + (tid >> 3) + 64 * i) * 1024 + src_chunk(tid);
    gemm_mainloop<MT>(al, bl, 16, smem, acc);
  }
  u16* actp = (e < 256) ? ((u16*)(p.ws + OFF_ACT) + (size_t)rowbase * 256) : (u16*)(p.ws + OFF_ACTS);
  float* cs = (float*)smem;
#pragma unroll 1
  for (int half = 0; half < (MT == 4 ? 2 : 1); ++half) {
    __syncthreads();
    if (MT == 2 || wm == half) {
      const int rb = (MT == 4) ? 0 : wm * 64;
#pragma unroll
      for (int mt = 0; mt < MT; ++mt)
#pragma unroll
        for (int i = 0; i < 16; ++i) cs[(rb + mt * 32 + crow(i, h5)) * 132 + wn * 32 + r] = siluf(acc[mt][0][i]) * acc[mt][1][i];
    }
    __syncthreads();
#pragma unroll 1
    for (int it = 0; it < 4; ++it) {
      const int i = it * NTHR + tid, row = i >> 4, c8 = (i & 15) * 8;
      const int rr = rbeg + half * 128 + row;
      if (rr < cnt_e) {
        const f32x4 va = *(const f32x4*)(cs + row * 132 + c8), vb = *(const f32x4*)(cs + row * 132 + c8 + 4);
        *(u32x4*)(actp + (size_t)rr * 256 + nchunk * 128 + c8) = pack8(va[0], va[1], va[2], va[3], vb[0], vb[1], vb[2], vb[3]);
      }
    }
  }
}

DI void phase8(const Params& p, char* smem) {
  const int g = blockIdx.x & 7;
  int* tbl = (int*)(smem + LDS_TBL);
  volatile int* slot = (volatile int*)(smem + LDS_TBL + 12256);
  int* qc = (int*)(p.ws + OFF_QC) + g * 32;
  build_tables(p, tbl);
  const int t0 = tbl[32 * g], ntl = tbl[32 * g + 32] - t0;
  const int ntask = ntl * 2 + 16;
  int id = queue_first(qc, slot);
  while (id < ntask) {
    int nxt = 0;
    if (opaque_tid() == 0) nxt = atomicAdd(qc, 1);
    if (id < ntl * 2) {
      const int item = t0 + (id >> 1), nchunk = id & 1;
      const int o = find_o(tbl, g, item);
      const int e = perm_e(o), rbeg = (item - tbl[o]) * 256, cnt_e = tbl[520 + o], rowbase = tbl[260 + o];
      if (cnt_e - rbeg > 128) p8_tile<4>(p, smem, e, rbeg, cnt_e, rowbase, nchunk);
      else                    p8_tile<2>(p, smem, e, rbeg, cnt_e, rowbase, nchunk);
    } else {
      const int sid = id - ntl * 2;
      p8_tile<4>(p, smem, 256, (8 * g + (sid >> 1)) * 256, T, 0, sid & 1);
    }
    __syncthreads();
    if (opaque_tid() == 0) *slot = nxt;
    __syncthreads();
    id = *slot;
    __syncthreads();
  }
}

struct P9Task { int e, rbeg, cnt_e, rowbase, ntile, mt; };
DI bool p9_decode(const int* tbl, int g, int t0, int ntask, int id, P9Task& t) {
  if (id >= ntask) return false;
  const int item = t0 + (id >> 2);
  const int o = find_o(tbl, g, item);
  t.ntile = id & 3; t.e = perm_e(o); t.rbeg = (item - tbl[o]) * 256; t.cnt_e = tbl[520 + o]; t.rowbase = tbl[260 + o];
  t.mt = (t.cnt_e - t.rbeg > 128) ? 4 : 2;
  return true;
}
DI void p9_setup(const Params& p, const P9Task& t, LoadBf16<4>& al, BLoadF32& bl, int& asg, int) {
  const int tid = opaque_tid();
  const u16* actp = (const u16*)(p.ws + OFF_ACT) + (size_t)t.rowbase * 256;
#pragma unroll
  for (int i = 0; i < 4; ++i) {
    int rr = t.rbeg + (tid >> 3) + 64 * i;
    if (rr >= t.cnt_e) rr = 0;
    al.rp[i] = actp + (size_t)rr * 256 + src_chunk(tid);
  }
  bl.ldb = 1024;
  bl.p = p.w2 + (size_t)t.e * 256 * 1024 + (size_t)((tid >> 6) * 8) * 1024 + t.ntile * 256 + (tid & 63) * 4;
  asg = -1;
  if (tid < 256 && t.rbeg + tid < t.cnt_e) asg = ((const int*)(p.ws + OFF_LIST))[(size_t)t.e * LISTCAP + t.rbeg + tid];
}
template <int MT, int VAR>
DI void p9_epilogue(const Params& p, char* smem, const P9Task& t, const f32x16 (&acc)[4][2], const int* rasg, int) {
  const int tid = opaque_tid();
  unsigned char* y = p.ws + (VAR ? OFF_Y2 : OFF_Y);
  if (VAR == 1 || VAR == 3) { asm volatile("" :: "v"(acc[0][0][0]), "v"(acc[1][1][5])); return; }
  const float* rwg = (const float*)(rasg + 256);
  float* cs = (float*)(smem + 65536);
#pragma unroll 1
  for (int q = 0; q < MT; ++q) {
    lds_barrier();
    stage_quarter<MT, 4>(cs, acc, q);
    lds_barrier();
#pragma unroll 1
    for (int it = 0; it < 4; ++it) {
      const int i = it * NTHR + tid, row = i >> 5, c8 = (i & 31) * 8;
      const int asg = rasg[q * 64 + row];
      if (asg >= 0) {
        const float wg = rwg[q * 64 + row];
        const f32x4 va = *(const f32x4*)(cs + row * 260 + c8), vb = *(const f32x4*)(cs + row * 260 + c8 + 4);
        const float ws = wg * Y_SCALE;
        int w0 = 0, w1 = 0;
        w0 = __builtin_amdgcn_cvt_pk_fp8_f32(va[0] * ws, va[1] * ws, w0, false); w0 = __builtin_amdgcn_cvt_pk_fp8_f32(va[2] * ws, va[3] * ws, w0, true);
        w1 = __builtin_amdgcn_cvt_pk_fp8_f32(vb[0] * ws, vb[1] * ws, w1, false); w1 = __builtin_amdgcn_cvt_pk_fp8_f32(vb[2] * ws, vb[3] * ws, w1, true);
        u32x2 pk = {(unsigned)w0, (unsigned)w1};
        *(u32x2*)(y + (size_t)asg * 1024 + t.ntile * 256 + c8) = pk;
      }
    }
  }
}

template <int VAR>
DI void phase9(const Params& p, char* smem) {
  const int g = blockIdx.x & 7, tid = opaque_tid();
  int* tbl = (int*)(smem + LDS_TBL);
  int* rasg = (int*)(smem + LDS_TBL + 4096);
  volatile int* slot = (volatile int*)(smem + LDS_TBL + 12256);
  int* qc = (int*)(p.ws + OFF_QC) + ((VAR ? 16 : 8) + g) * 32;
  const float* topw = (const float*)(p.ws + OFF_TOPW);
  build_tables(p, tbl);
  const int t0 = tbl[32 * g], ntl = tbl[32 * g + 32] - t0;
  const int ntask = ntl * 4;
  int id = queue_first(qc, slot);
  P9Task cur, nxt;
  LoadBf16<4> al; BLoadF32 bl;
  int asg = -1;
  bool have = p9_decode(tbl, g, t0, ntask, id, cur);
  if (have) { p9_setup(p, cur, al, bl, asg, tid); al.prefetch0(smem, tid); bl.prefetch0(smem + 32768, tid); }
  f32x16 acc[4][2];
  while (have) {
    int ticket = 0;
    if (tid == 0) ticket = atomicAdd(qc, 1);
    const float wg = (asg >= 0) ? topw[asg] : 0.f;
    if (cur.mt == 4) gemm_kloop_prefetched<4, 4, LoadBf16<4>, BLoadF32, (VAR == 2 || VAR == 3)>(al, bl, 4, smem, acc); else gemm_kloop_prefetched<2, 4, LoadBf16<4>, BLoadF32, (VAR == 2 || VAR == 3)>(al, bl, 4, smem, acc);
    if (tid < 256) { rasg[tid] = asg; ((float*)rasg)[256 + tid] = wg; }
    if (tid == 0) *slot = ticket;
    __syncthreads();
    id = *slot;
    const bool have2 = p9_decode(tbl, g, t0, ntask, id, nxt);
    if (have2) { p9_setup(p, nxt, al, bl, asg, tid); al.prefetch0(smem, tid); bl.prefetch0(smem + 32768, tid); }
    if (cur.mt == 4) p9_epilogue<4, VAR>(p, smem, cur, acc, rasg, tid); else p9_epilogue<2, VAR>(p, smem, cur, acc, rasg, tid);
    lds_barrier();
    cur = nxt; have = have2;
  }
}

DI void phase10(const Params& p, char* smem) {
  const u16* acts = (const u16*)(p.ws + OFF_ACTS);
  const u16* ws2T = (const u16*)(p.ws + OFF_WS2T);
  const unsigned char* y = p.ws + OFF_Y;
  const u16* d1 = (const u16*)(p.ws + OFF_D1);
  const float* mod = (const float*)(p.ws + OFF_MOD);
  float* cs = (float*)smem;
  const int xg = blockIdx.x & 7, xj = blockIdx.x >> 3, xn = gridDim.x >> 3;
  for (int l = xj; l < 32; l += xn) {
    const int mtile = xg * 8 + (l & 7), ntile = l >> 3, row0 = mtile * 256, b = row0 >> 12;
    LoadBf16<4> al; LoadBf16<4> bl;
    {
    const int tid = opaque_tid();
#pragma unroll
    for (int i = 0; i < 4; ++i) {
      al.rp[i] = acts + (size_t)(row0 + (tid >> 3) + 64 * i) * 256 + src_chunk(tid);
      bl.rp[i] = ws2T + (size_t)(ntile * 256 + (tid >> 3) + 64 * i) * 256 + src_chunk(tid);
    }
    }
    f32x16 acc[4][2];
    gemm_mainloop<4>(al, bl, 4, smem, acc);
    const int tid = opaque_tid();
#pragma unroll 1
    for (int half = 0; half < 2; ++half) {
      __syncthreads();
      stage_nat<4>(cs, acc, half);
      __syncthreads();
#pragma unroll 1
      for (int it = 0; it < 8; ++it) {
        const int i = it * NTHR + tid, row = i >> 5, c8 = (i & 31) * 8;
        const size_t t = row0 + half * 128 + row; const int col = ntile * 256 + c8;
        float v[8];
        {
          const f32x4 va = *(const f32x4*)(cs + row * 260 + c8), vb = *(const f32x4*)(cs + row * 260 + c8 + 4);
          v[0] = va[0]; v[1] = va[1]; v[2] = va[2]; v[3] = va[3]; v[4] = vb[0]; v[5] = vb[1]; v[6] = vb[2]; v[7] = vb[3];
        }
        {
          float ys[8];
#pragma unroll
          for (int q = 0; q < 8; ++q) ys[q] = 0.f;
#pragma unroll
          for (int k = 0; k < 8; ++k) {
            const u32x2 yy = *(const u32x2*)(y + (t * 8 + k) * 1024 + col);
            const f32x2_t a = __builtin_amdgcn_cvt_pk_f32_fp8((int)yy[0], false), bq = __builtin_amdgcn_cvt_pk_f32_fp8((int)yy[0], true);
            const f32x2_t c = __builtin_amdgcn_cvt_pk_f32_fp8((int)yy[1], false), d = __builtin_amdgcn_cvt_pk_f32_fp8((int)yy[1], true);
            ys[0] += a[0]; ys[1] += a[1]; ys[2] += bq[0]; ys[3] += bq[1]; ys[4] += c[0]; ys[5] += c[1]; ys[6] += d[0]; ys[7] += d[1];
          }
#pragma unroll
          for (int q = 0; q < 8; ++q) v[q] += ys[q] * (1.f / Y_SCALE);
        }
        const f32x4 g2a = *(const f32x4*)(mod + b * 6144 + 5120 + col), g2b = *(const f32x4*)(mod + b * 6144 + 5120 + col + 4);
        f32x4 xa = *(const f32x4*)(p.x + t * 1024 + col), xb = *(const f32x4*)(p.x + t * 1024 + col + 4);
        {
          const u32x4 dd = *(const u32x4*)(d1 + t * 1024 + col);
          xa[0] += bflo(dd[0]); xa[1] += bfhi(dd[0]); xa[2] += bflo(dd[1]); xa[3] += bfhi(dd[1]);
          xb[0] += bflo(dd[2]); xb[1] += bfhi(dd[2]); xb[2] += bflo(dd[3]); xb[3] += bfhi(dd[3]);
        }
        f32x4 oa = {xa[0] + g2a[0] * v[0], xa[1] + g2a[1] * v[1], xa[2] + g2a[2] * v[2], xa[3] + g2a[3] * v[3]};
        f32x4 ob = {xb[0] + g2b[0] * v[4], xb[1] + g2b[1] * v[5], xb[2] + g2b[2] * v[6], xb[3] + g2b[3] * v[7]};
        *(f32x4*)(p.out + t * 1024 + col) = oa;
        *(f32x4*)(p.out + t * 1024 + col + 4) = ob;
      }
    }
  }
}

#define XB_TMO      128
#define XB_XCNT(j)  (256  + 64 * (j))
#define XB_XSUB(j)  (1280 + 64 * (j))
#define XB_XGEN(j)  (2304 + 64 * (j))
#define XB_TOP      3328
#define XB_TOPGEN   3392
#define XCD_BAR_WORDS 3456
#define XB_SPIN_CAP (1u << 22)
#define LAS __attribute__((address_space(3)))
DI unsigned xb_ld(unsigned* p)              { return __hip_atomic_load(p, __ATOMIC_RELAXED, __HIP_MEMORY_SCOPE_AGENT); }
DI unsigned xb_add(unsigned* p, unsigned v) { return __hip_atomic_fetch_add(p, v, __ATOMIC_RELAXED, __HIP_MEMORY_SCOPE_AGENT); }
DI unsigned xb_xcc_id() { return (unsigned)__builtin_amdgcn_s_getreg((3 << 11) | 20) & 0xFu; }
#define XB_SPIN(cond, bar) do { unsigned _sp = 0; while (cond) { __builtin_amdgcn_s_sleep(1); \
    if ((++_sp & 255u) == 0u) { if (xb_ld(&(bar)[XB_TMO])) break; if (_sp > XB_SPIN_CAP) { atomicAdd(&(bar)[XB_TMO], 1u); break; } } } } while (0)
struct XcdBarrier { unsigned* bar; unsigned x; volatile LAS unsigned* st; };
DI XcdBarrier xcd_barrier_post(unsigned* bar, volatile LAS unsigned* st) {
  XcdBarrier b; b.bar = bar; b.x = xb_xcc_id(); b.st = st;
  if (threadIdx.x == 0) (void)xb_add(&bar[XB_XCNT(b.x)], 1u);
  return b;
}
DI void xcd_barrier_complete(unsigned* bar, unsigned x, unsigned& nloc, unsigned& nx) {
  const unsigned G = gridDim.x * gridDim.y * gridDim.z;
  unsigned sum, cnt, mine, sp = 0u;
  for (;;) {
    sum = 0u; cnt = 0u; mine = 0u;
#pragma unroll
    for (unsigned j = 0; j < 16; ++j) { const unsigned c = xb_ld(&bar[XB_XCNT(j)]); sum += c; cnt += (c > 0u) ? 1u : 0u; mine = (j == x) ? c : mine; }
    if (sum == G) break;
    __builtin_amdgcn_s_sleep(1);
    if ((++sp & 255u) == 0u) { if (xb_ld(&bar[XB_TMO])) break; if (sp > XB_SPIN_CAP) { atomicAdd(&bar[XB_TMO], 1u); break; } }
  }
  nloc = mine > 0u ? mine : 1u; nx = cnt > 0u ? cnt : 1u;
}
DI void xcd_barrier(const XcdBarrier& b) {
  asm volatile("s_waitcnt vmcnt(0)" ::: "memory");
  __syncthreads();
  if (threadIdx.x == 0) {
    unsigned* bar = b.bar;
    __builtin_amdgcn_s_waitcnt(0);
    unsigned nloc = b.st[0], nx = b.st[1];
    if (nloc == 0u) { xcd_barrier_complete(bar, b.x, nloc, nx); b.st[0] = nloc; b.st[1] = nx; }
    const unsigned old = xb_add(&bar[XB_XSUB(b.x)], 1u);
    const unsigned gen = old / nloc;
    if (old + 1u == (gen + 1u) * nloc) {
      __builtin_amdgcn_fence(__ATOMIC_RELEASE, "agent");
      asm volatile("s_waitcnt vmcnt(0)" ::: "memory");
      const unsigned og = xb_add(&bar[XB_TOP], 1u);
      const unsigned tg = og / nx;
      if (og + 1u == (tg + 1u) * nx) xb_add(&bar[XB_TOPGEN], 1u);
      else XB_SPIN(xb_ld(&bar[XB_TOPGEN]) == tg, bar);
      __builtin_amdgcn_fence(__ATOMIC_ACQUIRE, "agent");
      xb_add(&bar[XB_XGEN(b.x)], 1u);
      asm volatile("s_waitcnt vmcnt(0)" ::: "memory");
    } else {
      XB_SPIN(xb_ld(&bar[XB_XGEN(b.x)]) == gen, bar);
      __builtin_amdgcn_fence(__ATOMIC_ACQUIRE, "agent");
      asm volatile("s_waitcnt vmcnt(0)" ::: "memory");
    }
  }
  __syncthreads();
}


#if !FUSED
#define PHASE_KERNEL(name, body)                                                 \
  __global__ void __launch_bounds__(NTHR, 2) name(Params p) {                    \
    __shared__ __attribute__((aligned(16))) char smem[LDS_BYTES];                \
    body;                                                                        \
  }
PHASE_KERNEL(k_p0, phase0(p, smem))
PHASE_KERNEL(k_p1, phase1(p); (void)smem)
PHASE_KERNEL(k_p2, phase2(p, smem); phase2_ga(p, smem))
PHASE_KERNEL(k_p3, phase_moba<0>(p, smem, 0, 512, (u16*)(p.ws + OFF_MIX)); phase_gla_a(p))
PHASE_KERNEL(k_p4, phase_gla_b(p); (void)smem)
PHASE_KERNEL(k_p5, phase_gla_c(p); (void)smem)
PHASE_KERNEL(k_p6, phase6(p, smem))
PHASE_KERNEL(k_p7, phase7_rows(p); phase7(p, smem))
PHASE_KERNEL(k_p8, phase8(p, smem))
PHASE_KERNEL(k_p9, phase9<0>(p, smem))
PHASE_KERNEL(k_p10, phase10(p, smem))
#else
__global__ void __launch_bounds__(NTHR, 2) k_fused(Params p) {
  __shared__ __attribute__((aligned(16))) char smem[LDS_BYTES];
  volatile LAS unsigned* st = (volatile LAS unsigned*)(smem + LDS_BYTES - 16);
  if (threadIdx.x == 0) { st[0] = 0u; st[1] = 0u; st[2] = 0u; st[3] = 0u; }
  __syncthreads();
  (void)xcd_barrier_post((unsigned*)(p.ws + OFF_BAR), st);
#define GRID_BARRIER() do { XcdBarrier xb_; xb_.bar = (unsigned*)(p.ws + OFF_BAR); xb_.x = xb_xcc_id(); xb_.st = (volatile LAS unsigned*)(smem + LDS_BYTES - 16); xcd_barrier(xb_); } while (0)
#if TPROBE
  unsigned long long tp_prev = __builtin_amdgcn_s_memrealtime(), tp_extra = 0;
#define PHASE_END(bit) do { GRID_BARRIER(); const unsigned long long tn_ = __builtin_amdgcn_s_memrealtime(); if ((TPROBE >> (bit)) & 1) tp_extra += tn_ - tp_prev; tp_prev = tn_; } while (0)
#else
#define PHASE_END(bit) GRID_BARRIER()
#endif
  phase0(p, smem);                                    PHASE_END(0);
  phase1(p);                                          PHASE_END(1);
  phase2(p, smem); phase2_ga(p, smem);                PHASE_END(2);
#if TPROBE
  phase_moba<0>(p, smem, 0, 512, (u16*)(p.ws + OFF_MIX));                        PHASE_END(11);
#ifdef MOBA_VAR
  phase_moba<MOBA_VAR>(p, smem, 0, 512, (u16*)(p.ws + OFF_Y));   PHASE_END(12);
#endif
  phase_gla_a(p);                                     PHASE_END(3);
#else
  phase_moba<0>(p, smem, 0, 512, (u16*)(p.ws + OFF_MIX)); phase_gla_a(p);        PHASE_END(3);
#endif
  phase_gla_b(p);                                     PHASE_END(4);
  phase_gla_c(p);                                     PHASE_END(5);
  phase6(p, smem);                                    PHASE_END(6);
  phase7_rows(p); phase7(p, smem);                    PHASE_END(7);
  phase8(p, smem);                                    PHASE_END(8);
  phase9<0>(p, smem);                                 PHASE_END(9);
#ifdef P9_VAR
  phase9<P9_VAR>(p, smem);                            PHASE_END(12);
#endif
  phase10(p, smem);
#if TPROBE
  {
    __syncthreads();
    unsigned long long tn_ = __builtin_amdgcn_s_memrealtime();
    if ((TPROBE >> 10) & 1) tp_extra += tn_ - tp_prev;
    while (__builtin_amdgcn_s_memrealtime() - tn_ < tp_extra) __builtin_amdgcn_s_sleep(8);
  }
#endif
}
#endif

extern "C" void kernel_launch(void* const* d_in, const int* in_sizes, int n_in, void* d_out, int out_size, void* d_ws, size_t ws_size,
                              hipStream_t stream) {
  if (n_in != 23 || out_size != T * D || ws_size < WS_END) {
    fprintf(stderr, "kernel_launch: unexpected problem (n_in %d, out %d, ws %zu, need %zu)\n", n_in, out_size, ws_size, (size_t)WS_END);
    return;
  }
  Params p{};
  const float** f = (const float**)&p;
  for (int i = 0; i < 23; ++i) f[i] = (const float*)d_in[i];
  p.out = (float*)d_out;
  p.ws = (unsigned char*)d_ws;
  (void)hipMemsetAsync(d_ws, 0, ZERO_BYTES, stream);
#if !FUSED
  const dim3 grid(256), blk(NTHR);
  hipLaunchKernelGGL(k_p0, grid, blk, 0, stream, p);
  hipLaunchKernelGGL(k_p1, grid, blk, 0, stream, p);
  hipLaunchKernelGGL(k_p2, grid, blk, 0, stream, p);
  hipLaunchKernelGGL(k_p3, grid, blk, 0, stream, p);
  hipLaunchKernelGGL(k_p4, grid, blk, 0, stream, p);
  hipLaunchKernelGGL(k_p5, grid, blk, 0, stream, p);
  hipLaunchKernelGGL(k_p6, grid, blk, 0, stream, p);
  hipLaunchKernelGGL(k_p7, grid, blk, 0, stream, p);
  hipLaunchKernelGGL(k_p8, grid, blk, 0, stream, p);
  hipLaunchKernelGGL(k_p9, grid, blk, 0, stream, p);
  hipLaunchKernelGGL(k_p10, grid, blk, 0, stream, p);
#else
  static int grid_blocks = 0;
  if (!grid_blocks) {
    int dev = 0, cus = 0, per_cu = 0;
    (void)hipGetDevice(&dev);
    (void)hipDeviceGetAttribute(&cus, hipDeviceAttributeMultiprocessorCount, dev);
    (void)hipOccupancyMaxActiveBlocksPerMultiprocessor(&per_cu, k_fused, NTHR, 0);
    if (per_cu < 1) fprintf(stderr, "kernel_launch: occupancy query reports %d blocks per CU\n", per_cu);
    grid_blocks = cus;
    grid_blocks -= grid_blocks % 8;
  }
  hipLaunchKernelGGL(k_fused, dim3(grid_blocks), dim3(NTHR), 0, stream, p);
#endif
}
```

```cpp
#include <hip/hip_runtime.h>
#include <stdint.h>
#include <stdio.h>

#ifndef FUSED
#define FUSED 1
#endif
#ifndef TPROBE
#define TPROBE 0
#endif

#define DI __device__ __forceinline__
typedef short bf16x8 __attribute__((ext_vector_type(8)));
typedef float f32x16 __attribute__((ext_vector_type(16)));
typedef float f32x4 __attribute__((ext_vector_type(4)));
typedef unsigned u32x4 __attribute__((ext_vector_type(4)));
typedef unsigned u32x2 __attribute__((ext_vector_type(2)));
typedef __bf16 bf16x2_t __attribute__((ext_vector_type(2)));
typedef float f32x2_t __attribute__((ext_vector_type(2)));
typedef unsigned short u16;

#define MFMA32(a, b, c) __builtin_amdgcn_mfma_f32_32x32x16_bf16((a), (b), (c), 0, 0, 0)

constexpr int Bn = 4, S = 4096, D = 1024, T = Bn * S;
constexpr int DIN = 3088;
constexpr int NE = 256;
constexpr float EPS = 1e-6f;
constexpr float LOG2E = 1.4426950408889634f;
constexpr int LISTCAP = 16384;
constexpr float Y_SCALE = 32.f;
constexpr int NTHR = 512;

constexpr size_t al256(size_t x) { return (x + 255) & ~(size_t)255; }
constexpr size_t OFF_BAR   = 0;
constexpr size_t OFF_CNT   = 16384;
constexpr int CNT_STRIDE = 32;
constexpr size_t OFF_QC    = 16384 + 256 * 128;
constexpr size_t ZERO_BYTES = OFF_QC + 32 * 128;
constexpr size_t OFF_KMEAN = ZERO_BYTES;
constexpr size_t OFF_MOD   = al256(OFF_KMEAN + 4 * 8 * 16 * 64 * 4);
constexpr size_t OFF_WRT   = al256(OFF_MOD + 4 * 6144 * 4);
constexpr size_t OFF_WINT  = al256(OFF_WRT + 256 * 1024 * 2);
constexpr size_t OFF_WOUTT = al256(OFF_WINT + (size_t)3088 * 1024 * 2);
constexpr size_t OFF_WS13T = al256(OFF_WOUTT + (size_t)1024 * 1024 * 2);
constexpr size_t OFF_WS2T  = al256(OFF_WS13T + (size_t)512 * 1024 * 2);
constexpr size_t OFF_H1B   = al256(OFF_WS2T + (size_t)1024 * 256 * 2);
constexpr size_t OFF_MQ    = al256(OFF_H1B + (size_t)T * 1024 * 2);
constexpr size_t OFF_MK    = al256(OFF_MQ + (size_t)T * 512 * 2);
constexpr size_t OFF_VT    = al256(OFF_MK + (size_t)T * 512 * 2);
constexpr size_t OFF_GQ    = al256(OFF_VT + (size_t)T * 512 * 2);
constexpr size_t OFF_GK    = al256(OFF_GQ + (size_t)T * 256 * 2);
constexpr size_t OFF_GKT   = al256(OFF_GK + (size_t)T * 256 * 2);
constexpr size_t OFF_GVT   = al256(OFF_GKT + (size_t)T * 256 * 2);
constexpr size_t OFF_SG    = al256(OFF_GVT + (size_t)T * 512 * 2);
constexpr size_t OFF_BC    = al256(OFF_SG + (size_t)T * 512 * 2);
constexpr size_t OFF_BCT   = al256(OFF_BC + (size_t)T * 256 * 4);
constexpr size_t OFF_UT    = al256(OFF_BCT + (size_t)T * 256 * 4);
constexpr size_t OFF_DEC   = al256(OFF_UT + (size_t)16 * 64 * 128 * 64 * 4);
constexpr size_t OFF_ST    = al256(OFF_DEC + (size_t)16 * 64 * 64 * 4);
constexpr size_t OFF_MIX   = al256(OFF_ST + (size_t)16 * 64 * 128 * 64 * 2);
constexpr size_t OFF_D1    = al256(OFF_MIX + (size_t)T * 1024 * 2);
constexpr size_t OFF_H2B   = al256(OFF_D1 + (size_t)T * 1024 * 2);
constexpr size_t OFF_LIST  = al256(OFF_H2B + (size_t)T * 1024 * 2);
constexpr size_t OFF_TOPW  = al256(OFF_LIST + (size_t)256 * LISTCAP * 4);
constexpr size_t OFF_ACT   = al256(OFF_TOPW + (size_t)T * 8 * 4);
constexpr size_t OFF_ACTS  = al256(OFF_ACT + (size_t)T * 8 * 256 * 2);
constexpr size_t OFF_Y     = al256(OFF_ACTS + (size_t)T * 256 * 2);
constexpr size_t OFF_Y2    = al256(OFF_Y + (size_t)T * 8 * 1024);
constexpr size_t WS_END    = al256(OFF_Y2 + (size_t)T * 8 * 1024);

constexpr int LDS_C = 256 * 132 * 4;
constexpr int LDS_TBL = LDS_C;
constexpr int LDS_BYTES = LDS_C + 12288;

struct Params {
  const float *x, *c, *w_ada, *b_ada, *norm1_w, *norm2_w, *w_in, *q_norm_w, *k_norm_w, *rel_bias, *w_alpha, *b_alpha,
      *moba_out_w, *gla_out_w, *w_out, *w_router, *e_bias, *w1, *w3, *w2, *ws1, *ws3, *ws2;
  float* out;
  unsigned char* ws;
};

DI unsigned pack2(float a, float b) { f32x2_t v = {a, b}; return __builtin_bit_cast(unsigned, __builtin_convertvector(v, bf16x2_t)); }
DI float bflo(unsigned u) { return __uint_as_float(u << 16); }
DI float bfhi(unsigned u) { return __uint_as_float(u & 0xffff0000u); }
DI int opaque_tid() { int t = threadIdx.x; asm volatile("" : "+v"(t)); return t; }
DI int crow(int reg, int h) { return (reg & 3) + 8 * (reg >> 2) + 4 * h; }
DI int swz(int row) { return ((row >> 2) ^ (row >> 1)) & 7; }
DI u32x4 pack8(float a0, float a1, float a2, float a3, float a4, float a5, float a6, float a7) {
  u32x4 r; r[0] = pack2(a0, a1); r[1] = pack2(a2, a3); r[2] = pack2(a4, a5); r[3] = pack2(a6, a7); return r;
}
DI float wave_sum(float v) {
  v += __shfl_xor(v, 32); v += __shfl_xor(v, 16); v += __shfl_xor(v, 8); v += __shfl_xor(v, 4); v += __shfl_xor(v, 2); v += __shfl_xor(v, 1);
  return v;
}
DI float siluf(float x) { return x / (1.f + __expf(-x)); }
DI float max3f_mfma(float a, float b, float c) { float d; asm volatile("s_nop 15\n\tv_max3_f32 %0, %1, %2, %3" : "=v"(d) : "v"(a), "v"(b), "v"(c)); return d; }
DI float max3f(float a, float b, float c) { float d; asm("v_max3_f32 %0, %1, %2, %3" : "=v"(d) : "v"(a), "v"(b), "v"(c)); return d; }

typedef __attribute__((address_space(3))) void* lds_ptr_t;
typedef const __attribute__((address_space(1))) void* glb_ptr_t;
template <int NR>
struct LoadBf16 {
  const u16* rp[NR];
  DI void issue(int kt, char* sX, int tid) {
#pragma unroll
    for (int i = 0; i < NR; ++i)
      __builtin_amdgcn_global_load_lds((glb_ptr_t)(rp[i] + kt * 64), (lds_ptr_t)(sX + i * 8192 + tid * 16), 16, 0, 0);
  }
  DI void prefetch0(char* s0, int tid) { issue(0, s0, tid); }
  DI void finish0(char*, int, int) {}
  DI void prologue(char* s0, int nk, int tid) { issue(0, s0, tid); }
  DI void pre(int kt, int nk, char* nxt, int tid) { if (kt + 1 < nk) issue(kt + 1, nxt, tid); }
  DI void pre_commit(int, int, char*, int) {}
  DI void pre_dma(int kt, int nk, char* nxt, int tid) { if (kt + 1 < nk) issue(kt + 1, nxt, tid); }
  static constexpr int kRegLoads = 0;
  DI bool pre_regs(int, int) { return false; }
};
DI int src_chunk(int tid) { return ((tid & 7) ^ swz(tid >> 3)) * 8; }

#define WAIT_VMCNT(n) do { if ((n) == 0) asm volatile("s_waitcnt vmcnt(0)" ::: "memory"); else if ((n) == 1) asm volatile("s_waitcnt vmcnt(1)" ::: "memory"); \
    else if ((n) == 2) asm volatile("s_waitcnt vmcnt(2)" ::: "memory"); else if ((n) == 4) asm volatile("s_waitcnt vmcnt(4)" ::: "memory"); \
    else if ((n) == 5) asm volatile("s_waitcnt vmcnt(5)" ::: "memory"); else if ((n) == 8) asm volatile("s_waitcnt vmcnt(8)" ::: "memory"); \
    else if ((n) == 9) asm volatile("s_waitcnt vmcnt(9)" ::: "memory"); else if ((n) == 12) asm volatile("s_waitcnt vmcnt(12)" ::: "memory"); \
    else if ((n) == 16) asm volatile("s_waitcnt vmcnt(16)" ::: "memory"); else asm volatile("s_waitcnt vmcnt(0)" ::: "memory"); } while (0)

template <int NR>
struct LoadBf16Reg {
  const u16* rp[NR];
  u32x4 v[NR];
  static constexpr int kRegLoads = NR;
  DI void issue(int kt) {
#pragma unroll
    for (int i = 0; i < NR; ++i) v[i] = *(const u32x4*)(rp[i] + kt * 64);
  }
  DI void commit(char* sX, int tid) {
    const int c = tid & 7, row = tid >> 3;
    const int off = ((c ^ swz(row)) << 4);
#pragma unroll
    for (int i = 0; i < NR; ++i) *(u32x4*)(sX + (row + 64 * i) * 128 + off) = v[i];
  }
  DI void prefetch0(char*, int) { issue(0); }
  DI void finish0(char* s0, int nk, int tid) { commit(s0, tid); if (nk > 1) issue(1); }
  DI void prologue(char* s0, int nk, int tid) { issue(0); commit(s0, tid); if (nk > 1) issue(1); }
  DI void pre_commit(int kt, int nk, char* nxt, int tid) { if (kt + 1 < nk) commit(nxt, tid); }
  DI void pre_dma(int, int, char*, int) {}
  DI bool pre_regs(int kt, int nk) { if (kt + 2 < nk) { issue(kt + 2); return true; } return false; }
};

struct BLoadF32 {
  const float* p;
  size_t ldb;
  f32x4 v[8];
  DI void issue(int kt) {
    const float* q = p + (size_t)kt * 64 * ldb;
#pragma unroll
    for (int i = 0; i < 8; ++i) v[i] = *(const f32x4*)(q + (size_t)i * ldb);
  }
  DI void commit(char* sB, int tid) {
    const int n4 = (tid & 63) * 4, kg = tid >> 6;
#pragma unroll
    for (int j = 0; j < 4; ++j) {
      const int n = n4 + j;
      u32x4 w = pack8(v[0][j], v[1][j], v[2][j], v[3][j], v[4][j], v[5][j], v[6][j], v[7][j]);
      *(u32x4*)(sB + n * 128 + ((kg ^ swz(n)) << 4)) = w;
    }
  }
  DI void prefetch0(char*, int) { issue(0); }
  DI void finish0(char* s0, int nk, int tid) { commit(s0, tid); if (nk > 1) issue(1); }
  DI void prologue(char* s0, int nk, int tid) { issue(0); commit(s0, tid); if (nk > 1) issue(1); }
  DI void pre(int kt, int nk, char* nxt, int tid) {
    if (kt + 1 < nk) { commit(nxt, tid); if (kt + 2 < nk) issue(kt + 2); }
  }
  DI void pre_commit(int kt, int nk, char* nxt, int tid) { if (kt + 1 < nk) commit(nxt, tid); }
  DI void pre_dma(int, int, char*, int) {}
  static constexpr int kRegLoads = 8;
  DI bool pre_regs(int kt, int nk) { if (kt + 2 < nk) { issue(kt + 2); return true; } return false; }
};

template <int MT, int MA, bool SWAP = false>
DI void mma_step(const char* sA, const char* sB, f32x16 (&acc)[MA][2], int lane, int wm, int wn) {
  const int r = lane & 31, h = lane >> 5, f = swz(r);
  const char* a0 = sA + (wm * (MT * 32) + r) * 128;
  const char* b0 = sB + (wn * 64 + r) * 128;
  bf16x8 fa[2][MT], fb[2][2];
  {
    const int off = ((h ^ f) << 4);
    fb[0][0] = *(const bf16x8*)(b0 + off); fb[0][1] = *(const bf16x8*)(b0 + 32 * 128 + off);
#pragma unroll
    for (int mt = 0; mt < MT; ++mt) fa[0][mt] = *(const bf16x8*)(a0 + mt * 32 * 128 + off);
  }
#pragma unroll
  for (int kk = 0; kk < 4; ++kk) {
    const int cb = kk & 1, nb = cb ^ 1;
    if (kk < 3) {
      const int off = ((((kk + 1) * 2 + h) ^ f) << 4);
      fb[nb][0] = *(const bf16x8*)(b0 + off); fb[nb][1] = *(const bf16x8*)(b0 + 32 * 128 + off);
#pragma unroll
      for (int mt = 0; mt < MT; ++mt) fa[nb][mt] = *(const bf16x8*)(a0 + mt * 32 * 128 + off);
    }
#pragma unroll
    for (int mt = 0; mt < MT; ++mt) {
      if (SWAP) {
        acc[mt][0] = MFMA32(fb[cb][0], fa[cb][mt], acc[mt][0]);
        acc[mt][1] = MFMA32(fb[cb][1], fa[cb][mt], acc[mt][1]);
      } else {
        acc[mt][0] = MFMA32(fa[cb][mt], fb[cb][0], acc[mt][0]);
        acc[mt][1] = MFMA32(fa[cb][mt], fb[cb][1], acc[mt][1]);
      }
    }
  }
}

template <class AL, class BL, class F>
DI void kstep_loads(AL& al, BL& bl, int kt, int nk, char* nxt, int tid, F&& compute) {
  al.pre_commit(kt, nk, nxt, tid); bl.pre_commit(kt, nk, nxt + 32768, tid);
  al.pre_dma(kt, nk, nxt, tid);    bl.pre_dma(kt, nk, nxt + 32768, tid);
  const bool ra = al.pre_regs(kt, nk), rb = bl.pre_regs(kt, nk);
  compute();
  constexpr int nreg = AL::kRegLoads + BL::kRegLoads;
  if ((ra || rb) && nreg > 0) WAIT_VMCNT(nreg); else WAIT_VMCNT(0);
  asm volatile("s_waitcnt lgkmcnt(0)" ::: "memory");
  __builtin_amdgcn_s_barrier();
}

template <class AL, class BL>
DI void tile_start_wait(int nk) {
  constexpr int nreg = AL::kRegLoads + BL::kRegLoads;
  if (nreg > 0 && nk > 1) WAIT_VMCNT(nreg); else WAIT_VMCNT(0);
  asm volatile("s_waitcnt lgkmcnt(0)" ::: "memory");
  __builtin_amdgcn_s_barrier();
}

template <int MT, class AL, class BL, bool NOMMA = false>
DI void gemm_mainloop(AL& al, BL& bl, int nk, char* smem, f32x16 (&acc)[MT][2]) {
  const int tid = opaque_tid(), lane = tid & 63, w = tid >> 6, wm = w >> 2, wn = w & 3;
#pragma unroll
  for (int i = 0; i < MT; ++i)
#pragma unroll
    for (int j = 0; j < 2; ++j)
#pragma unroll
      for (int r = 0; r < 16; ++r) acc[i][j][r] = 0.f;
  __syncthreads();
  al.prefetch0(smem, tid); bl.prefetch0(smem + 32768, tid);
  al.finish0(smem, nk, tid); bl.finish0(smem + 32768, nk, tid);
  tile_start_wait<AL, BL>(nk);
  for (int kt = 0; kt < nk; ++kt) {
    const int cur = kt & 1;
    char* nxt = smem + (cur ^ 1) * 65536;
    kstep_loads(al, bl, kt, nk, nxt, tid, [&]() { if (!NOMMA) mma_step<MT, MT>(smem + cur * 65536, smem + cur * 65536 + 32768, acc, lane, wm, wn); });
  }
}

template <int MT, int MA, class AL, class BL, bool NOMMA = false, bool SWAP = false>
DI void gemm_kloop_prefetched(AL& al, BL& bl, int nk, char* smem, f32x16 (&acc)[MA][2]) {
  const int tid = opaque_tid(), lane = tid & 63, w = tid >> 6, wm = w >> 2, wn = w & 3;
#pragma unroll
  for (int i = 0; i < MT; ++i)
#pragma unroll
    for (int j = 0; j < 2; ++j)
#pragma unroll
      for (int r = 0; r < 16; ++r) acc[i][j][r] = 0.f;
  al.finish0(smem, nk, tid); bl.finish0(smem + 32768, nk, tid);
  tile_start_wait<AL, BL>(nk);
  for (int kt = 0; kt < nk; ++kt) {
    const int cur = kt & 1;
    char* nxt = smem + (cur ^ 1) * 65536;
    kstep_loads(al, bl, kt, nk, nxt, tid, [&]() { if (!NOMMA) mma_step<MT, MA, SWAP>(smem + cur * 65536, smem + cur * 65536 + 32768, acc, lane, wm, wn); });
  }
}
DI void lds_barrier() { asm volatile("s_waitcnt lgkmcnt(0)" ::: "memory"); __builtin_amdgcn_s_barrier(); }
template <int MT, int MA>
DI void stage_quarter(float* cs, const f32x16 (&acc)[MA][2], int q) {
  const int tid_ = opaque_tid(); const int lane = tid_ & 63, w = tid_ >> 6, wm = w >> 2, wn = w & 3, r = lane & 31, h = lane >> 5;
  if (MT == 4) {
    if (wm != (q >> 1)) return;
#pragma unroll
    for (int mt = 0; mt < 4; ++mt) {
      if ((mt >> 1) == (q & 1)) {
#pragma unroll
        for (int nt = 0; nt < 2; ++nt)
#pragma unroll
          for (int g = 0; g < 16; ++g) cs[((mt & 1) * 32 + crow(g, h)) * 260 + wn * 64 + nt * 32 + r] = acc[mt][nt][g];
      }
    }
  } else {
    if (wm != q) return;
#pragma unroll
    for (int mt = 0; mt < 2; ++mt)
#pragma unroll
      for (int nt = 0; nt < 2; ++nt)
#pragma unroll
        for (int g = 0; g < 16; ++g) cs[(mt * 32 + crow(g, h)) * 260 + wn * 64 + nt * 32 + r] = acc[mt][nt][g];
  }
}

template <int MT>
DI void stage_nat(float* cs, const f32x16 (&acc)[MT][2], int half) {
  const int tid_ = opaque_tid(); const int lane = tid_ & 63, w = tid_ >> 6, wm = w >> 2, wn = w & 3, r = lane & 31, h = lane >> 5;
  if (MT == 4 && wm != half) return;
  const int rb = (MT == 4) ? 0 : wm * 64;
#pragma unroll
  for (int mt = 0; mt < MT; ++mt)
#pragma unroll
    for (int nt = 0; nt < 2; ++nt)
#pragma unroll
      for (int g = 0; g < 16; ++g) cs[(rb + mt * 32 + crow(g, h)) * 260 + wn * 64 + nt * 32 + r] = acc[mt][nt][g];
}
DI void stage_tr(float* cs, const f32x16 (&acc)[4][2], int half) {
  const int tid_ = opaque_tid(); const int lane = tid_ & 63, w = tid_ >> 6, wm = w >> 2, wn = w & 3, r = lane & 31, h = lane >> 5;
  if (wm != half) return;
#pragma unroll
  for (int mt = 0; mt < 4; ++mt)
#pragma unroll
    for (int nt = 0; nt < 2; ++nt)
#pragma unroll
      for (int g = 0; g < 4; ++g) {
        f32x4 v = {acc[mt][nt][4 * g], acc[mt][nt][4 * g + 1], acc[mt][nt][4 * g + 2], acc[mt][nt][4 * g + 3]};
        *(f32x4*)(cs + (wn * 64 + nt * 32 + r) * 132 + mt * 32 + 8 * g + 4 * h) = v;
      }
}

DI void transpose_item(const float* src, int ld, int n_src_col, u16* dst_row, int k8) {
  float v[8];
#pragma unroll
  for (int j = 0; j < 8; ++j) v[j] = src[(size_t)(k8 + j) * ld + n_src_col];
  *(u32x4*)(dst_row + k8) = pack8(v[0], v[1], v[2], v[3], v[4], v[5], v[6], v[7]);
}

DI void phase0(const Params& p, char* smem) {
  const int tid = opaque_tid(), lane = tid & 63, w = tid >> 6;
  float* mod = (float*)(p.ws + OFF_MOD);
  float* sil = (float*)smem;
  float* red = sil + 4096;
  for (int task = blockIdx.x; task < 96; task += gridDim.x) {
    __syncthreads();
    for (int i = tid; i < 4096; i += NTHR) sil[i] = siluf(p.c[i]);
    __syncthreads();
    const int col = task * 64 + lane;
    float a0 = 0.f, a1 = 0.f, a2 = 0.f, a3 = 0.f;
    const float* wp = p.w_ada + (size_t)(w * 128) * 6144 + col;
#pragma unroll 32
    for (int k = 0; k < 128; ++k) {
      const float wv = wp[(size_t)k * 6144];
      const int kk = w * 128 + k;
      a0 += sil[kk] * wv; a1 += sil[1024 + kk] * wv; a2 += sil[2048 + kk] * wv; a3 += sil[3072 + kk] * wv;
    }
    red[(w * 4 + 0) * 64 + lane] = a0; red[(w * 4 + 1) * 64 + lane] = a1; red[(w * 4 + 2) * 64 + lane] = a2; red[(w * 4 + 3) * 64 + lane] = a3;
    __syncthreads();
    if (w < 4) {
      const int b = w;
      float s = 0.f;
#pragma unroll
      for (int q = 0; q < 8; ++q) s += red[(q * 4 + b) * 64 + lane];
      mod[b * 6144 + col] = s + p.b_ada[col];
    }
  }
  const int nfree = (int)gridDim.x > 96 ? (int)gridDim.x - 96 : (int)gridDim.x;
  const int fb = (int)gridDim.x > 96 ? (int)blockIdx.x - 96 : (int)blockIdx.x;
  if (fb < 0) return;
  const int gsz = nfree * NTHR, gid = fb * NTHR + tid;
  u16* wrT = (u16*)(p.ws + OFF_WRT);
  for (int i = gid; i < 256 * 128; i += gsz) { const int n = i & 255, k8 = (i >> 8) * 8; transpose_item(p.w_router, 256, n, wrT + (size_t)n * 1024, k8); }
  u16* winT = (u16*)(p.ws + OFF_WINT);
  for (int i = gid; i < 3088 * 128; i += gsz) { const int n = i % 3088, k8 = (i / 3088) * 8; transpose_item(p.w_in, DIN, n, winT + (size_t)n * 1024, k8); }
  u16* woutT = (u16*)(p.ws + OFF_WOUTT);
  for (int i = gid; i < 1024 * 128; i += gsz) { const int n = i & 1023, k8 = (i >> 10) * 8; transpose_item(p.w_out, 1024, n, woutT + (size_t)n * 1024, k8); }
  u16* ws13T = (u16*)(p.ws + OFF_WS13T);
  for (int i = gid; i < 512 * 128; i += gsz) {
    const int n = i & 511, k8 = (i >> 9) * 8;
    const int col = (n >> 8) * 128 + ((n >> 6) & 3) * 32 + (n & 31);
    transpose_item(((n >> 5) & 1) ? p.ws3 : p.ws1, 256, col, ws13T + (size_t)n * 1024, k8);
  }
  u16* ws2T = (u16*)(p.ws + OFF_WS2T);
  for (int i = gid; i < 1024 * 32; i += gsz) { const int n = i & 1023, k8 = (i >> 10) * 8; transpose_item(p.ws2, 1024, n, ws2T + (size_t)n * 256, k8); }
}

DI void phase1(const Params& p) {
  const int tid = opaque_tid(), lane = tid & 63, w = tid >> 6;
  const float* mod = (const float*)(p.ws + OFF_MOD);
  u16* h1b = (u16*)(p.ws + OFF_H1B);
  const int nW = gridDim.x * 8;
  for (int t0 = blockIdx.x * 8 + w; t0 < T; t0 += 4 * nW) {
    f32x4 xv[4][4]; float ssq[4];
#pragma unroll
    for (int q = 0; q < 4; ++q) {
      const int t = t0 + q * nW;
      ssq[q] = 0.f;
      if (t < T) {
#pragma unroll
        for (int i = 0; i < 4; ++i) xv[q][i] = *(const f32x4*)(p.x + (size_t)t * 1024 + i * 256 + lane * 4);
      }
    }
#pragma unroll
    for (int q = 0; q < 4; ++q) {
      const int t = t0 + q * nW;
      if (t < T) {
#pragma unroll
        for (int i = 0; i < 4; ++i) ssq[q] += xv[q][i][0] * xv[q][i][0] + xv[q][i][1] * xv[q][i][1] + xv[q][i][2] * xv[q][i][2] + xv[q][i][3] * xv[q][i][3];
      }
      ssq[q] = wave_sum(ssq[q]);
    }
#pragma unroll
    for (int q = 0; q < 4; ++q) {
      const int t = t0 + q * nW;
      if (t < T) {
        const int b = t >> 12;
        const float r = rsqrtf(ssq[q] * (1.f / 1024.f) + EPS);
#pragma unroll
        for (int i = 0; i < 4; ++i) {
          const int k = i * 256 + lane * 4;
          const f32x4 nw = *(const f32x4*)(p.norm1_w + k);
          const f32x4 sc = *(const f32x4*)(mod + b * 6144 + 1024 + k);
          const f32x4 sh = *(const f32x4*)(mod + b * 6144 + k);
          float o[4];
#pragma unroll
          for (int j = 0; j < 4; ++j) o[j] = xv[q][i][j] * r * nw[j] * (1.f + sc[j]) + sh[j];
          u32x2 pk = {pack2(o[0], o[1]), pack2(o[2], o[3])};
          *(u32x2*)(h1b + (size_t)t * 1024 + k) = pk;
        }
      }
    }
  }
}

DI float logsig(float z) { return fminf(z, 0.f) - log1pf(__expf(-fabsf(z))); }

template <int VAR>
DI void phase2(const Params& p, char* smem) {
  const int tid = opaque_tid();
  const u16* h1b = (const u16*)(p.ws + OFF_H1B);
  const u16* winT = (const u16*)(p.ws + OFF_WINT);
  float* cs = (float*)smem;
  const int xg = blockIdx.x & 7, xj = blockIdx.x >> 3, xn = gridDim.x >> 3;
  for (int l = xj; l < 96; l += xn) {
    const int mtile = xg * 8 + (l & 7), ntile = l >> 3;
    const int row0 = mtile * 256, b = row0 >> 12, s0 = row0 & 4095;
    LoadBf16<4> al; LoadBf16<4> bl;
#pragma unroll
    for (int i = 0; i < 4; ++i) {
      al.rp[i] = h1b + (size_t)(row0 + (tid >> 3) + 64 * i) * 1024 + src_chunk(tid);
      bl.rp[i] = winT + (size_t)(ntile * 256 + (tid >> 3) + 64 * i) * 1024 + src_chunk(tid);
    }
    f32x16 acc[4][2];
    gemm_mainloop<4, LoadBf16<4>, LoadBf16<4>, (VAR == 2)>(al, bl, 16, smem, acc);
    if (VAR == 1 || VAR == 2) { asm volatile("" :: "v"(acc[0][0][0]), "v"(acc[3][1][7])); continue; }
    const bool nat = (ntile < 4) || ntile == 6 || ntile == 7 || ntile >= 10;
    const bool tr = (ntile == 4 || ntile == 5 || (ntile >= 7 && ntile < 10));
    if (nat) {
      float ksum[8], nwv[8];
#pragma unroll
      for (int q = 0; q < 8; ++q) { ksum[q] = 0.f; nwv[q] = (ntile < 4) ? ((ntile < 2) ? p.q_norm_w : p.k_norm_w)[((tid & 31) * 8 & 63) + q] : 1.f; }
#pragma unroll 1
      for (int half = 0; half < 2; ++half) {
        __syncthreads();
        stage_nat<4>(cs, acc, half);
        __syncthreads();
        if (VAR == 4) continue;
#pragma unroll 4
        for (int it = 0; it < 8; ++it) {
          const int i = it * NTHR + tid, row = i >> 5, c8 = (i & 31) * 8;
          const int srow = s0 + half * 128 + row;
          const f32x4 va = *(const f32x4*)(cs + row * 260 + c8), vb = *(const f32x4*)(cs + row * 260 + c8 + 4);
          float v[8] = {va[0], va[1], va[2], va[3], vb[0], vb[1], vb[2], vb[3]};
          const int d0 = c8 & 63;
          if (ntile < 4) {
            float ssq = 0.f;
#pragma unroll
            for (int q = 0; q < 8; ++q) ssq += v[q] * v[q];
            ssq += __shfl_xor(ssq, 1); ssq += __shfl_xor(ssq, 2); ssq += __shfl_xor(ssq, 4);
            const float sc = rsqrtf(ssq * (1.f / 64.f) + EPS);
#pragma unroll
            for (int q = 0; q < 8; ++q) v[q] = v[q] * sc * nwv[q];
            const int hd = (ntile & 1) * 4 + (c8 >> 6);
            u16* dst = (u16*)(p.ws + (ntile < 2 ? OFF_MQ : OFF_MK)) + ((size_t)(b * 8 + hd) * S + srow) * 64 + d0;
            { const u32x4 pv_ = pack8(v[0], v[1], v[2], v[3], v[4], v[5], v[6], v[7]); if (VAR == 3) asm volatile("" :: "v"(pv_), "v"(dst)); else *(u32x4*)dst = pv_; }
            if (ntile >= 2) {
#pragma unroll
              for (int q = 0; q < 8; ++q) ksum[q] += v[q];
            }
          } else if (ntile < 8) {
            const int hd = c8 >> 6;
            if (ntile == 6) {
#pragma unroll
              for (int q = 0; q < 8; ++q) v[q] *= 0.125f;
            }
            u16* dst = (u16*)(p.ws + (ntile == 6 ? OFF_GQ : OFF_GK)) + ((size_t)(b * 4 + hd) * S + srow) * 64 + d0;
            { const u32x4 pv_ = pack8(v[0], v[1], v[2], v[3], v[4], v[5], v[6], v[7]); if (VAR == 3) asm volatile("" :: "v"(pv_), "v"(dst)); else *(u32x4*)dst = pv_; }
          } else {
#pragma unroll
            for (int q = 0; q < 8; ++q) v[q] = siluf(v[q]);
            u16* dst = (u16*)(p.ws + OFF_SG) + (size_t)(row0 + half * 128 + row) * 512 + (ntile - 10) * 256 + c8;
            { const u32x4 pv_ = pack8(v[0], v[1], v[2], v[3], v[4], v[5], v[6], v[7]); if (VAR == 3) asm volatile("" :: "v"(pv_), "v"(dst)); else *(u32x4*)dst = pv_; }
          }
        }
      }
      if (ntile == 2 || ntile == 3) {
        __syncthreads();
        const int c8 = (tid & 31) * 8;
#pragma unroll
        for (int q = 0; q < 8; ++q) cs[(tid >> 5) * 256 + c8 + q] = ksum[q];
        __syncthreads();
        if (tid < 256) {
          float s = 0.f;
#pragma unroll
          for (int q = 0; q < 16; ++q) s += cs[q * 256 + tid];
          const int hd = (ntile - 2) * 4 + (tid >> 6);
          float* km = (float*)(p.ws + OFF_KMEAN);
          if (VAR != 3) km[((size_t)(b * 8 + hd) * 16 + (s0 >> 8)) * 64 + (tid & 63)] = s * (1.f / 256.f);
        }
      }
    }
    if (tr) {
#pragma unroll 1
      for (int half = 0; half < 2; ++half) {
        __syncthreads();
        stage_tr(cs, acc, half);
        __syncthreads();
        if (VAR == 4) continue;
#pragma unroll 4
        for (int it = 0; it < 8; ++it) {
          const int i = it * NTHR + tid, col = i >> 4, r8 = (i & 15) * 8;
          const int srow = s0 + half * 128 + r8;
          const f32x4 va = *(const f32x4*)(cs + col * 132 + r8), vb = *(const f32x4*)(cs + col * 132 + r8 + 4);
          u16* dst;
          if (ntile < 6)       dst = (u16*)(p.ws + OFF_VT) + ((size_t)(b * 8 + (ntile - 4) * 4 + (col >> 6)) * 64 + (col & 63)) * S + srow;
          else if (ntile == 7) dst = (u16*)(p.ws + OFF_GKT) + ((size_t)(b * 4 + (col >> 6)) * 64 + (col & 63)) * S + srow;
          else                 dst = (u16*)(p.ws + OFF_GVT) + ((size_t)(b * 4 + (ntile - 8) * 2 + (col >> 7)) * 128 + (col & 127)) * S + srow;
          { const u32x4 pv_ = pack8(va[0], va[1], va[2], va[3], vb[0], vb[1], vb[2], vb[3]); if (VAR == 3) asm volatile("" :: "v"(pv_), "v"(dst)); else *(u32x4*)dst = pv_; }
        }
      }
    }
  }
}

DI void phase2_ga(const Params& p, char* smem) {
  const int tid = opaque_tid(), lane = tid & 63, w = tid >> 6, r = lane & 31, h5 = lane >> 5;
  const u16* h1b = (const u16*)(p.ws + OFF_H1B);
  const u16* winT = (const u16*)(p.ws + OFF_WINT);
  float* gs = (float*)smem;
  for (int task = blockIdx.x; task < 256; task += gridDim.x) {
    const int row0 = task * 64, b = row0 >> 12, s0 = row0 & 4095;
    __syncthreads();
    if (w < 2) {
      f32x16 acc;
#pragma unroll
      for (int i = 0; i < 16; ++i) acc[i] = 0.f;
      const u16* ap = h1b + (size_t)(row0 + w * 32 + r) * 1024 + h5 * 8;
      const u16* bp = winT + (size_t)(3072 + (r & 15)) * 1024 + h5 * 8;
#pragma unroll 4
      for (int ks = 0; ks < 64; ++ks) acc = MFMA32(*(const bf16x8*)(ap + ks * 16), *(const bf16x8*)(bp + ks * 16), acc);
      if (r < 16) {
#pragma unroll
        for (int i = 0; i < 16; ++i) gs[(w * 32 + crow(i, h5)) * 17 + r] = acc[i];
      }
    }
    __syncthreads();
    if (tid < 256) {
      float wa[16];
#pragma unroll
      for (int q = 0; q < 16; ++q) wa[q] = p.w_alpha[q * 256 + tid];
      const float ba = p.b_alpha[tid];
      const int hd = tid >> 6, d = tid & 63;
      float* bc = (float*)(p.ws + OFF_BC) + ((size_t)(b * 4 + hd) * S + s0) * 64 + d;
      float* bct = (float*)(p.ws + OFF_BCT) + ((size_t)(b * 4 + hd) * 64 + d) * S + s0;
      float cum = 0.f;
#pragma unroll 1
      for (int r4 = 0; r4 < 16; ++r4) {
        f32x4 o;
#pragma unroll
        for (int q4 = 0; q4 < 4; ++q4) {
          const int row = r4 * 4 + q4;
          float z = ba;
#pragma unroll
          for (int q = 0; q < 16; ++q) z += gs[row * 17 + q] * wa[q];
          cum += logsig(z) * (1.f / 16.f);
          bc[(size_t)row * 64] = cum;
          o[q4] = cum;
        }
        *(f32x4*)(bct + r4 * 4) = o;
      }
    }
  }
}

DI int t5_bucket(int rel) {
  if (rel < 16) return rel;
  int bkt = 16;
  bkt += (rel >= 19); bkt += (rel >= 21); bkt += (rel >= 24); bkt += (rel >= 27); bkt += (rel >= 31); bkt += (rel >= 35); bkt += (rel >= 40);
  bkt += (rel >= 46); bkt += (rel >= 52); bkt += (rel >= 59); bkt += (rel >= 67); bkt += (rel >= 77); bkt += (rel >= 87); bkt += (rel >= 99); bkt += (rel >= 113);
  return bkt;
}

struct MobaState { f32x16 o0, o1; float m, l; };
struct MobaFrags { bf16x8 k[4]; bf16x8 v[4]; };

DI int swap23(int r) { return (r & ~12) | ((r & 4) << 1) | ((r & 8) >> 1); }
DI int kofs(int i, int h) { return (i & 3) + 4 * ((i >> 2) & 1) + 8 * h + 16 * (i >> 3); }
DI void moba_lds_load(MobaFrags& f, const char* sp, int sb, int r, int h5) {
  const int kr = swap23(r);
  const char* kp = sp + (sb * 32 + kr) * 128;
  const int fk = swz(kr), fz = swz(r);
#pragma unroll
  for (int ks = 0; ks < 4; ++ks) f.k[ks] = *(const bf16x8*)(kp + (((ks * 2 + h5) ^ fk) << 4));
#pragma unroll
  for (int s2 = 0; s2 < 2; ++s2)
#pragma unroll
    for (int dt = 0; dt < 2; ++dt)
      f.v[s2 * 2 + dt] = *(const bf16x8*)(sp + 8192 + (dt * 32 + r) * 128 + (((sb * 4 + s2 * 2 + h5) ^ fz) << 4));
}

template <int MODE, int VAR>
DI void moba_tile(MobaState& st, const bf16x8 (&qf)[4], const char* sp, int kpos0, int qpos, bool sel,
                  const float* lut, float cb31, int r, int h5) {
  const float NEG = -__builtin_inff();
  MobaFrags f0, f1;
  moba_lds_load(f0, sp, 0, r, h5);
  moba_lds_load(f1, sp, 1, r, h5);
  f32x16 s0, s1;
#pragma unroll
  for (int i = 0; i < 16; ++i) { s0[i] = 0.f; s1[i] = 0.f; }
#pragma unroll
  for (int ks = 0; ks < 4; ++ks) { if (VAR != 1) { s0 = MFMA32(f0.k[ks], qf[ks], s0); s1 = MFMA32(f1.k[ks], qf[ks], s1); } else { s0[ks] += __builtin_bit_cast(float, (int)f0.k[ks][0]); s1[ks] += __builtin_bit_cast(float, (int)f1.k[ks][1]); } }
  const float c1 = 0.125f * LOG2E;
  float t0[16], t1[16]; float tm;
  float alpha;
  if (VAR == 3) {
#pragma unroll
    for (int i = 0; i < 16; ++i) { t0[i] = s0[i]; t1[i] = s1[i]; }
    alpha = 1.f;
  } else if (MODE == 0) {
    const float c1e = sel ? c1 : 0.f, cbe = sel ? cb31 : NEG;
    float sm = max3f_mfma(s0[15], s1[15], s0[0]);
    sm = max3f(sm, s1[0], s0[1]);
#pragma unroll
    for (int i = 1; i < 14; ++i) sm = max3f(sm, s1[i], s0[i + 1]);
    sm = fmaxf(sm, s1[14]);
    tm = sm * c1e + cbe;
    tm = fmaxf(tm, __shfl_xor(tm, 32));
    const float mn = fmaxf(st.m, tm);
    const float mu = (mn == NEG) ? 0.f : mn;
    alpha = __builtin_amdgcn_exp2f(st.m - mu);
    const float off = cbe - mu;
    float psum = 0.f;
#pragma unroll
    for (int i = 0; i < 16; ++i) { t0[i] = __builtin_amdgcn_exp2f(s0[i] * c1e + off); t1[i] = __builtin_amdgcn_exp2f(s1[i] * c1e + off); psum += t0[i] + t1[i]; }
    st.l = st.l * alpha + psum; st.m = mn;
  } else {
    tm = NEG;
#pragma unroll
    for (int i = 0; i < 16; ++i) {
      const int rel0 = qpos - (kpos0 + kofs(i, h5)), rel1 = rel0 - 32;
      const float b0 = lut[min(max(rel0, 0), 127)];
      const float b1 = lut[min(max(rel1, 0), 127)];
      float v0 = s0[i] * c1 + b0, v1 = s1[i] * c1 + b1;
      if (MODE == 2) { if (rel0 < 0) v0 = NEG; if (rel1 < 0) v1 = NEG; }
      if (MODE == 1 && !sel) { v0 = NEG; v1 = NEG; }
      t0[i] = v0; t1[i] = v1; tm = max3f(tm, v0, v1);
    }
    tm = fmaxf(tm, __shfl_xor(tm, 32));
    const float mn = fmaxf(st.m, tm);
    const float mu = (mn == NEG) ? 0.f : mn;
    alpha = __builtin_amdgcn_exp2f(st.m - mu);
    float psum = 0.f;
#pragma unroll
    for (int i = 0; i < 16; ++i) { t0[i] = __builtin_amdgcn_exp2f(t0[i] - mu); t1[i] = __builtin_amdgcn_exp2f(t1[i] - mu); psum += t0[i] + t1[i]; }
    st.l = st.l * alpha + psum; st.m = mn;
  }
#pragma unroll
  for (int i = 0; i < 16; ++i) { st.o0[i] *= alpha; st.o1[i] *= alpha; }
  const bf16x8 p00 = __builtin_bit_cast(bf16x8, pack8(t0[0], t0[1], t0[2], t0[3], t0[4], t0[5], t0[6], t0[7]));
  const bf16x8 p01 = __builtin_bit_cast(bf16x8, pack8(t0[8], t0[9], t0[10], t0[11], t0[12], t0[13], t0[14], t0[15]));
  const bf16x8 p10 = __builtin_bit_cast(bf16x8, pack8(t1[0], t1[1], t1[2], t1[3], t1[4], t1[5], t1[6], t1[7]));
  const bf16x8 p11 = __builtin_bit_cast(bf16x8, pack8(t1[8], t1[9], t1[10], t1[11], t1[12], t1[13], t1[14], t1[15]));
#pragma unroll
  for (int s2 = 0; s2 < 2; ++s2) {
#pragma unroll
    for (int dt = 0; dt < 2; ++dt) {
      const bf16x8 va = f0.v[s2 * 2 + dt], vb = f1.v[s2 * 2 + dt];
      if (VAR == 2) { st.o0[s2 * 2 + dt] += __builtin_bit_cast(float, (int)va[0] ^ (int)vb[1]) + __builtin_bit_cast(float, (int)(s2 ? p01 : p00)[0] + (int)(s2 ? p11 : p10)[1]); }
      else if (dt == 0) { st.o0 = MFMA32(va, s2 ? p01 : p00, st.o0); st.o0 = MFMA32(vb, s2 ? p11 : p10, st.o0); }
      else              { st.o1 = MFMA32(va, s2 ? p01 : p00, st.o1); st.o1 = MFMA32(vb, s2 ? p11 : p10, st.o1); }
    }
  }
}

template <int VAR>
DI void phase_moba(const Params& p, char* smem, int task_lo, int task_hi, u16* mix) {
  const int tid = opaque_tid(), lane = tid & 63, w = tid >> 6, r = lane & 31, h5 = lane >> 5;
  float* lut = (float*)(smem + 65536);
  unsigned* um = (unsigned*)(smem + 65536 + 512);
  const float NEG = -__builtin_inff();
  const u16* mq = (const u16*)(p.ws + OFF_MQ);
  const u16* mk = (const u16*)(p.ws + OFF_MK);
  const u16* vT = (const u16*)(p.ws + OFF_VT);
  const float* kmean = (const float*)(p.ws + OFF_KMEAN);
  for (int task = task_lo + blockIdx.x; task < task_hi; task += gridDim.x) {
    const int blk = (task < 256) ? 15 - (task >> 5) : ((task - 256) >> 5);
    const int bh = task & 31, hd = bh & 7, b = bh >> 3;
    __syncthreads();
    if (tid < 128) lut[tid] = p.rel_bias[t5_bucket(tid) * 8 + hd] * LOG2E;
    __syncthreads();
    const float cb31 = p.rel_bias[31 * 8 + hd] * LOG2E;
    const int qpos = blk * 256 + w * 32 + r;
    const u16* qptr = mq + ((size_t)bh * S + qpos) * 64 + h5 * 8;
    bf16x8 qf[4];
#pragma unroll
    for (int ks = 0; ks < 4; ++ks) qf[ks] = *(const bf16x8*)(qptr + ks * 16);
    unsigned selmask = 0;
    if (blk > 0) {
      f32x16 g;
#pragma unroll
      for (int i = 0; i < 16; ++i) g[i] = 0.f;
      const int n = r < 15 ? r : 15;
      const float* kmp = kmean + ((size_t)bh * 16 + n) * 64 + h5 * 8;
#pragma unroll
      for (int ks = 0; ks < 4; ++ks) {
        const f32x4 v0 = *(const f32x4*)(kmp + ks * 16), v1 = *(const f32x4*)(kmp + ks * 16 + 4);
        const u32x4 hi = pack8(v0[0], v0[1], v0[2], v0[3], v1[0], v1[1], v1[2], v1[3]);
        const u32x4 lo = pack8(v0[0] - bflo(hi[0]), v0[1] - bfhi(hi[0]), v0[2] - bflo(hi[1]), v0[3] - bfhi(hi[1]),
                               v1[0] - bflo(hi[2]), v1[1] - bfhi(hi[2]), v1[2] - bflo(hi[3]), v1[3] - bfhi(hi[3]));
        g = MFMA32(__builtin_bit_cast(bf16x8, hi), qf[ks], g);
        g = MFMA32(__builtin_bit_cast(bf16x8, lo), qf[ks], g);
      }
      float gt[16];
#pragma unroll
      for (int nn = 0; nn < 16; ++nn) {
        const int x = (nn >> 2) & 1, rr = (nn & 3) + 4 * (nn >> 3);
        const float own = g[rr];
        const float par = __shfl_xor(own, 32);
        gt[nn] = (h5 == x) ? own : par;
      }
#pragma unroll
      for (int it = 0; it < 3; ++it) {
        float best = NEG; int bi = -1;
#pragma unroll
        for (int nn = 0; nn < 16; ++nn) {
          const bool ok = (nn < blk) && !((selmask >> nn) & 1u);
          if (ok && gt[nn] > best) { best = gt[nn]; bi = nn; }
        }
        if (bi >= 0) selmask |= 1u << bi;
      }
    }
    unsigned wmask = 0;
    for (int nn = 0; nn < blk; ++nn) if (__any((int)((selmask >> nn) & 1u))) wmask |= 1u << nn;
    if (lane == 0) um[w] = wmask;
    __syncthreads();
    unsigned bmask = 1u << blk;
#pragma unroll
    for (int q = 0; q < 8; ++q) bmask |= um[q];
    MobaState st;
#pragma unroll
    for (int i = 0; i < 16; ++i) { st.o0[i] = 0.f; st.o1[i] = 0.f; }
    st.m = NEG; st.l = 0.f;
    const u16* kbase = mk + (size_t)bh * S * 64;
    const u16* vbase = vT + (size_t)bh * 64 * S;
    const int ntile = __builtin_popcount(bmask) * 4;
    LoadBf16<2> ld;
    int pn = __builtin_ctz(bmask), pj = 0, pit = 0;
    auto issue_next = [&]() {
      if (pit < ntile) {
        ld.rp[0] = kbase + (size_t)(pn * 256 + pj * 64 + (tid >> 3)) * 64 + src_chunk(tid);
        ld.rp[1] = vbase + (size_t)(tid >> 3) * S + pn * 256 + pj * 64 + src_chunk(tid);
        ld.issue(0, smem + (pit & 3) * 16384, tid);
        ++pit;
        if (++pj == 4) { pj = 0; if (pn != blk) pn = __builtin_ctz(bmask & ~((2u << pn) - 1u)); }
      }
    };
    issue_next(); issue_next(); issue_next();
    int n = __builtin_ctz(bmask), j = 0;
    for (int it = 0; it < ntile; ++it) {
      const int ahead = pit - it - 1;
      if (ahead >= 2) asm volatile("s_waitcnt vmcnt(4)" ::: "memory");
      else if (ahead == 1) asm volatile("s_waitcnt vmcnt(2)" ::: "memory");
      else asm volatile("s_waitcnt vmcnt(0)" ::: "memory");
      __builtin_amdgcn_s_barrier();
      issue_next();
      const char* sp = smem + (it & 3) * 16384;
      const int kp0 = n * 256 + j * 64;
      if (n == blk) {
        if (2 * j <= w) moba_tile<2, VAR>(st, qf, sp, kp0, qpos, true, lut, cb31, r, h5);
      } else if ((wmask >> n) & 1u) {
        const bool sel = (selmask >> n) & 1u;
        if (n == blk - 1) moba_tile<1, VAR>(st, qf, sp, kp0, qpos, sel, lut, cb31, r, h5);
        else              moba_tile<0, VAR>(st, qf, sp, kp0, qpos, sel, lut, cb31, r, h5);
      }
      if (++j == 4) { j = 0; if (n != blk) n = __builtin_ctz(bmask & ~((2u << n) - 1u)); }
    }
    __syncthreads();
    float l = st.l + __shfl_xor(st.l, 32);
    const float inv = 1.f / l;
    float ssq = 0.f;
#pragma unroll
    for (int i = 0; i < 16; ++i) { st.o0[i] *= inv; st.o1[i] *= inv; ssq += st.o0[i] * st.o0[i] + st.o1[i] * st.o1[i]; }
    ssq += __shfl_xor(ssq, 32);
    const float rs = rsqrtf(ssq * (1.f / 64.f) + EPS);
    u16* op = mix + (size_t)(b * S + qpos) * 1024 + hd * 64;
#pragma unroll
    for (int dt = 0; dt < 2; ++dt)
#pragma unroll
      for (int g4 = 0; g4 < 4; ++g4) {
        const int d0 = dt * 32 + 8 * g4 + 4 * h5;
        const f32x4 mw = *(const f32x4*)(p.moba_out_w + d0);
        float o[4];
#pragma unroll
        for (int q = 0; q < 4; ++q) o[q] = (dt ? st.o1[4 * g4 + q] : st.o0[4 * g4 + q]) * rs * mw[q];
        u32x2 pk = {pack2(o[0], o[1]), pack2(o[2], o[3])};
        *(u32x2*)(op + d0) = pk;
      }
  }
}

DI void phase_gla_a(const Params& p) {
  const int tid = opaque_tid(), lane = tid & 63, w = tid >> 6, r = lane & 31, h5 = lane >> 5;
  const u16* gkT = (const u16*)(p.ws + OFF_GKT);
  const u16* gvT = (const u16*)(p.ws + OFF_GVT);
  const float* bcT = (const float*)(p.ws + OFF_BCT);
  float* UT = (float*)(p.ws + OFF_UT);
  float* dec = (float*)(p.ws + OFF_DEC);
  for (int task = blockIdx.x; task < 512; task += gridDim.x) {
    const int bh = task >> 5, c = (task & 31) * 2 + (w >> 2), vt = w & 3;
    f32x16 acc[2];
#pragma unroll
    for (int i = 0; i < 16; ++i) { acc[0][i] = 0.f; acc[1][i] = 0.f; }
    const u16* vp = gvT + ((size_t)bh * 128 + vt * 32 + r) * S + c * 64 + h5 * 8;
#pragma unroll
    for (int dt = 0; dt < 2; ++dt) {
      const int d = dt * 32 + r;
      const float* bp = bcT + ((size_t)bh * 64 + d) * S + c * 64;
      const u16* kp = gkT + ((size_t)bh * 64 + d) * S + c * 64;
      const float bl = bp[63];
      if (vt == 0 && h5 == 0) dec[((size_t)bh * 64 + c) * 64 + d] = __expf(bl);
#pragma unroll
      for (int ks = 0; ks < 4; ++ks) {
        const u32x4 kk = *(const u32x4*)(kp + ks * 16 + h5 * 8);
        const f32x4 b0 = *(const f32x4*)(bp + ks * 16 + h5 * 8), b1 = *(const f32x4*)(bp + ks * 16 + h5 * 8 + 4);
        const u32x4 kh = pack8(bflo(kk[0]) * __expf(bl - b0[0]), bfhi(kk[0]) * __expf(bl - b0[1]), bflo(kk[1]) * __expf(bl - b0[2]), bfhi(kk[1]) * __expf(bl - b0[3]),
                               bflo(kk[2]) * __expf(bl - b1[0]), bfhi(kk[2]) * __expf(bl - b1[1]), bflo(kk[3]) * __expf(bl - b1[2]), bfhi(kk[3]) * __expf(bl - b1[3]));
        const bf16x8 vf = *(const bf16x8*)(vp + ks * 16);
        acc[dt] = MFMA32(vf, __builtin_bit_cast(bf16x8, kh), acc[dt]);
      }
    }
    float* up = UT + ((size_t)bh * 64 + c) * 128 * 64;
#pragma unroll
    for (int dt = 0; dt < 2; ++dt)
#pragma unroll
      for (int i = 0; i < 16; ++i) up[(size_t)(vt * 32 + crow(i, h5)) * 64 + dt * 32 + r] = acc[dt][i];
  }
}

DI void phase_gla_b(const Params& p) {
  const float* UT = (const float*)(p.ws + OFF_UT);
  const float* dec = (const float*)(p.ws + OFF_DEC);
  u16* ST = (u16*)(p.ws + OFF_ST);
  for (int i = blockIdx.x * NTHR + threadIdx.x; i < 16 * 128 * 16; i += gridDim.x * NTHR) {
    const int d4 = (i & 15) * 4, v = (i >> 4) & 127, bh = i >> 11;
    f32x4 st = {0.f, 0.f, 0.f, 0.f};
#pragma unroll 8
    for (int c = 0; c < 64; ++c) {
      const size_t o = (((size_t)bh * 64 + c) * 128 + v) * 64 + d4;
      const f32x4 u = *(const f32x4*)(UT + o);
      const f32x4 a = *(const f32x4*)(dec + ((size_t)bh * 64 + c) * 64 + d4);
      u32x2 pk = {pack2(st[0], st[1]), pack2(st[2], st[3])};
      *(u32x2*)(ST + o) = pk;
      st[0] = a[0] * st[0] + u[0]; st[1] = a[1] * st[1] + u[1]; st[2] = a[2] * st[2] + u[2]; st[3] = a[3] * st[3] + u[3];
    }
  }
}

DI void phase_gla_c(const Params& p) {
  const int tid = opaque_tid(), lane = tid & 63, w = tid >> 6, r = lane & 31, h5 = lane >> 5;
  const u16* gq = (const u16*)(p.ws + OFF_GQ);
  const u16* gk = (const u16*)(p.ws + OFF_GK);
  const u16* gvT = (const u16*)(p.ws + OFF_GVT);
  const float* bc = (const float*)(p.ws + OFF_BC);
  const u16* ST = (const u16*)(p.ws + OFF_ST);
  const u16* sg = (const u16*)(p.ws + OFF_SG);
  u16* mix = (u16*)(p.ws + OFF_MIX);
  for (int task = blockIdx.x; task < 256; task += gridDim.x) {
    const int bh = task >> 4, c = (task & 15) * 4 + (w >> 1), ih = w & 1, b = bh >> 2, hd = bh & 3;
    const int tpos = c * 64 + ih * 32 + r;
    bf16x8 stf[16];
    {
      const u16* sp = ST + (((size_t)bh * 64 + c) * 128 + r) * 64 + h5 * 8;
#pragma unroll
      for (int vt = 0; vt < 4; ++vt)
#pragma unroll
        for (int ks = 0; ks < 4; ++ks) stf[vt * 4 + ks] = *(const bf16x8*)(sp + (size_t)vt * 32 * 64 + ks * 16);
    }
    u32x4 k0r[4]; f32x4 k0b[8];
    {
      const int jpos = c * 64 + r;
      const u16* kp = gk + ((size_t)bh * S + jpos) * 64 + h5 * 8;
      const float* bp = bc + ((size_t)bh * S + jpos) * 64 + h5 * 8;
#pragma unroll
      for (int ks = 0; ks < 4; ++ks) { k0r[ks] = *(const u32x4*)(kp + ks * 16); k0b[2 * ks] = *(const f32x4*)(bp + ks * 16); k0b[2 * ks + 1] = *(const f32x4*)(bp + ks * 16 + 4); }
    }
    bf16x8 qt[4];
    {
      const u16* qp = gq + ((size_t)bh * S + tpos) * 64 + h5 * 8;
      const float* bp = bc + ((size_t)bh * S + tpos) * 64 + h5 * 8;
#pragma unroll
      for (int ks = 0; ks < 4; ++ks) {
        const u32x4 qq = *(const u32x4*)(qp + ks * 16);
        const f32x4 b0 = *(const f32x4*)(bp + ks * 16), b1 = *(const f32x4*)(bp + ks * 16 + 4);
        qt[ks] = __builtin_bit_cast(bf16x8, pack8(bflo(qq[0]) * __expf(b0[0]), bfhi(qq[0]) * __expf(b0[1]), bflo(qq[1]) * __expf(b0[2]), bfhi(qq[1]) * __expf(b0[3]),
                                                 bflo(qq[2]) * __expf(b1[0]), bfhi(qq[2]) * __expf(b1[1]), bflo(qq[3]) * __expf(b1[2]), bfhi(qq[3]) * __expf(b1[3])));
      }
    }
    f32x16 oacc[4];
#pragma unroll
    for (int vt = 0; vt < 4; ++vt)
#pragma unroll
      for (int i = 0; i < 16; ++i) oacc[vt][i] = 0.f;
#pragma unroll
    for (int vt = 0; vt < 4; ++vt)
#pragma unroll
      for (int ks = 0; ks < 4; ++ks) oacc[vt] = MFMA32(stf[vt * 4 + ks], qt[ks], oacc[vt]);
#pragma unroll
    for (int jt = 0; jt < 2; ++jt) {
      if (jt <= ih) {
        f32x16 X;
#pragma unroll
        for (int i = 0; i < 16; ++i) X[i] = 0.f;
        const int jpos = c * 64 + jt * 32 + r;
        const u16* kp = gk + ((size_t)bh * S + jpos) * 64 + h5 * 8;
        const float* bp = bc + ((size_t)bh * S + jpos) * 64 + h5 * 8;
#pragma unroll
        for (int ks = 0; ks < 4; ++ks) {
          const u32x4 kk = (jt == 0) ? k0r[ks] : *(const u32x4*)(kp + ks * 16);
          const f32x4 b0 = (jt == 0) ? k0b[2 * ks] : *(const f32x4*)(bp + ks * 16), b1 = (jt == 0) ? k0b[2 * ks + 1] : *(const f32x4*)(bp + ks * 16 + 4);
          const u32x4 kt = pack8(bflo(kk[0]) * __expf(-b0[0]), bfhi(kk[0]) * __expf(-b0[1]), bflo(kk[1]) * __expf(-b0[2]), bfhi(kk[1]) * __expf(-b0[3]),
                                 bflo(kk[2]) * __expf(-b1[0]), bfhi(kk[2]) * __expf(-b1[1]), bflo(kk[3]) * __expf(-b1[2]), bfhi(kk[3]) * __expf(-b1[3]));
          X = MFMA32(__builtin_bit_cast(bf16x8, kt), qt[ks], X);
        }
        if (jt == ih) {
#pragma unroll
          for (int i = 0; i < 16; ++i) if (crow(i, h5) > r) X[i] = 0.f;
        }
        const bf16x8 pf0 = __builtin_bit_cast(bf16x8, pack8(X[0], X[1], X[2], X[3], X[4], X[5], X[6], X[7]));
        const bf16x8 pf1 = __builtin_bit_cast(bf16x8, pack8(X[8], X[9], X[10], X[11], X[12], X[13], X[14], X[15]));
#pragma unroll
        for (int vt = 0; vt < 4; ++vt) {
#pragma unroll
          for (int s2 = 0; s2 < 2; ++s2) {
            const u16* vp = gvT + ((size_t)bh * 128 + vt * 32 + r) * S + c * 64 + jt * 32 + 16 * s2 + 4 * h5;
            const u32x2 lo = *(const u32x2*)vp, hi = *(const u32x2*)(vp + 8);
            u32x4 vv = {lo[0], lo[1], hi[0], hi[1]};
            oacc[vt] = MFMA32(__builtin_bit_cast(bf16x8, vv), s2 ? pf1 : pf0, oacc[vt]);
          }
        }
      }
    }
    float ssq = 0.f;
#pragma unroll
    for (int vt = 0; vt < 4; ++vt)
#pragma unroll
      for (int i = 0; i < 16; ++i) ssq += oacc[vt][i] * oacc[vt][i];
    ssq += __shfl_xor(ssq, 32);
    const float rs = rsqrtf(ssq * (1.f / 128.f) + EPS);
    const size_t t = (size_t)b * S + tpos;
    const u16* sgp = sg + t * 512 + hd * 128;
    u16* op = mix + t * 1024 + 512 + hd * 128;
#pragma unroll
    for (int vt = 0; vt < 4; ++vt)
#pragma unroll
      for (int g4 = 0; g4 < 4; ++g4) {
        const int v0 = vt * 32 + 8 * g4 + 4 * h5;
        const f32x4 gw = *(const f32x4*)(p.gla_out_w + v0);
        const u32x2 sv = *(const u32x2*)(sgp + v0);
        const float o0 = oacc[vt][4 * g4 + 0] * rs * gw[0] * bflo(sv[0]);
        const float o1 = oacc[vt][4 * g4 + 1] * rs * gw[1] * bfhi(sv[0]);
        const float o2 = oacc[vt][4 * g4 + 2] * rs * gw[2] * bflo(sv[1]);
        const float o3 = oacc[vt][4 * g4 + 3] * rs * gw[3] * bfhi(sv[1]);
        u32x2 pk = {pack2(o0, o1), pack2(o2, o3)};
        *(u32x2*)(op + v0) = pk;
      }
  }
}

DI void phase6(const Params& p, char* smem) {
  const int tid = opaque_tid();
  const u16* mix = (const u16*)(p.ws + OFF_MIX);
  const u16* woutT = (const u16*)(p.ws + OFF_WOUTT);
  const float* mod = (const float*)(p.ws + OFF_MOD);
  u16* d1 = (u16*)(p.ws + OFF_D1);
  float* cs = (float*)smem;
  const int xg = blockIdx.x & 7, xj = blockIdx.x >> 3, xn = gridDim.x >> 3;
  for (int l = xj; l < 32; l += xn) {
    const int mtile = xg * 8 + (l & 7), ntile = l >> 3, row0 = mtile * 256, b = row0 >> 12;
    LoadBf16<4> al; LoadBf16<4> bl;
#pragma unroll
    for (int i = 0; i < 4; ++i) {
      al.rp[i] = mix + (size_t)(row0 + (tid >> 3) + 64 * i) * 1024 + src_chunk(tid);
      bl.rp[i] = woutT + (size_t)(ntile * 256 + (tid >> 3) + 64 * i) * 1024 + src_chunk(tid);
    }
    f32x16 acc[4][2];
    gemm_mainloop<4>(al, bl, 16, smem, acc);
    const int c8 = (tid & 31) * 8, col = ntile * 256 + c8;
    const f32x4 ga = *(const f32x4*)(mod + b * 6144 + 2048 + col), gb = *(const f32x4*)(mod + b * 6144 + 2048 + col + 4);
#pragma unroll 1
    for (int half = 0; half < 2; ++half) {
      __syncthreads();
      stage_nat<4>(cs, acc, half);
      __syncthreads();
#pragma unroll 2
      for (int it = 0; it < 8; ++it) {
        const int i = it * NTHR + tid, row = i >> 5;
        const f32x4 va = *(const f32x4*)(cs + row * 260 + c8), vb = *(const f32x4*)(cs + row * 260 + c8 + 4);
        *(u32x4*)(d1 + (size_t)(row0 + half * 128 + row) * 1024 + col) =
            pack8(va[0] * ga[0], va[1] * ga[1], va[2] * ga[2], va[3] * ga[3], vb[0] * gb[0], vb[1] * gb[1], vb[2] * gb[2], vb[3] * gb[3]);
      }
    }
  }
}

DI void phase7_rows(const Params& p) {
  const int tid = opaque_tid(), lane = tid & 63, w = tid >> 6;
  const u16* d1 = (const u16*)(p.ws + OFF_D1);
  const float* mod = (const float*)(p.ws + OFF_MOD);
  u16* h2b = (u16*)(p.ws + OFF_H2B);
  for (int task = blockIdx.x; task < 256; task += gridDim.x) {
    const int row0 = task * 64, b = row0 >> 12;
    {
#pragma unroll 1
      for (int rr0 = 0; rr0 < 8; rr0 += 4) {
        f32x4 xv[4][4]; float ssq[4];
#pragma unroll
        for (int q = 0; q < 4; ++q) {
          const size_t t = row0 + w * 8 + rr0 + q;
#pragma unroll
          for (int i = 0; i < 4; ++i) {
            const f32x4 xx = *(const f32x4*)(p.x + t * 1024 + i * 256 + lane * 4);
            const u32x2 dd = *(const u32x2*)(d1 + t * 1024 + i * 256 + lane * 4);
            xv[q][i][0] = xx[0] + bflo(dd[0]); xv[q][i][1] = xx[1] + bfhi(dd[0]); xv[q][i][2] = xx[2] + bflo(dd[1]); xv[q][i][3] = xx[3] + bfhi(dd[1]);
          }
        }
#pragma unroll
        for (int q = 0; q < 4; ++q) {
          float a = 0.f;
#pragma unroll
          for (int i = 0; i < 4; ++i) a += xv[q][i][0] * xv[q][i][0] + xv[q][i][1] * xv[q][i][1] + xv[q][i][2] * xv[q][i][2] + xv[q][i][3] * xv[q][i][3];
          ssq[q] = wave_sum(a);
        }
#pragma unroll
        for (int i = 0; i < 4; ++i) {
          const int k = i * 256 + lane * 4;
          const f32x4 nw = *(const f32x4*)(p.norm2_w + k);
          const f32x4 sc = *(const f32x4*)(mod + b * 6144 + 4096 + k);
          const f32x4 sh = *(const f32x4*)(mod + b * 6144 + 3072 + k);
#pragma unroll
          for (int q = 0; q < 4; ++q) {
            const size_t t = row0 + w * 8 + rr0 + q;
            const float rn = rsqrtf(ssq[q] * (1.f / 1024.f) + EPS);
            float o[4];
#pragma unroll
            for (int j = 0; j < 4; ++j) o[j] = xv[q][i][j] * rn * (nw[j] * (1.f + sc[j])) + sh[j];
            u32x2 pk = {pack2(o[0], o[1]), pack2(o[2], o[3])};
            *(u32x2*)(h2b + t * 1024 + k) = pk;
          }
        }
      }
    }
  }
}

DI void phase7(const Params& p, char* smem) {
  const int tid = opaque_tid(), lane = tid & 63, w = tid >> 6, wm = w >> 2, wn = w & 3, r = lane & 31, h5 = lane >> 5;
  const float NEG = -__builtin_inff();
  const u16* d1 = (const u16*)(p.ws + OFF_D1);
  const float* mod = (const float*)(p.ws + OFF_MOD);
  u16* h2b = (u16*)(p.ws + OFF_H2B);
  const u16* wrT = (const u16*)(p.ws + OFF_WRT);
  int* cnt = (int*)(p.ws + OFF_CNT);
  int* list = (int*)(p.ws + OFF_LIST);
  float* topw = (float*)(p.ws + OFF_TOPW);
  float* lg = (float*)smem;
  for (int task = blockIdx.x; task < 256; task += gridDim.x) {
    const int row0 = task * 64, b = row0 >> 12;
    asm volatile("s_waitcnt vmcnt(0)" ::: "memory");
    __syncthreads();
    LoadBf16Reg<1> al; LoadBf16Reg<4> bl;
    al.rp[0] = h2b + (size_t)(row0 + (tid >> 3)) * 1024 + (tid & 7) * 8;
#pragma unroll
    for (int i = 0; i < 4; ++i) bl.rp[i] = wrT + (size_t)((tid >> 3) + 64 * i) * 1024 + (tid & 7) * 8;
    f32x16 acc[1][2];
    gemm_mainloop<1>(al, bl, 16, smem, acc);
#pragma unroll
    for (int nt = 0; nt < 2; ++nt)
#pragma unroll
      for (int i = 0; i < 16; ++i) lg[(wm * 32 + crow(i, h5)) * 256 + wn * 64 + nt * 32 + r] = acc[0][nt][i];
    __syncthreads();
    int* lcnt = (int*)(smem + 65536);
    int* lbase = lcnt + 256;
    int* abuf = lbase + 256;
    if (tid < 256) lcnt[tid] = 0;
    __syncthreads();
    const f32x4 eb = *(const f32x4*)(p.e_bias + lane * 4);
    const int mygrp = lane >> 3;
#pragma unroll 1
    for (int rr0 = 0; rr0 < 8; rr0 += 4) {
      float sc[4][4], cand[4][4];
#pragma unroll
      for (int u = 0; u < 4; ++u) {
        const int row = w * 8 + rr0 + u;
        const f32x4 lv = *(const f32x4*)(lg + row * 256 + lane * 4);
        float ch[4];
#pragma unroll
        for (int q = 0; q < 4; ++q) { sc[u][q] = 1.f / (1.f + __expf(-lv[q])); ch[q] = sc[u][q] + eb[q]; }
        float m1 = fmaxf(ch[0], ch[1]), m2 = fminf(ch[0], ch[1]);
#pragma unroll
        for (int q = 2; q < 4; ++q) { const float v = ch[q]; m2 = fmaxf(m2, fminf(m1, v)); m1 = fmaxf(m1, v); }
#pragma unroll
        for (int sft = 1; sft < 8; sft <<= 1) {
          const float o1 = __shfl_xor(m1, sft), o2 = __shfl_xor(m2, sft);
          const float n1 = fmaxf(m1, o1); const float n2 = fmaxf(fminf(m1, o1), fmaxf(m2, o2));
          m1 = n1; m2 = n2;
        }
        const float gs = m1 + m2;
        int rank = 0;
#pragma unroll
        for (int q = 0; q < 8; ++q) { const float og = __shfl(gs, q * 8); rank += (og > gs || (og == gs && q < mygrp)) ? 1 : 0; }
        const bool allowed = rank < 4;
#pragma unroll
        for (int q = 0; q < 4; ++q) cand[u][q] = allowed ? ch[q] : NEG;
      }
      float wsel[4], wsum[4]; int esel[4];
#pragma unroll
      for (int u = 0; u < 4; ++u) { wsel[u] = 0.f; wsum[u] = 0.f; esel[u] = 0; }
#pragma unroll 1
      for (int k = 0; k < 8; ++k) {
#pragma unroll
        for (int u = 0; u < 4; ++u) {
          float bv = cand[u][0]; int bi = lane * 4;
#pragma unroll
          for (int q = 1; q < 4; ++q) if (cand[u][q] > bv) { bv = cand[u][q]; bi = lane * 4 + q; }
#pragma unroll
          for (int sft = 32; sft >= 1; sft >>= 1) {
            const float ov = __shfl_xor(bv, sft); const int oi = __shfl_xor(bi, sft);
            if (ov > bv || (ov == bv && oi < bi)) { bv = ov; bi = oi; }
          }
          float sv = 0.f;
          if ((bi >> 2) == lane) {
#pragma unroll
            for (int q = 0; q < 4; ++q) if ((bi & 3) == q) { sv = sc[u][q]; cand[u][q] = NEG; }
          }
          sv = __shfl(sv, bi >> 2);
          wsum[u] += sv;
          if (lane == k) { wsel[u] = sv; esel[u] = bi; }
        }
      }
      if (lane < 8) {
#pragma unroll
        for (int u = 0; u < 4; ++u) {
          const int rowl = w * 8 + rr0 + u;
          const int pl = atomicAdd(&lcnt[esel[u]], 1);
          abuf[rowl * 8 + lane] = esel[u] | (pl << 8);
          topw[(row0 + rowl) * 8 + lane] = wsel[u] / wsum[u] * 2.5f;
        }
      }
    }
    __syncthreads();
    if (tid < 256) { const int c = lcnt[tid]; lbase[tid] = (c > 0) ? atomicAdd(&cnt[tid * CNT_STRIDE], c) : 0; }
    __syncthreads();
    {
      const int en = abuf[tid], e = en & 255, pl = en >> 8;
      list[(size_t)e * LISTCAP + lbase[e] + pl] = (row0 + (tid >> 3)) * 8 + (tid & 7);
    }
  }
}

DI int perm_e(int o) { return (o & 31) * 8 + (o >> 5); }
DI void build_tables(const Params& p, int* tbl) {
  const int tid = opaque_tid();
  const int* cnt = (const int*)(p.ws + OFF_CNT);
  __syncthreads();
  if (tid < 256) tbl[520 + tid] = cnt[perm_e(tid) * CNT_STRIDE];
  __syncthreads();
  if (tid < 256) {
    int tp = 0, rp = 0;
    for (int o = 0; o < tid; ++o) { const int cc = tbl[520 + o]; tp += (cc + 255) >> 8; rp += cc; }
    tbl[tid] = tp; tbl[260 + tid] = rp;
    if (tid == 255) { const int cc = tbl[520 + 255]; tbl[256] = tp + ((cc + 255) >> 8); tbl[260 + 256] = rp + cc; }
  }
  __syncthreads();
}
DI int find_o(const int* tb, int g, int item) {
  int lo = 32 * g, hi = 32 * g + 31;
  while (lo < hi) { const int mid = (lo + hi + 1) >> 1; if (tb[mid] <= item) lo = mid; else hi = mid - 1; }
  return lo;
}
DI int queue_first(int* qc, volatile int* slot) {
  if (opaque_tid() == 0) *slot = atomicAdd(qc, 1);
  __syncthreads();
  const int v = *slot;
  __syncthreads();
  return v;
}

template <int MT>
DI void p8_tile(const Params& p, char* smem, int e, int rbeg, int cnt_e, int rowbase, int nchunk) {
  const int tid = opaque_tid(), lane = tid & 63, w = tid >> 6, wm = w >> 2, wn = w & 3, r = lane & 31, h5 = lane >> 5;
  const u16* h2b = (const u16*)(p.ws + OFF_H2B);
  const int* list = (const int*)(p.ws + OFF_LIST);
  LoadBf16<MT> al;
#pragma unroll
  for (int i = 0; i < MT; ++i) {
    const int rr = rbeg + (tid >> 3) + 64 * i;
    int tok = 0;
    if (rr < cnt_e) tok = (e < 256) ? (list[(size_t)e * LISTCAP + rr] >> 3) : rr;
    al.rp[i] = h2b + (size_t)tok * 1024 + src_chunk(tid);
  }
  f32x16 acc[MT][2];
  if (e < 256) {
    BLoadF32 bl;
    const int n4 = (tid & 63) * 4, kg = tid >> 6;
    const int twn = n4 >> 6, tnt = (n4 >> 5) & 1, jj = n4 & 31;
    const int col = nchunk * 128 + twn * 32 + jj;
    bl.ldb = 256; bl.p = (tnt ? p.w3 : p.w1) + (size_t)e * 1024 * 256 + (size_t)(kg * 8) * 256 + col;
    gemm_mainloop<MT>(al, bl, 16, smem, acc);
  } else {
    LoadBf16<4> bl;
    const u16* ws13T = (const u16*)(p.ws + OFF_WS13T);
#pragma unroll
    for (int i = 0; i < 4; ++i) bl.rp[i] = ws13T + (size_t)(nchunk * 256 + (tid >> 3) + 64 * i) * 1024 + src_chunk(tid);
    gemm_mainloop<MT>(al, bl, 16, smem, acc);
  }
  u16* actp = (e < 256) ? ((u16*)(p.ws + OFF_ACT) + (size_t)rowbase * 256) : (u16*)(p.ws + OFF_ACTS);
  float* cs = (float*)smem;
#pragma unroll 1
  for (int half = 0; half < (MT == 4 ? 2 : 1); ++half) {
    __syncthreads();
    if (MT == 2 || wm == half) {
      const int rb = (MT == 4) ? 0 : wm * 64;
#pragma unroll
      for (int mt = 0; mt < MT; ++mt)
#pragma unroll
        for (int i = 0; i < 16; ++i) cs[(rb + mt * 32 + crow(i, h5)) * 132 + wn * 32 + r] = siluf(acc[mt][0][i]) * acc[mt][1][i];
    }
    __syncthreads();
#pragma unroll 1
    for (int it = 0; it < 4; ++it) {
      const int i = it * NTHR + tid, row = i >> 4, c8 = (i & 15) * 8;
      const int rr = rbeg + half * 128 + row;
      if (rr < cnt_e) {
        const f32x4 va = *(const f32x4*)(cs + row * 132 + c8), vb = *(const f32x4*)(cs + row * 132 + c8 + 4);
        *(u32x4*)(actp + (size_t)rr * 256 + nchunk * 128 + c8) = pack8(va[0], va[1], va[2], va[3], vb[0], vb[1], vb[2], vb[3]);
      }
    }
  }
}

struct P8Task { int e, rbeg, cnt_e, rowbase, nchunk, mt; };
DI bool p8_decode(const int* tbl, int g, int t0, int nrouted, int id, P8Task& t) {
  if (id >= nrouted) return false;
  const int item = t0 + (id >> 1);
  const int o = find_o(tbl, g, item);
  t.nchunk = id & 1; t.e = perm_e(o); t.rbeg = (item - tbl[o]) * 256; t.cnt_e = tbl[520 + o]; t.rowbase = tbl[260 + o];
  t.mt = (t.cnt_e - t.rbeg > 128) ? 4 : 2;
  return true;
}
DI void p8_setup_b(const Params& p, const P8Task& t, BLoadF32& bl, int (&tok)[4]) {
  const int tid = opaque_tid();
  const int n4 = (tid & 63) * 4, kg = tid >> 6;
  const int twn = n4 >> 6, tnt = (n4 >> 5) & 1, jj = n4 & 31;
  const int col = t.nchunk * 128 + twn * 32 + jj;
  bl.ldb = 256; bl.p = (tnt ? p.w3 : p.w1) + (size_t)t.e * 1024 * 256 + (size_t)(kg * 8) * 256 + col;
  const int* list = (const int*)(p.ws + OFF_LIST);
#pragma unroll
  for (int i = 0; i < 4; ++i) {
    const int rr = t.rbeg + (tid >> 3) + 64 * i;
    tok[i] = (rr < t.cnt_e) ? list[(size_t)t.e * LISTCAP + rr] : 0;
  }
}
DI void p8_setup_a(const Params& p, LoadBf16<4>& al, const int (&tok)[4]) {
  const int tid = opaque_tid();
  const u16* h2b = (const u16*)(p.ws + OFF_H2B);
#pragma unroll
  for (int i = 0; i < 4; ++i) al.rp[i] = h2b + (size_t)(tok[i] >> 3) * 1024 + src_chunk(tid);
}
template <int MT>
DI void p8_epilogue(const Params& p, const P8Task& t, const f32x16 (&acc)[4][2]) {
  const int tid = opaque_tid(), lane = tid & 63, w = tid >> 6, wm = w >> 2, wn = w & 3, r = lane & 31, h5 = lane >> 5;
  u16* actp = (u16*)(p.ws + OFF_ACT) + (size_t)t.rowbase * 256;
#pragma unroll
  for (int mt = 0; mt < MT; ++mt) {
    const int rr = t.rbeg + wm * (MT * 32) + mt * 32 + r;
    u16* arow = actp + (size_t)rr * 256 + t.nchunk * 128 + wn * 32 + (h5 ? 8 : 0);
    unsigned pk[4][2];
#pragma unroll
    for (int g4 = 0; g4 < 4; ++g4) {
      float v[4];
#pragma unroll
      for (int q = 0; q < 4; ++q) v[q] = siluf(acc[mt][0][4 * g4 + q]) * acc[mt][1][4 * g4 + q];
      pk[g4][0] = pack2(v[0], v[1]); pk[g4][1] = pack2(v[2], v[3]);
    }
#pragma unroll
    for (int pr = 0; pr < 2; ++pr) {
      const unsigned s0 = h5 ? pk[2 * pr][0] : pk[2 * pr + 1][0], s1 = h5 ? pk[2 * pr][1] : pk[2 * pr + 1][1];
      const unsigned r0 = __shfl_xor(s0, 32), r1 = __shfl_xor(s1, 32);
      u32x4 o;
      if (h5) { o[0] = r0; o[1] = r1; o[2] = pk[2 * pr + 1][0]; o[3] = pk[2 * pr + 1][1]; }
      else    { o[0] = pk[2 * pr][0]; o[1] = pk[2 * pr][1]; o[2] = r0; o[3] = r1; }
      if (rr < t.cnt_e) *(u32x4*)(arow + pr * 16) = o;
    }
  }
}

DI void phase8(const Params& p, char* smem) {
  const int g = blockIdx.x & 7, tid = opaque_tid();
  int* tbl = (int*)(smem + LDS_TBL);
  volatile int* slot = (volatile int*)(smem + LDS_TBL + 12256);
  int* qc = (int*)(p.ws + OFF_QC) + g * 32;
  build_tables(p, tbl);
  const int t0 = tbl[32 * g], ntl = tbl[32 * g + 32] - t0;
  const int nrouted = ntl * 2, ntask = nrouted + 16;
  int id = queue_first(qc, slot);
  {
    P8Task cur, nxt;
    LoadBf16<4> al; BLoadF32 bl;
    int tok[4];
    bool have = p8_decode(tbl, g, t0, nrouted, id, cur);
    if (have) { p8_setup_b(p, cur, bl, tok); bl.prefetch0(smem + 32768, tid); p8_setup_a(p, al, tok); al.prefetch0(smem, tid); }
    f32x16 acc[4][2];
    while (have) {
      int ticket = 0;
      if (tid == 0) ticket = atomicAdd(qc, 1);
      if (cur.mt == 4) gemm_kloop_prefetched<4, 4, LoadBf16<4>, BLoadF32, false, true>(al, bl, 16, smem, acc);
      else             gemm_kloop_prefetched<2, 4, LoadBf16<4>, BLoadF32, false, true>(al, bl, 16, smem, acc);
      if (tid == 0) *slot = ticket;
      __syncthreads();
      id = *slot;
      const bool have2 = p8_decode(tbl, g, t0, nrouted, id, nxt);
      if (have2) { p8_setup_b(p, nxt, bl, tok); bl.prefetch0(smem + 32768, tid); }
      if (cur.mt == 4) p8_epilogue<4>(p, cur, acc); else p8_epilogue<2>(p, cur, acc);
      if (have2) { p8_setup_a(p, al, tok); al.prefetch0(smem, tid); }
      lds_barrier();
      cur = nxt; have = have2;
    }
  }
  while (id < ntask) {
    int nx = 0;
    if (tid == 0) nx = atomicAdd(qc, 1);
    const int sid = id - nrouted;
    p8_tile<4>(p, smem, 256, (8 * g + (sid >> 1)) * 256, T, 0, sid & 1);
    __syncthreads();
    if (tid == 0) *slot = nx;
    __syncthreads();
    id = *slot;
    __syncthreads();
  }
}

struct P9Task { int e, rbeg, cnt_e, rowbase, ntile, mt; };
DI bool p9_decode(const int* tbl, int g, int t0, int ntask, int id, P9Task& t) {
  if (id >= ntask) return false;
  const int item = t0 + (id >> 2);
  const int o = find_o(tbl, g, item);
  t.ntile = id & 3; t.e = perm_e(o); t.rbeg = (item - tbl[o]) * 256; t.cnt_e = tbl[520 + o]; t.rowbase = tbl[260 + o];
  t.mt = (t.cnt_e - t.rbeg > 128) ? 4 : 2;
  return true;
}
DI void p9_setup(const Params& p, const P9Task& t, LoadBf16<4>& al, BLoadF32& bl, int& asg, int) {
  const int tid = opaque_tid();
  const u16* actp = (const u16*)(p.ws + OFF_ACT) + (size_t)t.rowbase * 256;
#pragma unroll
  for (int i = 0; i < 4; ++i) {
    int rr = t.rbeg + (tid >> 3) + 64 * i;
    if (rr >= t.cnt_e) rr = 0;
    al.rp[i] = actp + (size_t)rr * 256 + src_chunk(tid);
  }
  bl.ldb = 1024;
  bl.p = p.w2 + (size_t)t.e * 256 * 1024 + (size_t)((tid >> 6) * 8) * 1024 + t.ntile * 256 + (tid & 63) * 4;
  asg = -1;
  if (tid < 256 && t.rbeg + tid < t.cnt_e) asg = ((const int*)(p.ws + OFF_LIST))[(size_t)t.e * LISTCAP + t.rbeg + tid];
}
template <int MT, int VAR>
DI void p9_epilogue(const Params& p, char* smem, const P9Task& t, const f32x16 (&acc)[4][2], const int* rasg, int) {
  const int tid = opaque_tid(), lane = tid & 63, w = tid >> 6, wm = w >> 2, wn = w & 3, r = lane & 31, h5 = lane >> 5;
  unsigned char* y = p.ws + (VAR ? OFF_Y2 : OFF_Y);
  if (VAR == 1 || VAR == 3) { asm volatile("" :: "v"(acc[0][0][0]), "v"(acc[1][1][5])); return; }
  const float* rwg = (const float*)(rasg + 256);
#pragma unroll
  for (int mt = 0; mt < MT; ++mt) {
    const int rl = wm * (MT * 32) + mt * 32 + r;
    const int asg = rasg[rl];
    const float ws = rwg[rl] * Y_SCALE;
    unsigned char* yrow = y + (size_t)(asg < 0 ? 0 : asg) * 1024 + t.ntile * 256 + wn * 64 + (h5 ? 8 : 0);
#pragma unroll
    for (int nt = 0; nt < 2; ++nt) {
      int pk[4];
#pragma unroll
      for (int g4 = 0; g4 < 4; ++g4) {
        int wv = 0;
        wv = __builtin_amdgcn_cvt_pk_fp8_f32(acc[mt][nt][4 * g4] * ws, acc[mt][nt][4 * g4 + 1] * ws, wv, false);
        wv = __builtin_amdgcn_cvt_pk_fp8_f32(acc[mt][nt][4 * g4 + 2] * ws, acc[mt][nt][4 * g4 + 3] * ws, wv, true);
        pk[g4] = wv;
      }
#pragma unroll
      for (int pr = 0; pr < 2; ++pr) {
        const int snd = h5 ? pk[2 * pr] : pk[2 * pr + 1];
        const int rcv = __shfl_xor(snd, 32);
        u32x2 o;
        o[0] = (unsigned)(h5 ? rcv : pk[2 * pr]);
        o[1] = (unsigned)(h5 ? pk[2 * pr + 1] : rcv);
        if (asg >= 0) *(u32x2*)(yrow + nt * 32 + pr * 16) = o;
      }
    }
  }
}

template <int VAR>
DI void phase9(const Params& p, char* smem) {
  const int g = blockIdx.x & 7, tid = opaque_tid();
  int* tbl = (int*)(smem + LDS_TBL);
  int* rasg = (int*)(smem + LDS_TBL + 4096);
  volatile int* slot = (volatile int*)(smem + LDS_TBL + 12256);
  int* qc = (int*)(p.ws + OFF_QC) + ((VAR ? 16 : 8) + g) * 32;
  const float* topw = (const float*)(p.ws + OFF_TOPW);
  build_tables(p, tbl);
  const int t0 = tbl[32 * g], ntl = tbl[32 * g + 32] - t0;
  const int ntask = ntl * 4;
  int id = queue_first(qc, slot);
  P9Task cur, nxt;
  LoadBf16<4> al; BLoadF32 bl;
  int asg = -1;
  bool have = p9_decode(tbl, g, t0, ntask, id, cur);
  if (have) { p9_setup(p, cur, al, bl, asg, tid); al.prefetch0(smem, tid); bl.prefetch0(smem + 32768, tid); }
  f32x16 acc[4][2];
  while (have) {
    int ticket = 0;
    if (tid == 0) ticket = atomicAdd(qc, 1);
    const float wg = (asg >= 0) ? topw[asg] : 0.f;
    if (cur.mt == 4) gemm_kloop_prefetched<4, 4, LoadBf16<4>, BLoadF32, (VAR == 2 || VAR == 3), true>(al, bl, 4, smem, acc); else gemm_kloop_prefetched<2, 4, LoadBf16<4>, BLoadF32, (VAR == 2 || VAR == 3), true>(al, bl, 4, smem, acc);
    if (tid < 256) { rasg[tid] = asg; ((float*)rasg)[256 + tid] = wg; }
    if (tid == 0) *slot = ticket;
    __syncthreads();
    id = *slot;
    const bool have2 = p9_decode(tbl, g, t0, ntask, id, nxt);
    if (have2) { p9_setup(p, nxt, al, bl, asg, tid); al.prefetch0(smem, tid); bl.prefetch0(smem + 32768, tid); }
    if (cur.mt == 4) p9_epilogue<4, VAR>(p, smem, cur, acc, rasg, tid); else p9_epilogue<2, VAR>(p, smem, cur, acc, rasg, tid);
    lds_barrier();
    cur = nxt; have = have2;
  }
}

DI void phase10(const Params& p, char* smem) {
  const u16* acts = (const u16*)(p.ws + OFF_ACTS);
  const u16* ws2T = (const u16*)(p.ws + OFF_WS2T);
  const unsigned char* y = p.ws + OFF_Y;
  const u16* d1 = (const u16*)(p.ws + OFF_D1);
  const float* mod = (const float*)(p.ws + OFF_MOD);
  float* cs = (float*)smem;
  const int xg = blockIdx.x & 7, xj = blockIdx.x >> 3, xn = gridDim.x >> 3;
  for (int l = xj; l < 32; l += xn) {
    const int mtile = xg * 8 + (l & 7), ntile = l >> 3, row0 = mtile * 256, b = row0 >> 12;
    LoadBf16<4> al; LoadBf16<4> bl;
    {
    const int tid = opaque_tid();
#pragma unroll
    for (int i = 0; i < 4; ++i) {
      al.rp[i] = acts + (size_t)(row0 + (tid >> 3) + 64 * i) * 256 + src_chunk(tid);
      bl.rp[i] = ws2T + (size_t)(ntile * 256 + (tid >> 3) + 64 * i) * 256 + src_chunk(tid);
    }
    }
    f32x16 acc[4][2];
    gemm_mainloop<4>(al, bl, 4, smem, acc);
    const int tid = opaque_tid();
#pragma unroll 1
    for (int half = 0; half < 2; ++half) {
      __syncthreads();
      stage_nat<4>(cs, acc, half);
      __syncthreads();
#pragma unroll 1
      for (int it = 0; it < 8; ++it) {
        const int i = it * NTHR + tid, row = i >> 5, c8 = (i & 31) * 8;
        const size_t t = row0 + half * 128 + row; const int col = ntile * 256 + c8;
        float v[8];
        {
          const f32x4 va = *(const f32x4*)(cs + row * 260 + c8), vb = *(const f32x4*)(cs + row * 260 + c8 + 4);
          v[0] = va[0]; v[1] = va[1]; v[2] = va[2]; v[3] = va[3]; v[4] = vb[0]; v[5] = vb[1]; v[6] = vb[2]; v[7] = vb[3];
        }
        {
          float ys[8];
#pragma unroll
          for (int q = 0; q < 8; ++q) ys[q] = 0.f;
#pragma unroll
          for (int k = 0; k < 8; ++k) {
            const u32x2 yy = *(const u32x2*)(y + (t * 8 + k) * 1024 + col);
            const f32x2_t a = __builtin_amdgcn_cvt_pk_f32_fp8((int)yy[0], false), bq = __builtin_amdgcn_cvt_pk_f32_fp8((int)yy[0], true);
            const f32x2_t c = __builtin_amdgcn_cvt_pk_f32_fp8((int)yy[1], false), d = __builtin_amdgcn_cvt_pk_f32_fp8((int)yy[1], true);
            ys[0] += a[0]; ys[1] += a[1]; ys[2] += bq[0]; ys[3] += bq[1]; ys[4] += c[0]; ys[5] += c[1]; ys[6] += d[0]; ys[7] += d[1];
          }
#pragma unroll
          for (int q = 0; q < 8; ++q) v[q] += ys[q] * (1.f / Y_SCALE);
        }
        const f32x4 g2a = *(const f32x4*)(mod + b * 6144 + 5120 + col), g2b = *(const f32x4*)(mod + b * 6144 + 5120 + col + 4);
        f32x4 xa = *(const f32x4*)(p.x + t * 1024 + col), xb = *(const f32x4*)(p.x + t * 1024 + col + 4);
        {
          const u32x4 dd = *(const u32x4*)(d1 + t * 1024 + col);
          xa[0] += bflo(dd[0]); xa[1] += bfhi(dd[0]); xa[2] += bflo(dd[1]); xa[3] += bfhi(dd[1]);
          xb[0] += bflo(dd[2]); xb[1] += bfhi(dd[2]); xb[2] += bflo(dd[3]); xb[3] += bfhi(dd[3]);
        }
        f32x4 oa = {xa[0] + g2a[0] * v[0], xa[1] + g2a[1] * v[1], xa[2] + g2a[2] * v[2], xa[3] + g2a[3] * v[3]};
        f32x4 ob = {xb[0] + g2b[0] * v[4], xb[1] + g2b[1] * v[5], xb[2] + g2b[2] * v[6], xb[3] + g2b[3] * v[7]};
        *(f32x4*)(p.out + t * 1024 + col) = oa;
        *(f32x4*)(p.out + t * 1024 + col + 4) = ob;
      }
    }
  }
}

#define XB_TMO      128
#define XB_XCNT(j)  (256  + 64 * (j))
#define XB_XSUB(j)  (1280 + 64 * (j))
#define XB_XGEN(j)  (2304 + 64 * (j))
#define XB_TOP      3328
#define XB_TOPGEN   3392
#define XCD_BAR_WORDS 3456
#define XB_SPIN_CAP (1u << 22)
#define LAS __attribute__((address_space(3)))
DI unsigned xb_ld(unsigned* p)              { return __hip_atomic_load(p, __ATOMIC_RELAXED, __HIP_MEMORY_SCOPE_AGENT); }
DI unsigned xb_add(unsigned* p, unsigned v) { return __hip_atomic_fetch_add(p, v, __ATOMIC_RELAXED, __HIP_MEMORY_SCOPE_AGENT); }
DI unsigned xb_xcc_id() { return (unsigned)__builtin_amdgcn_s_getreg((3 << 11) | 20) & 0xFu; }
#define XB_SPIN(cond, bar) do { unsigned _sp = 0; while (cond) { __builtin_amdgcn_s_sleep(1); \
    if ((++_sp & 255u) == 0u) { if (xb_ld(&(bar)[XB_TMO])) break; if (_sp > XB_SPIN_CAP) { atomicAdd(&(bar)[XB_TMO], 1u); break; } } } } while (0)
struct XcdBarrier { unsigned* bar; unsigned x; volatile LAS unsigned* st; };
DI XcdBarrier xcd_barrier_post(unsigned* bar, volatile LAS unsigned* st) {
  XcdBarrier b; b.bar = bar; b.x = xb_xcc_id(); b.st = st;
  if (threadIdx.x == 0) (void)xb_add(&bar[XB_XCNT(b.x)], 1u);
  return b;
}
DI void xcd_barrier_complete(unsigned* bar, unsigned x, unsigned& nloc, unsigned& nx) {
  const unsigned G = gridDim.x * gridDim.y * gridDim.z;
  unsigned sum, cnt, mine, sp = 0u;
  for (;;) {
    sum = 0u; cnt = 0u; mine = 0u;
#pragma unroll
    for (unsigned j = 0; j < 16; ++j) { const unsigned c = xb_ld(&bar[XB_XCNT(j)]); sum += c; cnt += (c > 0u) ? 1u : 0u; mine = (j == x) ? c : mine; }
    if (sum == G) break;
    __builtin_amdgcn_s_sleep(1);
    if ((++sp & 255u) == 0u) { if (xb_ld(&bar[XB_TMO])) break; if (sp > XB_SPIN_CAP) { atomicAdd(&bar[XB_TMO], 1u); break; } }
  }
  nloc = mine > 0u ? mine : 1u; nx = cnt > 0u ? cnt : 1u;
}
DI void xcd_barrier(const XcdBarrier& b) {
  asm volatile("s_waitcnt vmcnt(0)" ::: "memory");
  __syncthreads();
  if (threadIdx.x == 0) {
    unsigned* bar = b.bar;
    __builtin_amdgcn_s_waitcnt(0);
    unsigned nloc = b.st[0], nx = b.st[1];
    if (nloc == 0u) { xcd_barrier_complete(bar, b.x, nloc, nx); b.st[0] = nloc; b.st[1] = nx; }
    const unsigned old = xb_add(&bar[XB_XSUB(b.x)], 1u);
    const unsigned gen = old / nloc;
    if (old + 1u == (gen + 1u) * nloc) {
      __builtin_amdgcn_fence(__ATOMIC_RELEASE, "agent");
      asm volatile("s_waitcnt vmcnt(0)" ::: "memory");
      const unsigned og = xb_add(&bar[XB_TOP], 1u);
      const unsigned tg = og / nx;
      if (og + 1u == (tg + 1u) * nx) xb_add(&bar[XB_TOPGEN], 1u);
      else XB_SPIN(xb_ld(&bar[XB_TOPGEN]) == tg, bar);
      __builtin_amdgcn_fence(__ATOMIC_ACQUIRE, "agent");
      xb_add(&bar[XB_XGEN(b.x)], 1u);
      asm volatile("s_waitcnt vmcnt(0)" ::: "memory");
    } else {
      XB_SPIN(xb_ld(&bar[XB_XGEN(b.x)]) == gen, bar);
      __builtin_amdgcn_fence(__ATOMIC_ACQUIRE, "agent");
      asm volatile("s_waitcnt vmcnt(0)" ::: "memory");
    }
  }
  __syncthreads();
}


#if !FUSED
#define PHASE_KERNEL(name, body)                                                 \
  __global__ void __launch_bounds__(NTHR, 2) name(Params p) {                    \
    __shared__ __attribute__((aligned(16))) char smem[LDS_BYTES];                \
    body;                                                                        \
  }
PHASE_KERNEL(k_p0, phase0(p, smem))
PHASE_KERNEL(k_p1, phase1(p); (void)smem)
PHASE_KERNEL(k_p2, phase2<0>(p, smem); phase2_ga(p, smem))
PHASE_KERNEL(k_p3, phase_moba<0>(p, smem, 0, 512, (u16*)(p.ws + OFF_MIX)); phase_gla_a(p))
PHASE_KERNEL(k_p4, phase_gla_b(p); (void)smem)
PHASE_KERNEL(k_p5, phase_gla_c(p); (void)smem)
PHASE_KERNEL(k_p6, phase6(p, smem))
PHASE_KERNEL(k_p7, phase7_rows(p); phase7(p, smem))
PHASE_KERNEL(k_p8, phase8(p, smem))
PHASE_KERNEL(k_p9, phase9<0>(p, smem))
PHASE_KERNEL(k_p10, phase10(p, smem))
#else
__global__ void __launch_bounds__(NTHR, 2) k_fused(Params p) {
  __shared__ __attribute__((aligned(16))) char smem[LDS_BYTES];
  volatile LAS unsigned* st = (volatile LAS unsigned*)(smem + LDS_BYTES - 16);
  if (threadIdx.x == 0) { st[0] = 0u; st[1] = 0u; st[2] = 0u; st[3] = 0u; }
  __syncthreads();
  (void)xcd_barrier_post((unsigned*)(p.ws + OFF_BAR), st);
#define GRID_BARRIER() do { XcdBarrier xb_; xb_.bar = (unsigned*)(p.ws + OFF_BAR); xb_.x = xb_xcc_id(); xb_.st = (volatile LAS unsigned*)(smem + LDS_BYTES - 16); xcd_barrier(xb_); } while (0)
#if TPROBE
  unsigned long long tp_prev = __builtin_amdgcn_s_memrealtime(), tp_extra = 0;
#define PHASE_END(bit) do { GRID_BARRIER(); const unsigned long long tn_ = __builtin_amdgcn_s_memrealtime(); if ((TPROBE >> (bit)) & 1) tp_extra += tn_ - tp_prev; tp_prev = tn_; } while (0)
#else
#define PHASE_END(bit) GRID_BARRIER()
#endif
  phase0(p, smem);                                    PHASE_END(0);
  phase1(p);                                          PHASE_END(1);
  phase2<0>(p, smem); phase2_ga(p, smem);             PHASE_END(2);
#ifdef P2_VAR
  phase2<P2_VAR>(p, smem);                            PHASE_END(12);
#endif
#if TPROBE
  phase_moba<0>(p, smem, 0, 512, (u16*)(p.ws + OFF_MIX));                        PHASE_END(11);
#ifdef MOBA_VAR
  phase_moba<MOBA_VAR>(p, smem, 0, 512, (u16*)(p.ws + OFF_Y));   PHASE_END(12);
#endif
  phase_gla_a(p);                                     PHASE_END(3);
#else
  phase_moba<0>(p, smem, 0, 512, (u16*)(p.ws + OFF_MIX)); phase_gla_a(p);        PHASE_END(3);
#endif
  phase_gla_b(p);                                     PHASE_END(4);
  phase_gla_c(p);                                     PHASE_END(5);
  phase6(p, smem);                                    PHASE_END(6);
  phase7_rows(p); phase7(p, smem);                    PHASE_END(7);
  phase8(p, smem);                                    PHASE_END(8);
  phase9<0>(p, smem);                                 PHASE_END(9);
#ifdef P9_VAR
  phase9<P9_VAR>(p, smem);                            PHASE_END(12);
#endif
  phase10(p, smem);
#if TPROBE
  {
    __syncthreads();
    unsigned long long tn_ = __builtin_amdgcn_s_memrealtime();
    if ((TPROBE >> 10) & 1) tp_extra += tn_ - tp_prev;
    while (__builtin_amdgcn_s_memrealtime() - tn_ < tp_extra) __builtin_amdgcn_s_sleep(8);
  }
#endif
}
#endif

extern "C" void kernel_launch(void* const* d_in, const int* in_sizes, int n_in, void* d_out, int out_size, void* d_ws, size_t ws_size,
                              hipStream_t stream) {
  if (n_in != 23 || out_size != T * D || ws_size < WS_END) {
    fprintf(stderr, "kernel_launch: unexpected problem (n_in %d, out %d, ws %zu, need %zu)\n", n_in, out_size, ws_size, (size_t)WS_END);
    return;
  }
  Params p{};
  const float** f = (const float**)&p;
  for (int i = 0; i < 23; ++i) f[i] = (const float*)d_in[i];
  p.out = (float*)d_out;
  p.ws = (unsigned char*)d_ws;
  (void)hipMemsetAsync(d_ws, 0, ZERO_BYTES, stream);
#if !FUSED
  const dim3 grid(256), blk(NTHR);
  hipLaunchKernelGGL(k_p0, grid, blk, 0, stream, p);
  hipLaunchKernelGGL(k_p1, grid, blk, 0, stream, p);
  hipLaunchKernelGGL(k_p2, grid, blk, 0, stream, p);
  hipLaunchKernelGGL(k_p3, grid, blk, 0, stream, p);
  hipLaunchKernelGGL(k_p4, grid, blk, 0, stream, p);
  hipLaunchKernelGGL(k_p5, grid, blk, 0, stream, p);
  hipLaunchKernelGGL(k_p6, grid, blk, 0, stream, p);
  hipLaunchKernelGGL(k_p7, grid, blk, 0, stream, p);
  hipLaunchKernelGGL(k_p8, grid, blk, 0, stream, p);
  hipLaunchKernelGGL(k_p9, grid, blk, 0, stream, p);
  hipLaunchKernelGGL(k_p10, grid, blk, 0, stream, p);
#else
  static int grid_blocks = 0;
  if (!grid_blocks) {
    int dev = 0, cus = 0, per_cu = 0;
    (void)hipGetDevice(&dev);
    (void)hipDeviceGetAttribute(&cus, hipDeviceAttributeMultiprocessorCount, dev);
    (void)hipOccupancyMaxActiveBlocksPerMultiprocessor(&per_cu, k_fused, NTHR, 0);
    if (per_cu < 1) fprintf(stderr, "kernel_launch: occupancy query reports %d blocks per CU\n", per_cu);
    grid_blocks = cus;
    grid_blocks -= grid_blocks % 8;
  }
  hipLaunchKernelGGL(k_fused, dim3(grid_blocks), dim3(NTHR), 0, stream, p);
#endif
}
```
